# Optimizing an MI355X kernel written in HIP

```python
import jax, jax.numpy as jnp
from jax import lax
import numpy as np

D_MODEL = 1024
BATCH = 4
SEQ = 8192
DEPTH = 1

MLA_HEADS = 8
QK_NOPE_DIM = 64
QK_ROPE_DIM = 32
QK_HEAD_DIM = QK_NOPE_DIM + QK_ROPE_DIM
V_HEAD_DIM = 64
Q_LORA_RANK = 384
KV_LORA_RANK = 256
ROPE_THETA = 10000.0
Q_BLOCK = 128
RWKV_HEADS = 8
RWKV_HEAD_DIM = 64
RWKV_DIM = RWKV_HEADS * RWKV_HEAD_DIM
DECAY_LORA = 64
AAA_LORA = 64
GATE_LORA = 128
GN_EPS = RWKV_HEAD_DIM * 1e-5
MLA_COLS = Q_LORA_RANK + KV_LORA_RANK + QK_ROPE_DIM
RWKV_COLS = 3 * RWKV_DIM + DECAY_LORA + AAA_LORA + GATE_LORA
GATE_COLS = 2 * D_MODEL
IN_COLS = MLA_COLS + RWKV_COLS + GATE_COLS
D_FF = 4 * D_MODEL
PLE_DIM = 256
RMS_EPS = 1e-6

kernel_name = "hybrid_mla_rwkv7_gated_block"


def rmsnorm(x, g):
    xf = x.astype(jnp.float32)
    y = xf * lax.rsqrt(jnp.mean(xf * xf, axis=-1, keepdims=True) + RMS_EPS)
    return (y * g.astype(jnp.float32)).astype(x.dtype)


def rope_tables(positions):
    half = QK_ROPE_DIM // 2
    inv_freq = ROPE_THETA ** (-jnp.arange(half, dtype=jnp.float32) / half)
    ang = positions.astype(jnp.float32)[..., None] * inv_freq
    return jnp.cos(ang), jnp.sin(ang)


def apply_rope(x, cos, sin):
    xf = x.astype(jnp.float32)
    x1, x2 = jnp.split(xf, 2, axis=-1)
    out = jnp.concatenate([x1 * cos - x2 * sin, x2 * cos + x1 * sin], axis=-1)
    return out.astype(x.dtype)


def causal_block_attention(q, k, v, scale):
    S = q.shape[1]
    outs = []
    for blk in range(S // Q_BLOCK):
        q0 = blk * Q_BLOCK
        kend = q0 + Q_BLOCK
        qb = q[:, q0:kend]
        s = jnp.einsum('bqhd,bkhd->bhqk', qb, k[:, :kend]).astype(jnp.float32) * scale
        mask = jnp.arange(kend)[None, :] <= (q0 + jnp.arange(Q_BLOCK))[:, None]
        s = jnp.where(mask, s, jnp.float32(-1e30))
        prob = jax.nn.softmax(s, axis=-1).astype(v.dtype)
        outs.append(jnp.einsum('bhqk,bkhd->bqhd', prob, v[:, :kend]))
    return jnp.concatenate(outs, axis=1)


def mla_branch(z, cos, sin, g_q_a, w_uq, g_kv_a, w_ukv, w_o_mla):
    B, S, _ = z.shape
    c_q, c_kv, k_pe = jnp.split(z, [Q_LORA_RANK, Q_LORA_RANK + KV_LORA_RANK], axis=-1)
    q = (rmsnorm(c_q, g_q_a) @ w_uq).reshape(B, S, MLA_HEADS, QK_HEAD_DIM)
    q_nope, q_pe = jnp.split(q, [QK_NOPE_DIM], axis=-1)
    q_pe = apply_rope(q_pe, cos[:, :, None, :], sin[:, :, None, :])
    kv = (rmsnorm(c_kv, g_kv_a) @ w_ukv).reshape(B, S, MLA_HEADS, QK_NOPE_DIM + V_HEAD_DIM)
    k_nope, v = jnp.split(kv, [QK_NOPE_DIM], axis=-1)
    k_pe = apply_rope(k_pe, cos, sin)
    qh = jnp.concatenate([q_nope, q_pe], axis=-1)
    kh = jnp.concatenate([k_nope, jnp.broadcast_to(k_pe[:, :, None, :], (B, S, MLA_HEADS, QK_ROPE_DIM))], axis=-1)
    o = causal_block_attention(qh, kh, v, QK_HEAD_DIM ** -0.5)
    return o.reshape(B, S, MLA_HEADS * V_HEAD_DIM) @ w_o_mla


def token_shift(z, mu):
    prev = jnp.pad(z, ((0, 0), (1, 0), (0, 0)))[:, :-1]
    return z + (prev - z) * mu


def wkv7_scan(r, decay, k, v, a_vec, b_vec):
    B, S, H, N = r.shape

    def step(state, inp):
        r_t, d_t, k_t, v_t, a_t, b_t = inp
        sa = jnp.einsum('bhvk,bhk->bhv', state, a_t)
        state = (state * d_t[:, :, None, :] + sa[..., None] * b_t[:, :, None, :]
                 + v_t[..., None] * k_t[:, :, None, :])
        return state, jnp.einsum('bhvk,bhk->bhv', state, r_t)

    xs = tuple(jnp.moveaxis(t, 1, 0) for t in (r, decay, k, v, a_vec, b_vec))
    _, ys = lax.scan(step, jnp.zeros((B, H, N, N), jnp.float32), xs)
    return jnp.moveaxis(ys, 0, 1)


def rwkv7_branch(z, mu_rwkv, w0, w2, a0, a2, g2, k_k, k_a, r_k, ln_x_w, ln_x_b, w_o_rwkv):
    B, S, _ = z.shape
    f32 = jnp.float32
    z = token_shift(z, mu_rwkv)
    r, k, v, w_lo, a_lo, g_lo = jnp.split(
        z, [RWKV_DIM, 2 * RWKV_DIM, 3 * RWKV_DIM, 3 * RWKV_DIM + DECAY_LORA,
            3 * RWKV_DIM + DECAY_LORA + AAA_LORA], axis=-1)
    w_log = -jax.nn.softplus(-(w0.astype(f32) + (jnp.tanh(w_lo) @ w2).astype(f32))) - 0.5
    decay = jnp.exp(-jnp.exp(w_log))
    a = jax.nn.sigmoid(a0.astype(f32) + (a_lo @ a2).astype(f32))
    g = jax.nn.sigmoid(g_lo) @ g2
    hs = (B, S, RWKV_HEADS, RWKV_HEAD_DIM)
    r = r.astype(f32).reshape(hs)
    k = k.astype(f32)
    v = v.astype(f32).reshape(hs)
    kk = (k * k_k.astype(f32)).reshape(hs)
    kk = kk / jnp.maximum(jnp.linalg.norm(kk, axis=-1, keepdims=True), 1e-12)
    k = (k * (1.0 + (a - 1.0) * k_a.astype(f32))).reshape(hs)
    a = a.reshape(hs)
    decay = decay.reshape(hs)
    y = wkv7_scan(r, decay, k, v, -kk, kk * a)
    mean = jnp.mean(y, axis=-1, keepdims=True)
    var = jnp.mean(jnp.square(y - mean), axis=-1, keepdims=True)
    y = ((y - mean) * lax.rsqrt(var + GN_EPS)).reshape(B, S, RWKV_DIM)
    y = y * ln_x_w.astype(f32) + ln_x_b.astype(f32)
    bonus = jnp.sum(r * k * r_k.astype(f32), axis=-1, keepdims=True) * v
    y = (y + bonus.reshape(B, S, RWKV_DIM)).astype(z.dtype) * g
    return y @ w_o_rwkv


def setup_inputs(seed: int = 0) -> dict:
    key = jax.random.key(seed)
    ks = jax.random.split(key, 40)
    f32 = jnp.float32
    L = DEPTH

    def nrm(k, shape, fan_in):
        return jax.random.normal(k, shape, f32) * (fan_in ** -0.5)

    def gain(k, shape):
        return 1.0 + 0.02 * jax.random.normal(k, shape, f32)

    H, N = RWKV_HEADS, RWKV_HEAD_DIM
    return {
        "x": jax.random.normal(ks[0], (BATCH, SEQ, D_MODEL), f32),
        "p": jax.random.normal(ks[1], (DEPTH, BATCH, SEQ, PLE_DIM), f32),
        "positions": (jax.random.randint(ks[2], (BATCH, 1), 0, 1024, jnp.int32)
                      + jnp.arange(SEQ, dtype=jnp.int32)[None, :]),
        "g_mix": gain(ks[3], (L, D_MODEL)),
        "w_in": nrm(ks[4], (L, D_MODEL, IN_COLS), D_MODEL),
        "g_q_a": gain(ks[5], (L, Q_LORA_RANK)),
        "w_uq": nrm(ks[6], (L, Q_LORA_RANK, MLA_HEADS * QK_HEAD_DIM), Q_LORA_RANK),
        "g_kv_a": gain(ks[7], (L, KV_LORA_RANK)),
        "w_ukv": nrm(ks[8], (L, KV_LORA_RANK, MLA_HEADS * (QK_NOPE_DIM + V_HEAD_DIM)), KV_LORA_RANK),
        "w_o_mla": nrm(ks[9], (L, MLA_HEADS * V_HEAD_DIM, D_MODEL), MLA_HEADS * V_HEAD_DIM),
        "mu_rwkv": jax.random.uniform(ks[10], (L, RWKV_COLS), f32),
        "w0": jax.random.uniform(ks[11], (L, RWKV_DIM), f32, -6.5, -1.5),
        "w2": nrm(ks[12], (L, DECAY_LORA, RWKV_DIM), DECAY_LORA),
        "a0": 0.1 * jax.random.normal(ks[13], (L, RWKV_DIM), f32),
        "a2": nrm(ks[14], (L, AAA_LORA, RWKV_DIM), AAA_LORA),
        "g2": nrm(ks[15], (L, GATE_LORA, RWKV_DIM), GATE_LORA),
        "k_k": 0.85 + 0.02 * jax.random.normal(ks[16], (L, RWKV_DIM), f32),
        "k_a": gain(ks[17], (L, RWKV_DIM)),
        "r_k": 0.1 * jax.random.normal(ks[18], (L, H, N), f32),
        "ln_x_w": gain(ks[19], (L, RWKV_DIM)),
        "ln_x_b": 0.02 * jax.random.normal(ks[20], (L, RWKV_DIM), f32),
        "w_o_rwkv": nrm(ks[21], (L, RWKV_DIM, D_MODEL), RWKV_DIM),
        "w_out": nrm(ks[22], (L, D_MODEL, D_MODEL), D_MODEL),
        "g_ffn": gain(ks[23], (L, D_MODEL)),
        "w_ffn_up": nrm(ks[24], (L, D_MODEL, D_FF), D_MODEL),
        "w_ffn_down": nrm(ks[25], (L, D_FF, D_MODEL), D_FF),
        "g_ple": gain(ks[26], (L, D_MODEL)),
        "w_ple_gate": nrm(ks[27], (L, D_MODEL, D_MODEL), D_MODEL),
        "w_ple_proj": nrm(ks[28], (L, PLE_DIM, D_MODEL), PLE_DIM),
        "g_final": gain(ks[29], (D_MODEL,)),
    }


def reference(x, p, positions, g_mix, w_in, g_q_a, w_uq, g_kv_a, w_ukv, w_o_mla,
              mu_rwkv, w0, w2, a0, a2, g2, k_k, k_a, r_k, ln_x_w, ln_x_b, w_o_rwkv,
              w_out, g_ffn, w_ffn_up, w_ffn_down, g_ple, w_ple_gate, w_ple_proj, g_final):
    cos, sin = rope_tables(positions)
    for i in range(DEPTH):
        h = rmsnorm(x, g_mix[i])
        z = h @ w_in[i]
        z_mla, z_rwkv, z_gate = jnp.split(z, [MLA_COLS, MLA_COLS + RWKV_COLS], axis=-1)
        y_a = mla_branch(z_mla, cos, sin, g_q_a[i], w_uq[i], g_kv_a[i], w_ukv[i], w_o_mla[i])
        y_b = rwkv7_branch(z_rwkv, mu_rwkv[i], w0[i], w2[i], a0[i], a2[i], g2[i], k_k[i], k_a[i],
                           r_k[i], ln_x_w[i], ln_x_b[i], w_o_rwkv[i])
        gate = jax.nn.sigmoid(z_gate)
        gate_a, gate_b = jnp.split(gate, 2, axis=-1)
        x = x + (gate_a * y_a + gate_b * y_b) @ w_out[i]
        h = rmsnorm(x, g_ffn[i])
        x = x + jnp.square(jax.nn.relu(h @ w_ffn_up[i])) @ w_ffn_down[i]
        ple_gate = jax.nn.sigmoid(rmsnorm(x, g_ple[i]) @ w_ple_gate[i])
        x = x + ple_gate * (p[i] @ w_ple_proj[i])
    return rmsnorm(x, g_final)
```

```cpp
#include <hip/hip_runtime.h>
#include <hip/hip_cooperative_groups.h>
#include <stdint.h>
#include <stdio.h>
namespace cg = cooperative_groups;

#ifndef MK_MULTI
#define MK_MULTI 0
#endif

typedef unsigned short bf16_t;
typedef short bf16x8 __attribute__((ext_vector_type(8)));
typedef float f32x4 __attribute__((ext_vector_type(4)));
typedef unsigned u32x4 __attribute__((ext_vector_type(4)));
typedef unsigned u32x2 __attribute__((ext_vector_type(2)));
#define LAS __attribute__((address_space(3)))

constexpr int T_TOK = 32768, SEQ = 8192, DM = 1024;
constexpr int NPH = 12;
constexpr float RMS_EPS = 1e-6f;
constexpr float QSCALE = 0.10206207261596577f * 1.4426950408889634f;

constexpr size_t MiB = 1ull << 20;
constexpr size_t OFF_BAR = 0, OFF_QUEUE = 16384, ZERO_BYTES = 32768;
constexpr size_t OFF_SS1 = 65536, OFF_SS2 = OFF_SS1 + 131072, OFF_RSQ = OFF_SS2 + 131072, OFF_RSKV = OFF_RSQ + 131072;
constexpr size_t OFF_CS = 1 * MiB;
constexpr size_t OFF_W = 5 * MiB;
constexpr size_t W_IN = OFF_W;
constexpr size_t W_UQ = W_IN + 4608ull * 1024 * 2;
constexpr size_t W_KN = W_UQ + 768ull * 384 * 2;
constexpr size_t W_V = W_KN + 512ull * 256 * 2;
constexpr size_t W_OA = W_V + 512ull * 256 * 2;
constexpr size_t W_W2 = W_OA + 1024ull * 512 * 2;
constexpr size_t W_A2 = W_W2 + 512ull * 64 * 2;
constexpr size_t W_G2 = W_A2 + 512ull * 64 * 2;
constexpr size_t W_OB = W_G2 + 512ull * 128 * 2;
constexpr size_t W_OUT = W_OB + 1024ull * 512 * 2;
constexpr size_t W_UP = W_OUT + 1024ull * 1024 * 2;
constexpr size_t W_DN = W_UP + 4096ull * 1024 * 2;
constexpr size_t W_PG = W_DN + 4096ull * 1024 * 2;
constexpr size_t W_PP = W_PG + 1024ull * 1024 * 2;
constexpr size_t W_END = W_PP + 1024ull * 256 * 2;
static_assert(W_END <= 42 * MiB, "weights region");
constexpr size_t R_A = 42 * MiB;
constexpr size_t R_B = 106 * MiB;
constexpr size_t R_C = 148 * MiB;
constexpr size_t R_D = 260 * MiB;
constexpr size_t R_E = 356 * MiB;
constexpr size_t R_F = 388 * MiB;
constexpr size_t R_G = 420 * MiB;
constexpr size_t R_H = 422 * MiB;
constexpr size_t R_I = 454 * MiB;
constexpr size_t R_PB = 486 * MiB;
constexpr size_t WS_NEED = 502 * MiB;
constexpr size_t R_U = R_B;

struct Params {
    const float* in[30];
    float* out;
    unsigned char* ws;
    int ph_lo, ph_hi;
};

#define GAS __attribute__((address_space(1)))
template <class T> __device__ __forceinline__ T* lnd(T* q) { GAS T* g = (GAS T*)q; asm volatile("" : "+s"(g)); return (T*)g; }
#define IN(k) lnd(p.in[k])
#define VHALF ((int)__builtin_amdgcn_readfirstlane((int)(threadIdx.x >> 8)))
#define VB ((int)blockIdx.x * 2 + VHALF)
#define VG ((int)gridDim.x * 2)
__device__ __forceinline__ int tidx512() { int t = threadIdx.x; asm volatile("" : "+v"(t)); return t; }
__device__ __forceinline__ int tidx() { int t = threadIdx.x & 255; asm volatile("" : "+v"(t)); return t; }
__device__ __forceinline__ unsigned f2bf(float f) { unsigned u = __float_as_uint(f); return (u + 0x7fffu + ((u >> 16) & 1u)) >> 16; }
typedef float f32x2_t __attribute__((ext_vector_type(2)));
typedef __bf16 bf16x2_t __attribute__((ext_vector_type(2)));
__device__ __forceinline__ unsigned pk2(float lo, float hi) { f32x2_t v = {lo, hi}; bf16x2_t b = __builtin_convertvector(v, bf16x2_t); return __builtin_bit_cast(unsigned, b); }
__device__ __forceinline__ float bflo(unsigned w) { return __uint_as_float(w << 16); }
__device__ __forceinline__ float bfhi(unsigned w) { return __uint_as_float(w & 0xffff0000u); }
__device__ __forceinline__ float bf1(bf16_t v) { return __uint_as_float((unsigned)v << 16); }
__device__ __forceinline__ void unpack8(const u32x4 w, float (&f)[8]) {
    f[0] = bflo(w.x); f[1] = bfhi(w.x); f[2] = bflo(w.y); f[3] = bfhi(w.y); f[4] = bflo(w.z); f[5] = bfhi(w.z); f[6] = bflo(w.w); f[7] = bfhi(w.w);
}
__device__ __forceinline__ u32x4 pack8(const float (&f)[8]) { u32x4 w; w.x = pk2(f[0], f[1]); w.y = pk2(f[2], f[3]); w.z = pk2(f[4], f[5]); w.w = pk2(f[6], f[7]); return w; }
__device__ __forceinline__ float sigmoidf_(float x) { return __builtin_amdgcn_rcpf(1.0f + __expf(-x)); }
__device__ __forceinline__ float wave_sum(float v) {
#pragma unroll
    for (int o = 32; o >= 1; o >>= 1) v += __shfl_xor(v, o);
    return v;
}
template <int CTRL> __device__ __forceinline__ float dppf(float v) {
    return __int_as_float(__builtin_amdgcn_update_dpp(0, __float_as_int(v), CTRL, 0xf, 0xf, false));
}
__device__ __forceinline__ float row16_sum(float v) {
    v += dppf<0x128>(v); v += dppf<0x124>(v); v += dppf<0x122>(v); v += dppf<0x121>(v); return v;
}

#define XB_TMO      128
#define XB_XCNT(j)  (256  + 64 * (j))
#define XB_XSUB(j)  (1280 + 64 * (j))
#define XB_XGEN(j)  (2304 + 64 * (j))
#define XB_TOP      3328
#define XB_TOPGEN   3392
#define XCD_BAR_WORDS 3456
#define XB_SPIN_CAP (1u << 22)
__device__ __forceinline__ unsigned xb_ld(unsigned* p) { return __hip_atomic_load(p, __ATOMIC_RELAXED, __HIP_MEMORY_SCOPE_AGENT); }
__device__ __forceinline__ unsigned xb_add(unsigned* p, unsigned v) { return __hip_atomic_fetch_add(p, v, __ATOMIC_RELAXED, __HIP_MEMORY_SCOPE_AGENT); }
__device__ __forceinline__ unsigned xb_xcc_id() { return (unsigned)__builtin_amdgcn_s_getreg((3 << 11) | 20) & 0xFu; }
#define XB_SPIN(cond, bar) do { unsigned _sp = 0; while (cond) { __builtin_amdgcn_s_sleep(1); \
    if ((++_sp & 255u) == 0u) { if (xb_ld(&(bar)[XB_TMO])) break; if (_sp > XB_SPIN_CAP) { atomicAdd(&(bar)[XB_TMO], 1u); break; } } } } while (0)
struct XcdBarrier { unsigned* bar; unsigned x; volatile LAS unsigned* st; };
__device__ __forceinline__ XcdBarrier xcd_barrier_post(unsigned* bar, volatile LAS unsigned* st) {
    XcdBarrier b; b.bar = bar; b.x = xb_xcc_id(); b.st = st;
    if (threadIdx.x == 0) (void)xb_add(&bar[XB_XCNT(b.x)], 1u);
    return b;
}
__device__ __forceinline__ void xcd_barrier_complete(unsigned* bar, unsigned x, unsigned& nloc, unsigned& nx) {
    const unsigned G = gridDim.x * gridDim.y * gridDim.z;
    unsigned sum, cnt, mine, sp = 0u;
    for (;;) {
        sum = 0u; cnt = 0u; mine = 0u;
#pragma unroll
        for (unsigned j = 0; j < 16; ++j) { const unsigned c = xb_ld(&bar[XB_XCNT(j)]); sum += c; cnt += (c > 0u) ? 1u : 0u; mine = (j == x) ? c : mine; }
        if (sum == G) break;
        __builtin_amdgcn_s_sleep(1);
        if ((++sp & 255u) == 0u) { if (xb_ld(&bar[XB_TMO])) break; if (sp > XB_SPIN_CAP) { atomicAdd(&bar[XB_TMO], 1u); break; } }
    }
    nloc = mine > 0u ? mine : 1u; nx = cnt > 0u ? cnt : 1u;
}
__device__ __forceinline__ void xcd_barrier(const XcdBarrier& b) {
    asm volatile("s_waitcnt vmcnt(0)" ::: "memory");
    __syncthreads();
    if (threadIdx.x == 0) {
        unsigned* bar = b.bar;
        __builtin_amdgcn_s_waitcnt(0);
        unsigned nloc = b.st[0], nx = b.st[1];
        if (nloc == 0u) { xcd_barrier_complete(bar, b.x, nloc, nx); b.st[0] = nloc; b.st[1] = nx; }
        const unsigned old = xb_add(&bar[XB_XSUB(b.x)], 1u);
        const unsigned gen = old / nloc;
        if (old + 1u == (gen + 1u) * nloc) {
            __builtin_amdgcn_fence(__ATOMIC_RELEASE, "agent");
            asm volatile("s_waitcnt vmcnt(0)" ::: "memory");
            const unsigned og = xb_add(&bar[XB_TOP], 1u);
            const unsigned tg = og / nx;
            if (og + 1u == (tg + 1u) * nx) xb_add(&bar[XB_TOPGEN], 1u);
            else XB_SPIN(xb_ld(&bar[XB_TOPGEN]) == tg, bar);
            __builtin_amdgcn_fence(__ATOMIC_ACQUIRE, "agent");
            xb_add(&bar[XB_XGEN(b.x)], 1u);
            asm volatile("s_waitcnt vmcnt(0)" ::: "memory");
        } else {
            XB_SPIN(xb_ld(&bar[XB_XGEN(b.x)]) == gen, bar);
            __builtin_amdgcn_fence(__ATOMIC_ACQUIRE, "agent");
            asm volatile("s_waitcnt vmcnt(0)" ::: "memory");
        }
    }
    __syncthreads();
}

__device__ __forceinline__ int sw64(int row) { return (0x78 >> (2 * ((row >> 2) & 3))) & 3; }
__device__ __forceinline__ void gemm_core(const bf16_t* A, int lda, const bf16_t* Bt, int ldb, int K, f32x4 (&acc)[4][4], unsigned char* lds) {
    const int tid = tidx(), l = tid & 63, w = __builtin_amdgcn_readfirstlane(tid >> 6), wr = w >> 1, wc = w & 1, fr = l & 15, fq = l >> 4;
#pragma unroll
    for (int i = 0; i < 4; ++i)
#pragma unroll
        for (int j = 0; j < 4; ++j) acc[i][j] = (f32x4){0.f, 0.f, 0.f, 0.f};
    const int nk = K >> 5;
    const int rin = l >> 2, skc = (l & 3) ^ sw64(rin);
    const bf16_t* ga = A + (size_t)(w * 32 + rin) * lda + skc * 8;
    const bf16_t* gb = Bt + (size_t)(w * 32 + rin) * ldb + skc * 8;
    LAS unsigned char* L = (LAS unsigned char*)lds + w * 2048;
    const unsigned aoff = (unsigned)((wr * 64 + fr) * 64 + ((fq ^ sw64(fr)) * 16)), boff = (unsigned)(8192 + (wc * 64 + fr) * 64 + ((fq ^ sw64(fr)) * 16));
#define GC_ISSUE(kt_) do { LAS unsigned char* Ld_ = L + ((kt_) & 3) * 16384; \
        __builtin_amdgcn_global_load_lds((const unsigned*)(ga + (kt_) * 32), (LAS unsigned*)(Ld_), 16, 0, 0); \
        __builtin_amdgcn_global_load_lds((const unsigned*)(ga + (size_t)16 * lda + (kt_) * 32), (LAS unsigned*)(Ld_ + 1024), 16, 0, 0); \
        __builtin_amdgcn_global_load_lds((const unsigned*)(gb + (kt_) * 32), (LAS unsigned*)(Ld_ + 8192), 16, 0, 0); \
        __builtin_amdgcn_global_load_lds((const unsigned*)(gb + (size_t)16 * ldb + (kt_) * 32), (LAS unsigned*)(Ld_ + 8192 + 1024), 16, 0, 0); } while (0)
    const unsigned lbase = (unsigned)(size_t)(LAS unsigned char*)lds;
    asm volatile("s_waitcnt vmcnt(0)" ::: "memory");
    __syncthreads();
    GC_ISSUE(0);
    if (nk > 1) GC_ISSUE(1);
    if (nk > 2) GC_ISSUE(2);
#define GC_RD(dst, addr, OFF) asm volatile("ds_read_b128 %0, %1 offset:" #OFF : "=v"(dst) : "v"(addr) : "memory")
    for (int kt = 0; kt < nk; ++kt) {
        if (kt + 2 < nk) asm volatile("s_waitcnt vmcnt(8)" ::: "memory");
        else if (kt + 1 < nk) asm volatile("s_waitcnt vmcnt(4)" ::: "memory");
        else asm volatile("s_waitcnt vmcnt(0)" ::: "memory");
        __builtin_amdgcn_s_barrier();
        asm volatile("" ::: "memory");
        if (kt + 3 < nk) GC_ISSUE(kt + 3);
        const unsigned sa = lbase + (unsigned)((kt & 3) * 16384) + aoff, sb = lbase + (unsigned)((kt & 3) * 16384) + boff;
        bf16x8 a0, a1, a2, a3, b0, b1, b2, b3;
        GC_RD(a0, sa, 0); GC_RD(b0, sb, 0); GC_RD(a1, sa, 1024); GC_RD(b1, sb, 1024);
        GC_RD(a2, sa, 2048); GC_RD(b2, sb, 2048); GC_RD(a3, sa, 3072); GC_RD(b3, sb, 3072);
#define GC_MMA(mi, ni, A_, B_) acc[mi][ni] = __builtin_amdgcn_mfma_f32_16x16x32_bf16(B_, A_, acc[mi][ni], 0, 0, 0)
        asm volatile("s_waitcnt lgkmcnt(4)" : "+v"(a0), "+v"(a1), "+v"(b0), "+v"(b1) :: "memory");
        GC_MMA(0, 0, a0, b0); GC_MMA(0, 1, a0, b1); GC_MMA(1, 0, a1, b0); GC_MMA(1, 1, a1, b1);
        asm volatile("s_waitcnt lgkmcnt(2)" : "+v"(a2), "+v"(b2) :: "memory");
        GC_MMA(0, 2, a0, b2); GC_MMA(1, 2, a1, b2); GC_MMA(2, 0, a2, b0); GC_MMA(2, 1, a2, b1); GC_MMA(2, 2, a2, b2);
        asm volatile("s_waitcnt lgkmcnt(0)" : "+v"(a3), "+v"(b3) :: "memory");
        GC_MMA(0, 3, a0, b3); GC_MMA(1, 3, a1, b3); GC_MMA(2, 3, a2, b3); GC_MMA(3, 0, a3, b0); GC_MMA(3, 1, a3, b1); GC_MMA(3, 2, a3, b2); GC_MMA(3, 3, a3, b3);
    }
    __syncthreads();
}
__device__ __forceinline__ bool tile_map(int iter, int MT, int NT, int& rt, int& ct) {
    const int G = gridDim.x;
    if ((G & 7) == 0 && (MT & 63) == 0) {
        const int x = blockIdx.x & 7, lb = (blockIdx.x >> 3) * 2 + VHALF, nlb = (G >> 3) * 2, MTx = MT >> 3;
        const int li = lb + iter * nlb;
        if (li >= MTx * NT) return false;
        const int per = 8 * NT, rg = li / per, r = li - rg * per;
        ct = r >> 3; rt = x * MTx + rg * 8 + (r & 7);
        return true;
    }
    const int it = VB + iter * VG;
    if (it >= MT * NT) return false;
    rt = it / NT; ct = it - rt * NT; return true;
}
__device__ __forceinline__ void gemm8(const bf16_t* A, int lda, const bf16_t* Bt, int ldb, int K, f32x4 (&acc)[8][4], unsigned char* lds, bool pre = false, const bf16_t* nA = nullptr, const bf16_t* nBt = nullptr) {
    const int tid = tidx512(), l = tid & 63, w = __builtin_amdgcn_readfirstlane(tid >> 6), wr = w >> 2, wc = w & 3, fr = l & 15, fq = l >> 4;
#pragma unroll
    for (int i = 0; i < 8; ++i)
#pragma unroll
        for (int j = 0; j < 4; ++j) acc[i][j] = (f32x4){0.f, 0.f, 0.f, 0.f};
    const int nk = K >> 6;
    const int rin = l >> 3, skc = (l & 7) ^ (rin & 7);
    const bf16_t* ga = A + (size_t)(w * 32 + rin) * lda + skc * 8;
    const bf16_t* gb = Bt + (size_t)(w * 32 + rin) * ldb + skc * 8;
    LAS unsigned char* L = (LAS unsigned char*)lds + w * 4096;
#define G8_ISSUE(kt_) do { LAS unsigned char* Ld_ = L + ((kt_) & 1) * 65536; \
        __builtin_amdgcn_global_load_lds((const unsigned*)(ga + (kt_) * 64), (LAS unsigned*)(Ld_), 16, 0, 0); \
        __builtin_amdgcn_global_load_lds((const unsigned*)(ga + (size_t)8 * lda + (kt_) * 64), (LAS unsigned*)(Ld_ + 1024), 16, 0, 0); \
        __builtin_amdgcn_global_load_lds((const unsigned*)(ga + (size_t)16 * lda + (kt_) * 64), (LAS unsigned*)(Ld_ + 2048), 16, 0, 0); \
        __builtin_amdgcn_global_load_lds((const unsigned*)(ga + (size_t)24 * lda + (kt_) * 64), (LAS unsigned*)(Ld_ + 3072), 16, 0, 0); \
        __builtin_amdgcn_global_load_lds((const unsigned*)(gb + (kt_) * 64), (LAS unsigned*)(Ld_ + 32768), 16, 0, 0); \
        __builtin_amdgcn_global_load_lds((const unsigned*)(gb + (size_t)8 * ldb + (kt_) * 64), (LAS unsigned*)(Ld_ + 32768 + 1024), 16, 0, 0); \
        __builtin_amdgcn_global_load_lds((const unsigned*)(gb + (size_t)16 * ldb + (kt_) * 64), (LAS unsigned*)(Ld_ + 32768 + 2048), 16, 0, 0); \
        __builtin_amdgcn_global_load_lds((const unsigned*)(gb + (size_t)24 * ldb + (kt_) * 64), (LAS unsigned*)(Ld_ + 32768 + 3072), 16, 0, 0); } while (0)
    const unsigned lbase = (unsigned)(size_t)(LAS unsigned char*)lds;
    const unsigned arow = (unsigned)((wr * 128 + fr) * 128), brow = (unsigned)(32768 + (wc * 64 + fr) * 128);
    const unsigned sw0 = (unsigned)(((0 + fq) ^ (fr & 7)) * 16), sw1 = (unsigned)(((4 + fq) ^ (fr & 7)) * 16);
    if (!pre) {
        asm volatile("s_waitcnt vmcnt(0)" ::: "memory");
        __syncthreads();
        G8_ISSUE(0);
    }
#define G8_MMA(mi, ni, A_, B_) acc[mi][ni] = __builtin_amdgcn_mfma_f32_16x16x32_bf16(B_, A_, acc[mi][ni], 0, 0, 0)
#define G8_HALF(sa, sb, F1, F2, F3, F4) do { \
        bf16x8 a0, a1, a2, a3, b0, b1, b2, b3, c0, c1, c2, c3; \
        GC_RD(b0, sb, 0); GC_RD(b1, sb, 2048); GC_RD(b2, sb, 4096); GC_RD(b3, sb, 6144); \
        GC_RD(a0, sa, 0); GC_RD(a1, sa, 2048); GC_RD(a2, sa, 4096); GC_RD(a3, sa, 6144); \
        asm volatile("s_waitcnt lgkmcnt(2)" : "+v"(b0), "+v"(b1), "+v"(b2), "+v"(b3), "+v"(a0), "+v"(a1) :: "memory"); \
        G8_MMA(0, 0, a0, b0); G8_MMA(0, 1, a0, b1); G8_MMA(0, 2, a0, b2); G8_MMA(0, 3, a0, b3); \
        G8_MMA(1, 0, a1, b0); G8_MMA(1, 1, a1, b1); G8_MMA(1, 2, a1, b2); G8_MMA(1, 3, a1, b3); \
        F1; \
        asm volatile("s_waitcnt lgkmcnt(0)" : "+v"(a2), "+v"(a3) :: "memory"); \
        G8_MMA(2, 0, a2, b0); G8_MMA(2, 1, a2, b1); G8_MMA(2, 2, a2, b2); G8_MMA(2, 3, a2, b3); \
        G8_MMA(3, 0, a3, b0); G8_MMA(3, 1, a3, b1); G8_MMA(3, 2, a3, b2); G8_MMA(3, 3, a3, b3); \
        GC_RD(c0, sa, 8192); GC_RD(c1, sa, 10240); GC_RD(c2, sa, 12288); GC_RD(c3, sa, 14336); \
        F2; \
        asm volatile("s_waitcnt lgkmcnt(2)" : "+v"(c0), "+v"(c1) :: "memory"); \
        G8_MMA(4, 0, c0, b0); G8_MMA(4, 1, c0, b1); G8_MMA(4, 2, c0, b2); G8_MMA(4, 3, c0, b3); \
        G8_MMA(5, 0, c1, b0); G8_MMA(5, 1, c1, b1); G8_MMA(5, 2, c1, b2); G8_MMA(5, 3, c1, b3); \
        F3; \
        asm volatile("s_waitcnt lgkmcnt(0)" : "+v"(c2), "+v"(c3) :: "memory"); \
        G8_MMA(6, 0, c2, b0); G8_MMA(6, 1, c2, b1); G8_MMA(6, 2, c2, b2); G8_MMA(6, 3, c2, b3); \
        G8_MMA(7, 0, c3, b0); G8_MMA(7, 1, c3, b1); G8_MMA(7, 2, c3, b2); G8_MMA(7, 3, c3, b3); \
        F4; } while (0)
#define G8_PA(kt_, j) __builtin_amdgcn_global_load_lds((const unsigned*)(ga + (size_t)(8 * (j)) * lda + (kt_) * 64), (LAS unsigned*)(L + ((kt_) & 1) * 65536 + 1024 * (j)), 16, 0, 0)
#define G8_PB(kt_, j) __builtin_amdgcn_global_load_lds((const unsigned*)(gb + (size_t)(8 * (j)) * ldb + (kt_) * 64), (LAS unsigned*)(L + ((kt_) & 1) * 65536 + 32768 + 1024 * (j)), 16, 0, 0)
    for (int kt = 0; kt < nk; ++kt) {
        asm volatile("s_waitcnt vmcnt(0)" ::: "memory");
        __builtin_amdgcn_s_barrier();
        asm volatile("" ::: "memory");
        const bool nxt = kt + 1 < nk;
        const unsigned slot = lbase + (unsigned)((kt & 1) * 65536);
        const unsigned sa0 = slot + arow + sw0, sb0 = slot + brow + sw0, sa1 = slot + arow + sw1, sb1 = slot + brow + sw1;
        __builtin_amdgcn_s_setprio(1);
        G8_HALF(sa0, sb0,
                if (nxt) { G8_PA(kt + 1, 0); G8_PB(kt + 1, 0); },
                if (nxt) { G8_PA(kt + 1, 1); G8_PB(kt + 1, 1); },
                if (nxt) { G8_PA(kt + 1, 2); G8_PB(kt + 1, 2); },
                if (nxt) { G8_PA(kt + 1, 3); G8_PB(kt + 1, 3); });
        G8_HALF(sa1, sb1, (void)0, (void)0, (void)0, (void)0);
        __builtin_amdgcn_s_setprio(0);
    }
    __syncthreads();
    if (nA) {
        const bf16_t* ga2 = nA + (size_t)(w * 32 + rin) * lda + skc * 8;
        const bf16_t* gb2 = nBt + (size_t)(w * 32 + rin) * ldb + skc * 8;
#pragma unroll
        for (int j = 0; j < 4; ++j) {
            __builtin_amdgcn_global_load_lds((const unsigned*)(ga2 + (size_t)(8 * j) * lda), (LAS unsigned*)(L + 1024 * j), 16, 0, 0);
            __builtin_amdgcn_global_load_lds((const unsigned*)(gb2 + (size_t)(8 * j) * ldb), (LAS unsigned*)(L + 32768 + 1024 * j), 16, 0, 0);
        }
    }
}
__device__ __forceinline__ bool tile_map8(int iter, int MT, int NT, int& rt, int& ct) {
    const int G = gridDim.x;
    if ((G & 7) == 0 && (MT & 63) == 0) {
        const int x = blockIdx.x & 7, lb = blockIdx.x >> 3, nlb = G >> 3, MTx = MT >> 3;
        const int li = lb + iter * nlb;
        if (li >= MTx * NT) return false;
        const int per = 4 * NT, rg = li / per, r = li - rg * per;
        ct = r >> 2; rt = x * MTx + rg * 4 + (r & 3);
        return true;
    }
    const int it = (int)blockIdx.x + iter * G;
    if (it >= MT * NT) return false;
    rt = it / NT; ct = it - rt * NT; return true;
}
#define EPI8_IDS const int tid_ = tidx512(), l_ = tid_ & 63, w_ = tid_ >> 6, wr = w_ >> 2, wc = w_ & 3, fr = l_ & 15, fq = l_ >> 4; (void)wr; (void)wc; (void)fr; (void)fq;
#define EPI_IDS const int tid_ = tidx(), l_ = tid_ & 63, w_ = tid_ >> 6, wr = w_ >> 1, wc = w_ & 1, fr = l_ & 15, fq = l_ >> 4; (void)wr; (void)wc; (void)fr; (void)fq;

__device__ void transpose_job(const float* __restrict__ W, int K, int ldw, int rows, int mode, int perm, const float* __restrict__ gs, bf16_t* __restrict__ Wt, int gtid, int gthreads) {
    const int nch = rows * (K >> 3), nnb = rows >> 3;
    for (int id = gtid; id < nch; id += gthreads) {
        const int tile = id >> 6, lane = id & 63;
        const int n = (tile % nnb) * 8 + (lane & 7), kc = (tile / nnb) * 8 + (lane >> 3);
        int nn = n;
        if (perm) { const int j = n & 31; nn = (n & ~31) + ((j >> 2) & 3) * 8 + (j >> 4) * 4 + (j & 3); }
        int col = nn;
        if (mode == 1) col = (nn >> 6) * 128 + (nn & 63); else if (mode == 2) col = (nn >> 6) * 128 + 64 + (nn & 63);
        float v[8];
#pragma unroll
        for (int j = 0; j < 8; ++j) { const int k = kc * 8 + j; float x = W[(size_t)k * ldw + col]; if (gs) x *= gs[k]; v[j] = x; }
        *(u32x4*)(Wt + (size_t)n * K + kc * 8) = pack8(v);
    }
}
__device__ void rmsnorm_rows_bf16(const float* __restrict__ x, const float* __restrict__ g, bf16_t* __restrict__ h) {
    const int l = tidx() & 63, gw = VB * 4 + (tidx() >> 6), nw = VG * 4;
    for (int row = gw; row < T_TOK; row += nw) {
        const float* xr = x + (size_t)row * DM;
        f32x4 v[4]; float ss = 0.f;
#pragma unroll
        for (int i = 0; i < 4; ++i) { v[i] = *(const f32x4*)(xr + i * 256 + l * 4); ss += v[i][0] * v[i][0] + v[i][1] * v[i][1] + v[i][2] * v[i][2] + v[i][3] * v[i][3]; }
        ss = wave_sum(ss);
        const float rs = rsqrtf(ss * (1.0f / DM) + RMS_EPS);
#pragma unroll
        for (int i = 0; i < 4; ++i) {
            const f32x4 gg = *(const f32x4*)(g + i * 256 + l * 4);
            u32x2 o; o.x = pk2(v[i][0] * rs * gg[0], v[i][1] * rs * gg[1]); o.y = pk2(v[i][2] * rs * gg[2], v[i][3] * rs * gg[3]);
            *(u32x2*)(h + (size_t)row * DM + i * 256 + l * 4) = o;
        }
    }
}

__device__ void phase0(const Params& p) {
    unsigned char* ws = lnd(p.ws);
    const int gtid = VB * 256 + tidx(), gth = VG * 256;
    transpose_job(IN(4), 1024, 4512, 4512, 0, 1, nullptr, (bf16_t*)(ws + W_IN), gtid, gth);
    transpose_job(IN(6), 384, 768, 768, 0, 0, IN(5), (bf16_t*)(ws + W_UQ), gtid, gth);
    transpose_job(IN(8), 256, 1024, 512, 1, 1, IN(7), (bf16_t*)(ws + W_KN), gtid, gth);
    transpose_job(IN(8), 256, 1024, 512, 2, 0, IN(7), (bf16_t*)(ws + W_V), gtid, gth);
    transpose_job(IN(9), 512, 1024, 1024, 0, 1, nullptr, (bf16_t*)(ws + W_OA), gtid, gth);
    transpose_job(IN(12), 64, 512, 512, 0, 1, nullptr, (bf16_t*)(ws + W_W2), gtid, gth);
    transpose_job(IN(14), 64, 512, 512, 0, 1, nullptr, (bf16_t*)(ws + W_A2), gtid, gth);
    transpose_job(IN(15), 128, 512, 512, 0, 1, nullptr, (bf16_t*)(ws + W_G2), gtid, gth);
    transpose_job(IN(21), 512, 1024, 1024, 0, 1, nullptr, (bf16_t*)(ws + W_OB), gtid, gth);
    transpose_job(IN(22), 1024, 1024, 1024, 0, 1, nullptr, (bf16_t*)(ws + W_OUT), gtid, gth);
    transpose_job(IN(24), 1024, 4096, 4096, 0, 1, IN(23), (bf16_t*)(ws + W_UP), gtid, gth);
    transpose_job(IN(25), 4096, 1024, 1024, 0, 1, nullptr, (bf16_t*)(ws + W_DN), gtid, gth);
    transpose_job(IN(27), 1024, 1024, 1024, 0, 1, IN(26), (bf16_t*)(ws + W_PG), gtid, gth);
    transpose_job(IN(28), 256, 1024, 1024, 0, 1, nullptr, (bf16_t*)(ws + W_PP), gtid, gth);
    {
        const float* pp = IN(1); bf16_t* pb = (bf16_t*)(ws + R_PB);
        for (int id = gtid; id < T_TOK * 256 / 8; id += gth) {
            const f32x4 a = *(const f32x4*)(pp + (size_t)id * 8), b = *(const f32x4*)(pp + (size_t)id * 8 + 4);
            u32x4 o; o.x = pk2(a[0], a[1]); o.y = pk2(a[2], a[3]); o.z = pk2(b[0], b[1]); o.w = pk2(b[2], b[3]);
            *(u32x4*)(pb + (size_t)id * 8) = o;
        }
    }
    { float* z = (float*)(ws + OFF_SS1); for (int id = gtid; id < 2 * T_TOK; id += gth) z[id] = 0.f; }
    rmsnorm_rows_bf16(IN(0), IN(3), (bf16_t*)(ws + R_A));
}

__device__ void phase1(const Params& p, unsigned char* lds8) {
    unsigned char* ws = lnd(p.ws); EPI8_IDS
    const bf16_t* h = (const bf16_t*)(ws + R_A); const bf16_t* Wt = (const bf16_t*)(ws + W_IN);
    bf16_t* zm = (bf16_t*)(ws + R_B); bf16_t* zr = (bf16_t*)(ws + R_C);
    int rt, ct; bool have = tile_map8(0, 128, 10, rt, ct), pre = false;
    for (int iter = 0; have; ++iter) {
        const int m0 = rt * 256, n0 = ct * 256;
        int rt2 = 0, ct2 = 0; const bool have2 = tile_map8(iter + 1, 128, 10, rt2, ct2);
        f32x4 acc[8][4];
        gemm8(h + (size_t)m0 * 1024, 1024, Wt + (size_t)n0 * 1024, 1024, 1024, acc, lds8, pre, have2 ? h + (size_t)rt2 * 256 * 1024 : nullptr, have2 ? Wt + (size_t)ct2 * 256 * 1024 : nullptr);
#pragma unroll
        for (int mi = 0; mi < 8; ++mi) {
            const int row = m0 + wr * 128 + mi * 16 + fr;
#pragma unroll
            for (int q = 0; q < 2; ++q) {
                const int col = n0 + wc * 64 + q * 32 + fq * 8;
                u32x4 o; o.x = pk2(acc[mi][2 * q][0], acc[mi][2 * q][1]); o.y = pk2(acc[mi][2 * q][2], acc[mi][2 * q][3]);
                o.z = pk2(acc[mi][2 * q + 1][0], acc[mi][2 * q + 1][1]); o.w = pk2(acc[mi][2 * q + 1][2], acc[mi][2 * q + 1][3]);
                if (col < 672) *(u32x4*)(zm + (size_t)row * 672 + col) = o;
                else if (col < 2464) *(u32x4*)(zr + (size_t)row * 1792 + (col - 672)) = o;
            }
        }
        pre = have2; rt = rt2; ct = ct2; have = have2;
    }
}

__device__ void phase2(const Params& p) {
    unsigned char* ws = lnd(p.ws);
    const bf16_t* zm = (const bf16_t*)(ws + R_B); const bf16_t* zr = (const bf16_t*)(ws + R_C);
    float* rsq = (float*)(ws + OFF_RSQ); float* rskv = (float*)(ws + OFF_RSKV); float* cs = (float*)(ws + OFF_CS);
    bf16_t* kpe = (bf16_t*)(ws + R_G);
    bf16_t* lin = (bf16_t*)(ws + R_A + 48 * MiB);
    bf16_t* rs = (bf16_t*)(ws + R_D); bf16_t* ks = rs + (size_t)T_TOK * 512; bf16_t* vs = ks + (size_t)T_TOK * 512;
    const float* mu = IN(10); const int* pos = (const int*)IN(2);
    const int l = tidx() & 63, gw = VB * 4 + (tidx() >> 6), nw = VG * 4;
    for (int tok = gw; tok < T_TOK; tok += nw) {
        const bf16_t* zrow = zm + (size_t)tok * 672;
        float sq = 0.f, skv = 0.f;
        {
            float f[8]; unpack8(*(const u32x4*)(zrow + l * 8), f);
            float s = 0.f;
#pragma unroll
            for (int j = 0; j < 8; ++j) s += f[j] * f[j];
            if (l < 48) sq += s; else skv += s;
            if (l < 16) { unpack8(*(const u32x4*)(zrow + (64 + l) * 8), f); s = 0.f;
#pragma unroll
                for (int j = 0; j < 8; ++j) s += f[j] * f[j];
                skv += s; }
        }
        sq = wave_sum(sq); skv = wave_sum(skv);
        if (l == 0) { rsq[tok] = rsqrtf(sq * (1.0f / 384.0f) + RMS_EPS); rskv[tok] = rsqrtf(skv * (1.0f / 256.0f) + RMS_EPS); }
        if (l < 16) {
            const float invf = powf(10000.0f, -(float)l * (1.0f / 16.0f));
            const float ang = (float)pos[tok] * invf;
            float sn, c; sincosf(ang, &sn, &c);
            cs[(size_t)tok * 32 + l] = c; cs[(size_t)tok * 32 + 16 + l] = sn;
            const float x1 = bf1(zrow[640 + l]), x2 = bf1(zrow[656 + l]);
            kpe[(size_t)tok * 32 + l] = (bf16_t)f2bf(x1 * c - x2 * sn);
            kpe[(size_t)tok * 32 + 16 + l] = (bf16_t)f2bf(x2 * c + x1 * sn);
        }
        const bool first = (tok % SEQ) == 0;
        const bf16_t* cur = zr + (size_t)tok * 1792; const bf16_t* prv = cur - 1792;
#pragma unroll
        for (int ps = 0; ps < 4; ++ps) {
            const int ch = ps * 64 + l;
            if (ch < 224) {
                const int c0 = ch * 8;
                float fc[8], fp[8], zs[8];
                unpack8(*(const u32x4*)(cur + c0), fc);
                if (first) {
#pragma unroll
                    for (int j = 0; j < 8; ++j) fp[j] = 0.f;
                } else unpack8(*(const u32x4*)(prv + c0), fp);
                const f32x4 m0 = *(const f32x4*)(mu + c0), m1 = *(const f32x4*)(mu + c0 + 4);
#pragma unroll
                for (int j = 0; j < 8; ++j) { const float m = j < 4 ? m0[j] : m1[j - 4]; zs[j] = fc[j] + (fp[j] - fc[j]) * m; }
                bf16_t* dst;
                if (c0 < 512) dst = rs + (size_t)tok * 512 + c0;
                else if (c0 < 1024) dst = ks + (size_t)tok * 512 + (c0 - 512);
                else if (c0 < 1536) dst = vs + (size_t)tok * 512 + (c0 - 1024);
                else {
                    dst = lin + (size_t)tok * 256 + (c0 - 1536);
                    if (c0 < 1600) {
#pragma unroll
                        for (int j = 0; j < 8; ++j) zs[j] = tanhf(zs[j]);
                    } else if (c0 >= 1664) {
#pragma unroll
                        for (int j = 0; j < 8; ++j) zs[j] = sigmoidf_(zs[j]);
                    }
                }
                *(u32x4*)dst = pack8(zs);
            }
        }
    }
}

__device__ void phase3(const Params& p, unsigned char* lds) {
    unsigned char* ws = lnd(p.ws); EPI_IDS
    const bf16_t* zm = (const bf16_t*)(ws + R_B);
    const bf16_t* lin = (const bf16_t*)(ws + R_A + 48 * MiB);
    const float* rsq = (const float*)(ws + OFF_RSQ); const float* rskv = (const float*)(ws + OFF_RSKV); const float* cs = (const float*)(ws + OFF_CS);
    bf16_t* qb = (bf16_t*)(ws + R_A); bf16_t* kn = (bf16_t*)(ws + R_E); bf16_t* vt = (bf16_t*)(ws + R_F);
    bf16_t* ks = (bf16_t*)(ws + R_D) + (size_t)T_TOK * 512;
    bf16_t* kk = (bf16_t*)(ws + R_C); bf16_t* bb = kk + (size_t)T_TOK * 512; bf16_t* om = bb + (size_t)T_TOK * 512;
    bf16_t* gg = (bf16_t*)(ws + R_H);
    constexpr int N_Q = 256 * 6, N_KN = 256 * 4, N_VT = 4 * 256, N_L = 256 * 4;
    constexpr int TOT = N_Q + N_KN + N_VT + 3 * N_L;
    for (int it = VB; it < TOT; it += VG) {
        f32x4 acc[4][4];
        if (it < N_Q) {
            const int rt = it / 6, ct = it % 6, m0 = rt * 128, n0 = ct * 128;
            gemm_core(zm + (size_t)m0 * 672, 672, (const bf16_t*)(ws + W_UQ) + (size_t)n0 * 384, 384, 384, acc, lds);
            const int G0 = (n0 + wc * 64) >> 4;
#pragma unroll
            for (int mi = 0; mi < 4; ++mi) {
                const int row = m0 + wr * 64 + mi * 16 + fr;
                const float sc = rsq[row] * QSCALE;
#pragma unroll
                for (int np = 0; np < 4; np += 2) {
                    const int r6 = (G0 + np) % 6;
                    f32x4 a = acc[mi][np] * sc, b = acc[mi][np + 1] * sc;
                    if (r6 == 4) {
                        const f32x4 c = *(const f32x4*)(cs + (size_t)row * 32 + fq * 4), s = *(const f32x4*)(cs + (size_t)row * 32 + 16 + fq * 4);
                        const f32x4 o1 = a * c - b * s, o2 = b * c + a * s; a = o1; b = o2;
                    }
                    const int col = n0 + wc * 64 + np * 16 + fq * 4;
                    u32x2 o; o.x = pk2(a[0], a[1]); o.y = pk2(a[2], a[3]); *(u32x2*)(qb + (size_t)row * 768 + col) = o;
                    o.x = pk2(b[0], b[1]); o.y = pk2(b[2], b[3]); *(u32x2*)(qb + (size_t)row * 768 + col + 16) = o;
                }
            }
        } else if (it < N_Q + N_KN) {
            const int i2 = it - N_Q, rt = i2 >> 2, ct = i2 & 3, m0 = rt * 128, n0 = ct * 128;
            gemm_core(zm + (size_t)m0 * 672 + 384, 672, (const bf16_t*)(ws + W_KN) + (size_t)n0 * 256, 256, 256, acc, lds);
#pragma unroll
            for (int mi = 0; mi < 4; ++mi) {
                const int row = m0 + wr * 64 + mi * 16 + fr; const float sc = rskv[row];
#pragma unroll
                for (int q = 0; q < 2; ++q) {
                    const int col = n0 + wc * 64 + q * 32 + fq * 8; const f32x4 a = acc[mi][2 * q] * sc, c = acc[mi][2 * q + 1] * sc;
                    u32x4 o; o.x = pk2(a[0], a[1]); o.y = pk2(a[2], a[3]); o.z = pk2(c[0], c[1]); o.w = pk2(c[2], c[3]);
                    *(u32x4*)(kn + (size_t)row * 512 + col) = o;
                }
            }
        } else if (it < N_Q + N_KN + N_VT) {
            const int i2 = it - N_Q - N_KN, rt = i2 & 3, ct = i2 >> 2, m0 = rt * 128, n0 = ct * 128;
            gemm_core((const bf16_t*)(ws + W_V) + (size_t)m0 * 256, 256, zm + (size_t)n0 * 672 + 384, 672, 256, acc, lds);
#pragma unroll
            for (int ni = 0; ni < 4; ++ni) {
                const int col = n0 + wc * 64 + ni * 16 + fq * 4; const f32x4 sc = *(const f32x4*)(rskv + col);
#pragma unroll
                for (int mi = 0; mi < 4; ++mi) {
                    const int row = m0 + wr * 64 + mi * 16 + fr; const f32x4 a = acc[mi][ni] * sc;
                    u32x2 o; o.x = pk2(a[0], a[1]); o.y = pk2(a[2], a[3]); *(u32x2*)(vt + (size_t)row * T_TOK + col) = o;
                }
            }
        } else {
            const int i2 = it - N_Q - N_KN - N_VT, which = i2 / N_L, i3 = i2 % N_L, rt = i3 >> 2, ct = i3 & 3, m0 = rt * 128, n0 = ct * 128;
            if (which == 0) {
                gemm_core(lin + (size_t)m0 * 256, 256, (const bf16_t*)(ws + W_W2) + (size_t)n0 * 64, 64, 64, acc, lds);
                const float* w0 = IN(11);
#pragma unroll
                for (int q = 0; q < 2; ++q) {
                    const int col = n0 + wc * 64 + q * 32 + fq * 8; const f32x4 w0a = *(const f32x4*)(w0 + col), w0b = *(const f32x4*)(w0 + col + 4);
#pragma unroll
                    for (int mi = 0; mi < 4; ++mi) {
                        const int row = m0 + wr * 64 + mi * 16 + fr; float o8[8];
#pragma unroll
                        for (int r = 0; r < 8; ++r) {
                            const float x = (r < 4 ? w0a[r & 3] : w0b[r & 3]) + (r < 4 ? acc[mi][2 * q][r & 3] : acc[mi][2 * q + 1][r & 3]);
                            const float e = 0.60653065971f * sigmoidf_(x);
                            o8[r] = e * (1.0f - e * (0.5f - e * (0.16666667f - e * (0.041666667f - e * (0.0083333333f - e * (0.0013888889f - e * 0.0001984127f))))));
                        }
                        *(u32x4*)(om + (size_t)row * 512 + col) = pack8(o8);
                    }
                }
            } else if (which == 1) {
                gemm_core(lin + (size_t)m0 * 256 + 64, 256, (const bf16_t*)(ws + W_A2) + (size_t)n0 * 64, 64, 64, acc, lds);
                const float* a0 = IN(13); const float* k_k = IN(16); const float* k_a = IN(17);
#pragma unroll
                for (int mi = 0; mi < 4; ++mi) {
                    const int row = m0 + wr * 64 + mi * 16 + fr;
                    float ksv[2][8], kkr[2][8], al[2][8]; float ss = 0.f;
#pragma unroll
                    for (int q = 0; q < 2; ++q) {
                        const int col = n0 + wc * 64 + q * 32 + fq * 8;
                        unpack8(*(const u32x4*)(ks + (size_t)row * 512 + col), ksv[q]);
                        const f32x4 a0a = *(const f32x4*)(a0 + col), a0b = *(const f32x4*)(a0 + col + 4), kka = *(const f32x4*)(k_k + col), kkb = *(const f32x4*)(k_k + col + 4);
#pragma unroll
                        for (int r = 0; r < 8; ++r) {
                            const float av = r < 4 ? acc[mi][2 * q][r & 3] : acc[mi][2 * q + 1][r & 3];
                            al[q][r] = sigmoidf_((r < 4 ? a0a[r & 3] : a0b[r & 3]) + av);
                            kkr[q][r] = ksv[q][r] * (r < 4 ? kka[r & 3] : kkb[r & 3]); ss += kkr[q][r] * kkr[q][r];
                        }
                    }
                    ss += __shfl_xor(ss, 16); ss += __shfl_xor(ss, 32);
                    const float inv = 1.0f / fmaxf(sqrtf(ss), 1e-12f);
#pragma unroll
                    for (int q = 0; q < 2; ++q) {
                        const int col = n0 + wc * 64 + q * 32 + fq * 8;
                        const f32x4 kaa = *(const f32x4*)(k_a + col), kab = *(const f32x4*)(k_a + col + 4);
                        float k1[8], b1[8], kp[8];
#pragma unroll
                        for (int r = 0; r < 8; ++r) { k1[r] = kkr[q][r] * inv; b1[r] = k1[r] * al[q][r]; kp[r] = ksv[q][r] * (1.0f + (al[q][r] - 1.0f) * (r < 4 ? kaa[r & 3] : kab[r & 3])); }
                        *(u32x4*)(kk + (size_t)row * 512 + col) = pack8(k1);
                        *(u32x4*)(bb + (size_t)row * 512 + col) = pack8(b1);
                        *(u32x4*)(ks + (size_t)row * 512 + col) = pack8(kp);
                    }
                }
            } else {
                gemm_core(lin + (size_t)m0 * 256 + 128, 256, (const bf16_t*)(ws + W_G2) + (size_t)n0 * 128, 128, 128, acc, lds);
#pragma unroll
                for (int mi = 0; mi < 4; ++mi) {
                    const int row = m0 + wr * 64 + mi * 16 + fr;
#pragma unroll
                    for (int q = 0; q < 2; ++q) {
                        const int col = n0 + wc * 64 + q * 32 + fq * 8; const f32x4 a = acc[mi][2 * q], c = acc[mi][2 * q + 1];
                        u32x4 o; o.x = pk2(a[0], a[1]); o.y = pk2(a[2], a[3]); o.z = pk2(c[0], c[1]); o.w = pk2(c[2], c[3]);
                        *(u32x4*)(gg + (size_t)row * 512 + col) = o;
                    }
                }
            }
        }
    }
}

struct HalfBar { unsigned addr; unsigned target; };
__device__ __forceinline__ void hb_sync(HalfBar& hb) {
    asm volatile("s_waitcnt lgkmcnt(0)" ::: "memory");
    hb.target += 4u;
    const int lane = threadIdx.x & 63;
    if (lane == 0) asm volatile("ds_add_u32 %0, %1" :: "v"(hb.addr), "v"(1u) : "memory");
    for (;;) {
        unsigned v;
        asm volatile("ds_read_b32 %0, %1\n\ts_waitcnt lgkmcnt(0)" : "=v"(v) : "v"(hb.addr) : "memory");
        if ((int)(__builtin_amdgcn_readfirstlane(v) - hb.target) >= 0) break;
        __builtin_amdgcn_s_sleep(1);
    }
    asm volatile("" ::: "memory");
}
#define SCAN_BAR() do { asm volatile("s_waitcnt lgkmcnt(0)" ::: "memory"); __builtin_amdgcn_s_barrier(); asm volatile("" ::: "memory"); } while (0)
constexpr int SCAN_CH = 32;
constexpr int SCAN_NBAR = 2 + (SEQ / SCAN_CH);
__device__ void scan_consumer(const Params& p, int si, unsigned char* lds) {
    unsigned char* ws = lnd(p.ws);
    const int chain = si >> 2, rg = si & 3, b = chain >> 3, h = chain & 7;
    const int tid = tidx(), w = tid >> 6, l = tid & 63, rowA = w * 4 + (l >> 4), kg = l & 15;
    const bf16_t* rs = (const bf16_t*)(ws + R_D); const bf16_t* ks = rs + (size_t)T_TOK * 512; const bf16_t* vs = ks + (size_t)T_TOK * 512;
    const bf16_t* kk = (const bf16_t*)(ws + R_C); const bf16_t* bb = kk + (size_t)T_TOK * 512; const bf16_t* om = bb + (size_t)T_TOK * 512;
    bf16_t* yo = (bf16_t*)(ws + R_I);
    float* ops = (float*)lds;
    float* vb = (float*)(lds + 81920);
    float* yb = (float*)(lds + 86016);
    const size_t tokb = (size_t)b * SEQ;
    const int lrem = tid & 127, lstep = lrem >> 3, lpart = lrem & 7, lhalf = tid >> 7;
    const bf16_t* sp0 = (lhalf ? om : kk) + (tokb + lstep) * 512 + h * 64 + lpart * 8;
    const bf16_t* sp1 = (lhalf ? ks : bb) + (tokb + lstep) * 512 + h * 64 + lpart * 8;
    const bf16_t* sp2 = rs + (tokb + lstep) * 512 + h * 64 + lpart * 8;
    const bf16_t* spv = vs + (tokb + ((tid & 31) >> 1)) * 512 + h * 64 + rg * 16 + (tid & 1) * 8;
    const int ldst0 = lstep * 320 + lhalf * 64 + lpart * 8, ldst1 = lstep * 320 + (2 + lhalf) * 64 + lpart * 8, ldst2 = lstep * 320 + 256 + lpart * 8;
    (void)sp0; (void)sp1; (void)sp2; (void)spv; (void)ldst0; (void)ldst1; (void)ldst2;
    constexpr int NCH = SEQ / SCAN_CH;
    const unsigned lds_ops = (unsigned)(size_t)(LAS unsigned char*)lds, lds_vb = lds_ops + 81920u, lds_yb = lds_ops + 86016u;
#define SC_RD(KK, DD, NB, K_, RR, VV, PA, PV, ST) do { \
        asm volatile("ds_read_b128 %0, %1 offset:%2" : "=v"(KK) : "v"(PA), "i"((ST) * 1280) : "memory"); \
        asm volatile("ds_read_b128 %0, %1 offset:%2" : "=v"(DD) : "v"(PA), "i"((ST) * 1280 + 256) : "memory"); \
        asm volatile("ds_read_b128 %0, %1 offset:%2" : "=v"(NB) : "v"(PA), "i"((ST) * 1280 + 512) : "memory"); \
        asm volatile("ds_read_b128 %0, %1 offset:%2" : "=v"(K_) : "v"(PA), "i"((ST) * 1280 + 768) : "memory"); \
        asm volatile("ds_read_b128 %0, %1 offset:%2" : "=v"(RR) : "v"(PA), "i"((ST) * 1280 + 1024) : "memory"); \
        asm volatile("ds_read_b32 %0, %1 offset:%2" : "=v"(VV) : "v"(PV), "i"((ST) * 64) : "memory"); } while (0)
#define SC_WAIT(N, KK, DD, NB, K_, RR, VV) asm volatile("s_waitcnt lgkmcnt(" #N ")" : "+v"(KK), "+v"(DD), "+v"(NB), "+v"(K_), "+v"(RR), "+v"(VV) :: "memory")
    typedef float f32x2 __attribute__((ext_vector_type(2)));
    f32x2 S01 = {0.f, 0.f}, S23 = {0.f, 0.f};
#define SC_STEP(ST, CKK, CD, CNB, CK, CR, CV, NKK, ND, NNB, NK, NR, NV, WN) do { \
        f32x2 u_ = {0.f, 0.f}; \
        if ((ST) > 0) { u_ = S01 * NR.xy; u_ = S23 * NR.zw + u_; } \
        if ((ST) < 31) SC_RD(NKK, ND, NNB, NK, NR, NV, pa, pv, (ST) + 1); \
        SC_WAIT(WN, CKK, CD, CNB, CK, CR, CV); \
        f32x2 t_ = S01 * CKK.xy; t_ = S23 * CKK.zw + t_; \
        float sa_ = t_.x + t_.y; \
        const f32x2 W01_ = S01 * CD.xy + CK.xy * CV, W23_ = S23 * CD.zw + CK.zw * CV; \
        float y_ = u_.x + u_.y; \
        sa_ += dppf<0x128>(sa_); sa_ += dppf<0x124>(sa_); \
        if ((ST) > 0) y_ += dppf<0x128>(y_); \
        sa_ += dppf<0x122>(sa_); sa_ += dppf<0x121>(sa_); \
        S01 = CNB.xy * sa_ + W01_; S23 = CNB.zw * sa_ + W23_; \
        if ((ST) > 0) asm volatile("ds_write_b32 %0, %1 offset:%2" :: "v"(pw), "v"(y_), "i"(((ST) > 0 ? (ST) - 1 : 0) * 512) : "memory"); } while (0)
    SCAN_BAR();
    SCAN_BAR();
    for (int c = 0; c < NCH; ++c) {
        const int buf = c & 1;
        const unsigned pa = lds_ops + (unsigned)(buf * 40960 + kg * 16), pv = lds_vb + (unsigned)(buf * 2048 + rowA * 4);
        const unsigned pw = lds_yb + (unsigned)(buf * 16384 + (rowA * 8 + (kg & 7)) * 4);
        f32x4 akk, ad, anb, ak, ar, bkk, bd, bnb, bk, br; float av, bv;
        SC_RD(akk, ad, anb, ak, ar, av, pa, pv, 0);
        SC_STEP(0, akk, ad, anb, ak, ar, av, bkk, bd, bnb, bk, br, bv, 6);
        SC_STEP(1, bkk, bd, bnb, bk, br, bv, akk, ad, anb, ak, ar, av, 6);
        SC_STEP(2, akk, ad, anb, ak, ar, av, bkk, bd, bnb, bk, br, bv, 7);
        SC_STEP(3, bkk, bd, bnb, bk, br, bv, akk, ad, anb, ak, ar, av, 7);
        SC_STEP(4, akk, ad, anb, ak, ar, av, bkk, bd, bnb, bk, br, bv, 7);
        SC_STEP(5, bkk, bd, bnb, bk, br, bv, akk, ad, anb, ak, ar, av, 7);
        SC_STEP(6, akk, ad, anb, ak, ar, av, bkk, bd, bnb, bk, br, bv, 7);
        SC_STEP(7, bkk, bd, bnb, bk, br, bv, akk, ad, anb, ak, ar, av, 7);
        SC_STEP(8, akk, ad, anb, ak, ar, av, bkk, bd, bnb, bk, br, bv, 7);
        SC_STEP(9, bkk, bd, bnb, bk, br, bv, akk, ad, anb, ak, ar, av, 7);
        SC_STEP(10, akk, ad, anb, ak, ar, av, bkk, bd, bnb, bk, br, bv, 7);
        SC_STEP(11, bkk, bd, bnb, bk, br, bv, akk, ad, anb, ak, ar, av, 7);
        SC_STEP(12, akk, ad, anb, ak, ar, av, bkk, bd, bnb, bk, br, bv, 7);
        SC_STEP(13, bkk, bd, bnb, bk, br, bv, akk, ad, anb, ak, ar, av, 7);
        SC_STEP(14, akk, ad, anb, ak, ar, av, bkk, bd, bnb, bk, br, bv, 7);
        SC_STEP(15, bkk, bd, bnb, bk, br, bv, akk, ad, anb, ak, ar, av, 7);
        SC_STEP(16, akk, ad, anb, ak, ar, av, bkk, bd, bnb, bk, br, bv, 7);
        SC_STEP(17, bkk, bd, bnb, bk, br, bv, akk, ad, anb, ak, ar, av, 7);
        SC_STEP(18, akk, ad, anb, ak, ar, av, bkk, bd, bnb, bk, br, bv, 7);
        SC_STEP(19, bkk, bd, bnb, bk, br, bv, akk, ad, anb, ak, ar, av, 7);
        SC_STEP(20, akk, ad, anb, ak, ar, av, bkk, bd, bnb, bk, br, bv, 7);
        SC_STEP(21, bkk, bd, bnb, bk, br, bv, akk, ad, anb, ak, ar, av, 7);
        SC_STEP(22, akk, ad, anb, ak, ar, av, bkk, bd, bnb, bk, br, bv, 7);
        SC_STEP(23, bkk, bd, bnb, bk, br, bv, akk, ad, anb, ak, ar, av, 7);
        SC_STEP(24, akk, ad, anb, ak, ar, av, bkk, bd, bnb, bk, br, bv, 7);
        SC_STEP(25, bkk, bd, bnb, bk, br, bv, akk, ad, anb, ak, ar, av, 7);
        SC_STEP(26, akk, ad, anb, ak, ar, av, bkk, bd, bnb, bk, br, bv, 7);
        SC_STEP(27, bkk, bd, bnb, bk, br, bv, akk, ad, anb, ak, ar, av, 7);
        SC_STEP(28, akk, ad, anb, ak, ar, av, bkk, bd, bnb, bk, br, bv, 7);
        SC_STEP(29, bkk, bd, bnb, bk, br, bv, akk, ad, anb, ak, ar, av, 7);
        SC_STEP(30, akk, ad, anb, ak, ar, av, bkk, bd, bnb, bk, br, bv, 7);
        SC_STEP(31, bkk, bd, bnb, bk, br, bv, akk, ad, anb, ak, ar, av, 1);
        {
            f32x2 u_ = S01 * br.xy; u_ = S23 * br.zw + u_;
            float y_ = u_.x + u_.y; y_ += dppf<0x128>(y_);
            asm volatile("ds_write_b32 %0, %1 offset:%2" :: "v"(pw), "v"(y_), "i"(31 * 512) : "memory");
        }
        asm volatile("s_waitcnt lgkmcnt(0)" ::: "memory");
        SCAN_BAR();
#pragma unroll
        for (int hh = 0; hh < 2; ++hh) {
            const int st = (tid >> 4) + 16 * hh, r = tid & 15;
            const float* yr = yb + buf * 4096 + st * 128 + r * 8;
            const f32x4 a0 = *(const f32x4*)(yr), a1 = *(const f32x4*)(yr + 4);
            const f32x4 sm = a0 + a1;
            const float y = (sm[0] + sm[1]) + (sm[2] + sm[3]);
            const unsigned short yv = (unsigned short)f2bf(y);
            const bf16_t* ya = yo + (tokb + (size_t)c * SCAN_CH + st) * 512 + h * 64 + rg * 16 + r;
            asm volatile("global_store_short %0, %1, off" :: "v"(ya), "v"((unsigned)yv) : "memory");
        }
    }
    asm volatile("s_waitcnt vmcnt(0)" ::: "memory");
}
__device__ void scan_producer(const Params& p, int si, unsigned char* lds) {
    unsigned char* ws = lnd(p.ws);
    const int chain = si >> 2, rg = si & 3, b = chain >> 3, h = chain & 7;
    const int tid = tidx(), w = tid >> 6, l = tid & 63, rowA = w * 4 + (l >> 4), kg = l & 15;
    const bf16_t* rs = (const bf16_t*)(ws + R_D); const bf16_t* ks = rs + (size_t)T_TOK * 512; const bf16_t* vs = ks + (size_t)T_TOK * 512;
    const bf16_t* kk = (const bf16_t*)(ws + R_C); const bf16_t* bb = kk + (size_t)T_TOK * 512; const bf16_t* om = bb + (size_t)T_TOK * 512;
    bf16_t* yo = (bf16_t*)(ws + R_I);
    float* ops = (float*)lds;
    float* vb = (float*)(lds + 81920);
    float* yb = (float*)(lds + 86016);
    const size_t tokb = (size_t)b * SEQ;
    const int lrem = tid & 127, lstep = lrem >> 3, lpart = lrem & 7, lhalf = tid >> 7;
    const bf16_t* sp0 = (lhalf ? om : kk) + (tokb + lstep) * 512 + h * 64 + lpart * 8;
    const bf16_t* sp1 = (lhalf ? ks : bb) + (tokb + lstep) * 512 + h * 64 + lpart * 8;
    const bf16_t* sp2 = rs + (tokb + lstep) * 512 + h * 64 + lpart * 8;
    const bf16_t* spv = vs + (tokb + ((tid & 31) >> 1)) * 512 + h * 64 + rg * 16 + (tid & 1) * 8;
    const int ldst0 = lstep * 320 + lhalf * 64 + lpart * 8, ldst1 = lstep * 320 + (2 + lhalf) * 64 + lpart * 8, ldst2 = lstep * 320 + 256 + lpart * 8;
    struct GSet { u32x4 g0, g1, g2, gv, h0, h1, h2, hv; };
    GSet RA, RB, RC;
    auto gload = [&](int c, GSet& R) {
        const size_t o = (size_t)c * SCAN_CH * 512 * 2, o2 = o + (size_t)16 * 512 * 2;
        const char* q0 = (const char*)sp0 + o; const char* q1 = (const char*)sp1 + o; const char* q2 = (const char*)sp2 + o; const char* q3 = (const char*)spv + o;
        const char* r0 = (const char*)sp0 + o2; const char* r1 = (const char*)sp1 + o2; const char* r2 = (const char*)sp2 + o2; const char* r3 = (const char*)spv + o2;
        asm volatile("global_load_dwordx4 %0, %1, off" : "=v"(R.g0) : "v"(q0) : "memory");
        asm volatile("global_load_dwordx4 %0, %1, off" : "=v"(R.g1) : "v"(q1) : "memory");
        asm volatile("global_load_dwordx4 %0, %1, off" : "=v"(R.g2) : "v"(q2) : "memory");
        asm volatile("global_load_dwordx4 %0, %1, off" : "=v"(R.gv) : "v"(q3) : "memory");
        asm volatile("global_load_dwordx4 %0, %1, off" : "=v"(R.h0) : "v"(r0) : "memory");
        asm volatile("global_load_dwordx4 %0, %1, off" : "=v"(R.h1) : "v"(r1) : "memory");
        asm volatile("global_load_dwordx4 %0, %1, off" : "=v"(R.h2) : "v"(r2) : "memory");
        asm volatile("global_load_dwordx4 %0, %1, off" : "=v"(R.hv) : "v"(r3) : "memory");
    };
    auto lstore1 = [&](int buf, int sub, const u32x4& x0, const u32x4& x1, const u32x4& x2, const u32x4& xv) {
        float f[8]; float* ob = ops + buf * 10240 + sub * 5120;
        unpack8(x0, f);
        if (lhalf) {
#pragma unroll
            for (int j = 0; j < 8; ++j) f[j] = 1.0f - f[j];
        }
        *(f32x4*)(ob + ldst0) = (f32x4){f[0], f[1], f[2], f[3]}; *(f32x4*)(ob + ldst0 + 4) = (f32x4){f[4], f[5], f[6], f[7]};
        unpack8(x1, f);
        if (!lhalf) {
#pragma unroll
            for (int j = 0; j < 8; ++j) f[j] = -f[j];
        }
        *(f32x4*)(ob + ldst1) = (f32x4){f[0], f[1], f[2], f[3]}; *(f32x4*)(ob + ldst1 + 4) = (f32x4){f[4], f[5], f[6], f[7]};
        if (tid < 128) { unpack8(x2, f); *(f32x4*)(ob + ldst2) = (f32x4){f[0], f[1], f[2], f[3]}; *(f32x4*)(ob + ldst2 + 4) = (f32x4){f[4], f[5], f[6], f[7]}; }
        if (tid < 32) { unpack8(xv, f); float* vd = vb + buf * 512 + sub * 256 + (tid >> 1) * 16 + (tid & 1) * 8;
            *(f32x4*)(vd) = (f32x4){f[0], f[1], f[2], f[3]}; *(f32x4*)(vd + 4) = (f32x4){f[4], f[5], f[6], f[7]}; }
    };
    auto lstore = [&](int buf, const GSet& R) { lstore1(buf, 0, R.g0, R.g1, R.g2, R.gv); lstore1(buf, 1, R.h0, R.h1, R.h2, R.hv); };
#define SC_VWAIT(N, R) asm volatile("s_waitcnt vmcnt(" #N ")" : "+v"(R.g0), "+v"(R.g1), "+v"(R.g2), "+v"(R.gv), "+v"(R.h0), "+v"(R.h1), "+v"(R.h2), "+v"(R.hv) :: "memory")
    constexpr int NCH = SEQ / SCAN_CH;
    (void)yo; (void)yb; (void)rowA; (void)kg;
    asm volatile("s_waitcnt vmcnt(0)" ::: "memory");
    SCAN_BAR();
    gload(0, RA); SC_VWAIT(0, RA); lstore(0, RA);
    gload(1, RB); gload(2, RC); gload(3, RA);
    SCAN_BAR();
    auto do_chunk = [&](int c, GSet& NX) {
        const int buf = c & 1;
        if (c + 1 < NCH) { SC_VWAIT(16, NX); lstore(buf ^ 1, NX); }
        SCAN_BAR();
        gload(c + 4 < NCH ? c + 4 : NCH - 1, NX);
    };
    for (int c = 0; c < NCH; c += 3) {
        do_chunk(c, RB);
        if (c + 1 < NCH) do_chunk(c + 1, RC);
        if (c + 2 < NCH) do_chunk(c + 2, RA);
    }
    asm volatile("s_waitcnt vmcnt(0)" ::: "memory");
}

__device__ __forceinline__ int pe_sw(int row) { return (0x78 >> (2 * ((row >> 2) & 3))) & 3; }
__device__ void attn_unit(const Params& p, int b, int h, int qblk, unsigned char* lds) {
    unsigned char* ws = lnd(p.ws);
    const bf16_t* Q = (const bf16_t*)(ws + R_A); const bf16_t* KN = (const bf16_t*)(ws + R_E); const bf16_t* VT = (const bf16_t*)(ws + R_F);
    const bf16_t* KP = (const bf16_t*)(ws + R_G); bf16_t* O = (bf16_t*)(ws + R_B);
    const int tid = tidx(), w = tid >> 6, l = tid & 63, fr = l & 15, g = l >> 4;
    const size_t tokb = (size_t)b * SEQ;
    const int q0 = qblk * 128 + w * 32;
    constexpr int BUFB = 21504, KP_OFF = 8192, VT_OFF = 12288;
    bf16x8 qf[2][3];
#pragma unroll
    for (int qi = 0; qi < 2; ++qi)
#pragma unroll
        for (int s = 0; s < 3; ++s) qf[qi][s] = *(const bf16x8*)(Q + (tokb + q0 + qi * 16 + fr) * 768 + h * 96 + s * 32 + g * 8);
    f32x4 o[4][2];
#pragma unroll
    for (int i = 0; i < 4; ++i) { o[i][0] = (f32x4){0.f, 0.f, 0.f, 0.f}; o[i][1] = (f32x4){0.f, 0.f, 0.f, 0.f}; }
    float mrun[2] = {-1e30f, -1e30f}, lsum[2] = {0.f, 0.f};
    const int ntiles = 2 * qblk + 2;
    const int kkey = tid >> 3, kkc = tid & 7;
    const int pkey = tid >> 2, pkc = tid & 3;
    const bf16_t* gkn = KN + (tokb + kkey) * 512 + h * 64 + kkc * 8;
    const bf16_t* gkp = KP + (tokb + pkey) * 32 + pkc * 8;
    const bf16_t* gvt = VT + ((size_t)h * 64 + kkey) * T_TOK + tokb + kkc * 8;
    const unsigned dkn = (unsigned)(kkey * 128 + ((kkc ^ (kkey & 7)) * 16));
    const unsigned dkp = (unsigned)(KP_OFF + pkey * 64 + ((pkc ^ pe_sw(pkey)) * 16));
    const unsigned dvt = (unsigned)(VT_OFF + kkey * 144 + kkc * 16);
    u32x4 rk0, rk1, rp, rv0, rv1;
    auto gload = [&](int kt) {
        rk0 = *(const u32x4*)(gkn + (size_t)kt * 64 * 512); rk1 = *(const u32x4*)(gkn + ((size_t)kt * 64 + 32) * 512);
        rp = *(const u32x4*)(gkp + (size_t)kt * 64 * 32);
        rv0 = *(const u32x4*)(gvt + kt * 64); rv1 = *(const u32x4*)(gvt + (size_t)32 * T_TOK + kt * 64);
    };
    auto lstore = [&](int buf) {
        unsigned char* d = lds + buf * BUFB;
        *(u32x4*)(d + dkn) = rk0; *(u32x4*)(d + dkn + 32 * 128) = rk1; *(u32x4*)(d + dkp) = rp;
        *(u32x4*)(d + dvt) = rv0; *(u32x4*)(d + dvt + 32 * 144) = rv1;
    };
    const unsigned kfo0 = (unsigned)(fr * 128 + (((0 + g) ^ (fr & 7)) * 16)), kfo1 = (unsigned)(fr * 128 + (((4 + g) ^ (fr & 7)) * 16));
    const unsigned kfo2 = (unsigned)(KP_OFF + fr * 64 + ((g ^ pe_sw(fr)) * 16));
    const unsigned vfo = (unsigned)(VT_OFF + fr * 144 + g * 8);
    __syncthreads();
    gload(0); lstore(0);
    __syncthreads();
    for (int kt = 0; kt < ntiles; ++kt) {
        const unsigned char* d = lds + (kt & 1) * BUFB;
        if (kt + 1 < ntiles) gload(kt + 1);
        f32x4 s_[4][2];
#pragma unroll
        for (int j = 0; j < 4; ++j) {
            const bf16x8 k0 = *(const bf16x8*)(d + kfo0 + j * 2048), k1 = *(const bf16x8*)(d + kfo1 + j * 2048), k2 = *(const bf16x8*)(d + kfo2 + j * 1024);
#pragma unroll
            for (int qi = 0; qi < 2; ++qi) {
                f32x4 a = {0.f, 0.f, 0.f, 0.f};
                a = __builtin_amdgcn_mfma_f32_16x16x32_bf16(k0, qf[qi][0], a, 0, 0, 0);
                a = __builtin_amdgcn_mfma_f32_16x16x32_bf16(k1, qf[qi][1], a, 0, 0, 0);
                a = __builtin_amdgcn_mfma_f32_16x16x32_bf16(k2, qf[qi][2], a, 0, 0, 0);
                s_[j][qi] = a;
            }
        }
        if (kt * 64 + 63 > q0) {
#pragma unroll
            for (int j = 0; j < 4; ++j)
#pragma unroll
                for (int qi = 0; qi < 2; ++qi)
#pragma unroll
                    for (int r = 0; r < 4; ++r) { const int key = kt * 64 + j * 16 + g * 4 + r, q = q0 + qi * 16 + fr; if (key > q) s_[j][qi][r] = -1e30f; }
        }
        bf16x8 pf[2][2];
#pragma unroll
        for (int qi = 0; qi < 2; ++qi) {
            float mx = -1e30f;
#pragma unroll
            for (int j = 0; j < 4; ++j) mx = fmaxf(mx, fmaxf(fmaxf(s_[j][qi][0], s_[j][qi][1]), fmaxf(s_[j][qi][2], s_[j][qi][3])));
            mx = fmaxf(mx, __shfl_xor(mx, 16)); mx = fmaxf(mx, __shfl_xor(mx, 32));
            const float mn = fmaxf(mrun[qi], mx);
            const float alpha = __builtin_amdgcn_exp2f(mrun[qi] - mn);
            mrun[qi] = mn;
            float psum = 0.f;
#pragma unroll
            for (int j = 0; j < 4; ++j)
#pragma unroll
                for (int r = 0; r < 4; ++r) { const float pv = __builtin_amdgcn_exp2f(s_[j][qi][r] - mn); s_[j][qi][r] = pv; psum += pv; }
            lsum[qi] = lsum[qi] * alpha + psum;
#pragma unroll
            for (int dt = 0; dt < 4; ++dt) o[dt][qi] = o[dt][qi] * alpha;
#pragma unroll
            for (int ksx = 0; ksx < 2; ++ksx) {
                u32x4 pw; pw.x = pk2(s_[2 * ksx][qi][0], s_[2 * ksx][qi][1]); pw.y = pk2(s_[2 * ksx][qi][2], s_[2 * ksx][qi][3]);
                pw.z = pk2(s_[2 * ksx + 1][qi][0], s_[2 * ksx + 1][qi][1]); pw.w = pk2(s_[2 * ksx + 1][qi][2], s_[2 * ksx + 1][qi][3]);
                pf[ksx][qi] = __builtin_bit_cast(bf16x8, pw);
            }
        }
#pragma unroll
        for (int ksx = 0; ksx < 2; ++ksx)
#pragma unroll
            for (int dt = 0; dt < 4; ++dt) {
                const u32x2 v0 = *(const u32x2*)(d + vfo + dt * 16 * 144 + ksx * 64), v1 = *(const u32x2*)(d + vfo + dt * 16 * 144 + ksx * 64 + 32);
                u32x4 vw; vw.x = v0.x; vw.y = v0.y; vw.z = v1.x; vw.w = v1.y;
                const bf16x8 vf = __builtin_bit_cast(bf16x8, vw);
                o[dt][0] = __builtin_amdgcn_mfma_f32_16x16x32_bf16(vf, pf[ksx][0], o[dt][0], 0, 0, 0);
                o[dt][1] = __builtin_amdgcn_mfma_f32_16x16x32_bf16(vf, pf[ksx][1], o[dt][1], 0, 0, 0);
            }
        if (kt + 1 < ntiles) lstore((kt + 1) & 1);
        __syncthreads();
    }
#pragma unroll
    for (int qi = 0; qi < 2; ++qi) {
        float lt = lsum[qi]; lt += __shfl_xor(lt, 16); lt += __shfl_xor(lt, 32);
        const float inv = 1.0f / lt;
        const size_t tok = tokb + q0 + qi * 16 + fr;
#pragma unroll
        for (int dt = 0; dt < 4; ++dt) {
            const f32x4 v = o[dt][qi] * inv;
            u32x2 ow; ow.x = pk2(v[0], v[1]); ow.y = pk2(v[2], v[3]);
            *(u32x2*)(O + tok * 512 + h * 64 + dt * 16 + g * 4) = ow;
        }
    }
}

__device__ void phase4(const Params& p, unsigned char* lds, int* s_item, int rep) {
    if (VHALF == 0) {
        for (int si = blockIdx.x; si < 128; si += gridDim.x) {
            __builtin_amdgcn_s_setprio(3);
            scan_consumer(p, si, lds);
            __builtin_amdgcn_s_setprio(0);
        }
    } else {
        for (int si = blockIdx.x; si < 128; si += gridDim.x) scan_producer(p, si, lds - 65536);
    }
    unsigned* queue = (unsigned*)(p.ws + OFF_QUEUE) + 512 * rep;
    const int myx = (int)(xb_xcc_id() & 7u);
    for (;;) {
        __syncthreads();
        if (threadIdx.x == 0) {
            int code = -1;
            for (int k = 0; k < 8; ++k) {
                const int xx = (myx + k) & 7;
                const unsigned it = atomicAdd(queue + xx * 16, 2u);
                if (it < 256u) { code = xx * 256 + (int)it; break; }
            }
            s_item[0] = code;
        }
        __syncthreads();
        const int code = s_item[0];
        if (code < 0) break;
        const int h = code >> 8, it = (code & 255) + VHALF;
        const int qblk = 63 - (it >> 2), b = it & 3;
        attn_unit(p, b, h, qblk, lds);
    }
}

__device__ void phase5(const Params& p) {
    unsigned char* ws = lnd(p.ws);
    const bf16_t* rs = (const bf16_t*)(ws + R_D); const bf16_t* ks = rs + (size_t)T_TOK * 512; const bf16_t* vs = ks + (size_t)T_TOK * 512;
    const bf16_t* yv = (const bf16_t*)(ws + R_I); const bf16_t* gg = (const bf16_t*)(ws + R_H);
    bf16_t* ybp = (bf16_t*)(ws + R_C);
    const float* lnw = IN(19); const float* lnb = IN(20); const float* rk = IN(18);
    const int l = tidx() & 63, gw = VB * 4 + (tidx() >> 6), nw = VG * 4;
    const int c0 = l * 8;
    float wv[8], bv[8], rkv[8];
    { const f32x4 a = *(const f32x4*)(lnw + c0), b = *(const f32x4*)(lnw + c0 + 4), c = *(const f32x4*)(lnb + c0), d = *(const f32x4*)(lnb + c0 + 4), e = *(const f32x4*)(rk + c0), f = *(const f32x4*)(rk + c0 + 4);
#pragma unroll
      for (int j = 0; j < 4; ++j) { wv[j] = a[j]; wv[j + 4] = b[j]; bv[j] = c[j]; bv[j + 4] = d[j]; rkv[j] = e[j]; rkv[j + 4] = f[j]; } }
    for (int tok = gw; tok < T_TOK; tok += nw) {
        const size_t off = (size_t)tok * 512 + c0;
        float y[8], r[8], k[8], v[8], g[8];
        unpack8(*(const u32x4*)(yv + off), y); unpack8(*(const u32x4*)(rs + off), r); unpack8(*(const u32x4*)(ks + off), k);
        unpack8(*(const u32x4*)(vs + off), v); unpack8(*(const u32x4*)(gg + off), g);
        float s = 0.f, bs = 0.f;
#pragma unroll
        for (int j = 0; j < 8; ++j) { s += y[j]; bs += r[j] * k[j] * rkv[j]; }
        s += __shfl_xor(s, 1); s += __shfl_xor(s, 2); s += __shfl_xor(s, 4);
        bs += __shfl_xor(bs, 1); bs += __shfl_xor(bs, 2); bs += __shfl_xor(bs, 4);
        const float mean = s * (1.0f / 64.0f);
        float q = 0.f;
#pragma unroll
        for (int j = 0; j < 8; ++j) { const float d = y[j] - mean; q += d * d; }
        q += __shfl_xor(q, 1); q += __shfl_xor(q, 2); q += __shfl_xor(q, 4);
        const float rstd = rsqrtf(q * (1.0f / 64.0f) + 64e-5f);
        float o[8];
#pragma unroll
        for (int j = 0; j < 8; ++j) o[j] = ((y[j] - mean) * rstd * wv[j] + bv[j] + bs * v[j]) * g[j];
        *(u32x4*)(ybp + off) = pack8(o);
    }
    rmsnorm_rows_bf16(IN(0), IN(3), (bf16_t*)(ws + R_A));
}

__device__ void phase6(const Params& p, unsigned char* lds8) {
    unsigned char* ws = lnd(p.ws); EPI8_IDS
    const bf16_t* h = (const bf16_t*)(ws + R_A); const bf16_t* ob = (const bf16_t*)(ws + R_B); const bf16_t* ybp = (const bf16_t*)(ws + R_C);
    const bf16_t* Wg = (const bf16_t*)(ws + W_IN) + (size_t)2464 * 1024;
    bf16_t* mo = (bf16_t*)(ws + R_D);
    bf16_t* gsc = (bf16_t*)(ws + R_C + 32 * MiB);
    for (int iter = 0, rt, ct; tile_map8(iter, 128, 4, rt, ct); ++iter) {
        const int m0 = rt * 256, n0 = ct * 256;
        const int row0 = m0 + wr * 128 + fr, col0 = n0 + wc * 64 + fq * 8;
        f32x4 acc[8][4];
#pragma unroll 1
        for (int pass = 0; pass < 2; ++pass) {
            gemm8(h + (size_t)m0 * 1024, 1024, Wg + (size_t)(pass * 1024 + n0) * 1024, 1024, 1024, acc, lds8);
#pragma unroll
            for (int mi = 0; mi < 8; ++mi) {
#pragma unroll
                for (int q = 0; q < 2; ++q) {
                    float v[8];
#pragma unroll
                    for (int r = 0; r < 4; ++r) { v[r] = sigmoidf_(acc[mi][2 * q][r]); v[4 + r] = sigmoidf_(acc[mi][2 * q + 1][r]); }
                    *(u32x4*)(gsc + (size_t)(row0 + mi * 16) * 1024 + col0 + q * 32) = pack8(v);
                }
            }
            if (pass == 0) gemm8(ob + (size_t)m0 * 512, 512, (const bf16_t*)(ws + W_OA) + (size_t)n0 * 512, 512, 512, acc, lds8);
            else gemm8(ybp + (size_t)m0 * 512, 512, (const bf16_t*)(ws + W_OB) + (size_t)n0 * 512, 512, 512, acc, lds8);
            {
                u32x4 gn[2], pn[2];
#pragma unroll
                for (int q = 0; q < 2; ++q) { gn[q] = *(const u32x4*)(gsc + (size_t)row0 * 1024 + col0 + q * 32); pn[q] = pass ? *(const u32x4*)(mo + (size_t)row0 * 1024 + col0 + q * 32) : (u32x4){0u, 0u, 0u, 0u}; }
#pragma unroll
                for (int mi = 0; mi < 8; ++mi) {
                    const int row = row0 + mi * 16;
                    u32x4 gc[2], pc[2];
#pragma unroll
                    for (int q = 0; q < 2; ++q) { gc[q] = gn[q]; pc[q] = pn[q]; }
                    if (mi < 7) {
#pragma unroll
                        for (int q = 0; q < 2; ++q) { gn[q] = *(const u32x4*)(gsc + (size_t)(row + 16) * 1024 + col0 + q * 32); pn[q] = pass ? *(const u32x4*)(mo + (size_t)(row + 16) * 1024 + col0 + q * 32) : (u32x4){0u, 0u, 0u, 0u}; }
                    }
#pragma unroll
                    for (int q = 0; q < 2; ++q) {
                        float g[8], pv[8], v[8];
                        unpack8(gc[q], g); unpack8(pc[q], pv);
#pragma unroll
                        for (int r = 0; r < 4; ++r) { v[r] = g[r] * acc[mi][2 * q][r] + pv[r]; v[4 + r] = g[4 + r] * acc[mi][2 * q + 1][r] + pv[4 + r]; }
                        *(u32x4*)(mo + (size_t)row * 1024 + col0 + q * 32) = pack8(v);
                    }
                }
            }
        }
    }
}

__device__ __forceinline__ void epi_residual8(const f32x4 (&acc)[8][4], int m0, int n0, const float* xin, float* xo, bf16_t* xb, float* ssq, const float* ss_in) {
    EPI8_IDS
    const int row0 = m0 + wr * 128 + fr, col0 = n0 + wc * 64 + fq * 8;
    f32x4 xn[4]; float sn = 0.f;
#pragma unroll
    for (int q = 0; q < 2; ++q) { xn[2 * q] = *(const f32x4*)(xin + (size_t)row0 * DM + col0 + q * 32); xn[2 * q + 1] = *(const f32x4*)(xin + (size_t)row0 * DM + col0 + q * 32 + 4); }
    if (ss_in) sn = ss_in[row0];
#pragma unroll
    for (int mi = 0; mi < 8; ++mi) {
        const int row = row0 + mi * 16;
        f32x4 xc[4]; const float sc_in = sn;
#pragma unroll
        for (int i = 0; i < 4; ++i) xc[i] = xn[i];
        if (mi < 7) {
#pragma unroll
            for (int q = 0; q < 2; ++q) { xn[2 * q] = *(const f32x4*)(xin + (size_t)(row + 16) * DM + col0 + q * 32); xn[2 * q + 1] = *(const f32x4*)(xin + (size_t)(row + 16) * DM + col0 + q * 32 + 4); }
            if (ss_in) sn = ss_in[row + 16];
        }
        float sc = 1.0f;
        if (ss_in) { const float r = rsqrtf(sc_in * (1.0f / DM) + RMS_EPS); sc = r * r; }
        float ss = 0.f;
#pragma unroll
        for (int q = 0; q < 2; ++q) {
            const int col = col0 + q * 32;
            const f32x4 v0 = xc[2 * q] + acc[mi][2 * q] * sc, v1 = xc[2 * q + 1] + acc[mi][2 * q + 1] * sc;
            *(f32x4*)(xo + (size_t)row * DM + col) = v0; *(f32x4*)(xo + (size_t)row * DM + col + 4) = v1;
            u32x4 o; o.x = pk2(v0[0], v0[1]); o.y = pk2(v0[2], v0[3]); o.z = pk2(v1[0], v1[1]); o.w = pk2(v1[2], v1[3]);
            *(u32x4*)(xb + (size_t)row * DM + col) = o;
            ss += (v0[0] * v0[0] + v0[1] * v0[1] + v0[2] * v0[2] + v0[3] * v0[3]) + (v1[0] * v1[0] + v1[1] * v1[1] + v1[2] * v1[2] + v1[3] * v1[3]);
        }
        ss += __shfl_xor(ss, 16); ss += __shfl_xor(ss, 32);
        if (fq == 0) atomicAdd(ssq + row, ss);
    }
}

__device__ void phase7(const Params& p, unsigned char* lds8) {
    unsigned char* ws = lnd(p.ws);
    const bf16_t* mo = (const bf16_t*)(ws + R_D);
    int rt, ct; bool have = tile_map8(0, 128, 4, rt, ct), pre = false;
    for (int iter = 0; have; ++iter) {
        const int m0 = rt * 256, n0 = ct * 256;
        int rt2 = 0, ct2 = 0; const bool have2 = tile_map8(iter + 1, 128, 4, rt2, ct2);
        f32x4 acc[8][4];
        gemm8(mo + (size_t)m0 * 1024, 1024, (const bf16_t*)(ws + W_OUT) + (size_t)n0 * 1024, 1024, 1024, acc, lds8, pre, have2 ? mo + (size_t)rt2 * 256 * 1024 : nullptr, have2 ? (const bf16_t*)(ws + W_OUT) + (size_t)ct2 * 256 * 1024 : nullptr);
        epi_residual8(acc, m0, n0, IN(0), lnd(p.out), (bf16_t*)(ws + R_A), (float*)(ws + OFF_SS1), nullptr);
        pre = have2; rt = rt2; ct = ct2; have = have2;
    }
}
__device__ void phase8(const Params& p, unsigned char* lds8) {
    unsigned char* ws = lnd(p.ws); EPI8_IDS
    const bf16_t* xb = (const bf16_t*)(ws + R_A); bf16_t* u = (bf16_t*)(ws + R_U);
    int rt, ct; bool have = tile_map8(0, 128, 16, rt, ct), pre = false;
    for (int iter = 0; have; ++iter) {
        const int m0 = rt * 256, n0 = ct * 256;
        int rt2 = 0, ct2 = 0; const bool have2 = tile_map8(iter + 1, 128, 16, rt2, ct2);
        f32x4 acc[8][4];
        gemm8(xb + (size_t)m0 * 1024, 1024, (const bf16_t*)(ws + W_UP) + (size_t)n0 * 1024, 1024, 1024, acc, lds8, pre, have2 ? xb + (size_t)rt2 * 256 * 1024 : nullptr, have2 ? (const bf16_t*)(ws + W_UP) + (size_t)ct2 * 256 * 1024 : nullptr);
#pragma unroll
        for (int mi = 0; mi < 8; ++mi) {
            const int row = m0 + wr * 128 + mi * 16 + fr;
#pragma unroll
            for (int q = 0; q < 2; ++q) {
                const int col = n0 + wc * 64 + q * 32 + fq * 8;
                float v[8];
#pragma unroll
                for (int r = 0; r < 4; ++r) { const float a = fmaxf(acc[mi][2 * q][r], 0.f), c = fmaxf(acc[mi][2 * q + 1][r], 0.f); v[r] = a * a; v[4 + r] = c * c; }
                *(u32x4*)(u + (size_t)row * 4096 + col) = pack8(v);
            }
        }
        pre = have2; rt = rt2; ct = ct2; have = have2;
    }
}
__device__ void phase9(const Params& p, unsigned char* lds8) {
    unsigned char* ws = lnd(p.ws);
    const bf16_t* u = (const bf16_t*)(ws + R_U);
    int rt, ct; bool have = tile_map8(0, 128, 4, rt, ct), pre = false;
    for (int iter = 0; have; ++iter) {
        const int m0 = rt * 256, n0 = ct * 256;
        int rt2 = 0, ct2 = 0; const bool have2 = tile_map8(iter + 1, 128, 4, rt2, ct2);
        f32x4 acc[8][4];
        gemm8(u + (size_t)m0 * 4096, 4096, (const bf16_t*)(ws + W_DN) + (size_t)n0 * 4096, 4096, 4096, acc, lds8, pre, have2 ? u + (size_t)rt2 * 256 * 4096 : nullptr, have2 ? (const bf16_t*)(ws + W_DN) + (size_t)ct2 * 256 * 4096 : nullptr);
        epi_residual8(acc, m0, n0, lnd(p.out), lnd(p.out), (bf16_t*)(ws + R_A), (float*)(ws + OFF_SS2), (const float*)(ws + OFF_SS1));
        pre = have2; rt = rt2; ct = ct2; have = have2;
    }
}
__device__ void phase10(const Params& p, unsigned char* lds8) {
    unsigned char* ws = lnd(p.ws); EPI8_IDS
    const bf16_t* xb = (const bf16_t*)(ws + R_A); const bf16_t* pb = (const bf16_t*)(ws + R_PB);
    const float* ss2 = (const float*)(ws + OFF_SS2);
    float* xo = lnd(p.out);
    bf16_t* ppb = (bf16_t*)(ws + R_B);
    for (int iter = 0, rt, ct; tile_map8(iter, 128, 4, rt, ct); ++iter) {
        const int m0 = rt * 256, n0 = ct * 256;
        const int row0 = m0 + wr * 128 + fr, col0 = n0 + wc * 64 + fq * 8;
        f32x4 acc[8][4];
        gemm8(pb + (size_t)m0 * 256, 256, (const bf16_t*)(ws + W_PP) + (size_t)n0 * 256, 256, 256, acc, lds8);
#pragma unroll
        for (int mi = 0; mi < 8; ++mi) {
#pragma unroll
            for (int q = 0; q < 2; ++q) {
                u32x4 o; o.x = pk2(acc[mi][2 * q][0], acc[mi][2 * q][1]); o.y = pk2(acc[mi][2 * q][2], acc[mi][2 * q][3]);
                o.z = pk2(acc[mi][2 * q + 1][0], acc[mi][2 * q + 1][1]); o.w = pk2(acc[mi][2 * q + 1][2], acc[mi][2 * q + 1][3]);
                *(u32x4*)(ppb + (size_t)(row0 + mi * 16) * 1024 + col0 + q * 32) = o;
            }
        }
        gemm8(xb + (size_t)m0 * 1024, 1024, (const bf16_t*)(ws + W_PG) + (size_t)n0 * 1024, 1024, 1024, acc, lds8);
        {
            f32x4 xn[4]; u32x4 pn[2]; float sn;
#pragma unroll
            for (int q = 0; q < 2; ++q) { xn[2 * q] = *(const f32x4*)(xo + (size_t)row0 * DM + col0 + q * 32); xn[2 * q + 1] = *(const f32x4*)(xo + (size_t)row0 * DM + col0 + q * 32 + 4);
                                          pn[q] = *(const u32x4*)(ppb + (size_t)row0 * 1024 + col0 + q * 32); }
            sn = ss2[row0];
#pragma unroll
            for (int mi = 0; mi < 8; ++mi) {
                const int row = row0 + mi * 16;
                f32x4 xc[4]; u32x4 pc[2]; const float rstd = rsqrtf(sn * (1.0f / DM) + RMS_EPS);
#pragma unroll
                for (int i = 0; i < 4; ++i) xc[i] = xn[i];
                pc[0] = pn[0]; pc[1] = pn[1];
                if (mi < 7) {
#pragma unroll
                    for (int q = 0; q < 2; ++q) { xn[2 * q] = *(const f32x4*)(xo + (size_t)(row + 16) * DM + col0 + q * 32); xn[2 * q + 1] = *(const f32x4*)(xo + (size_t)(row + 16) * DM + col0 + q * 32 + 4);
                                                  pn[q] = *(const u32x4*)(ppb + (size_t)(row + 16) * 1024 + col0 + q * 32); }
                    sn = ss2[row + 16];
                }
#pragma unroll
                for (int q = 0; q < 2; ++q) {
                    float pf[8]; unpack8(pc[q], pf);
                    f32x4 v0 = xc[2 * q], v1 = xc[2 * q + 1];
#pragma unroll
                    for (int r = 0; r < 4; ++r) { v0[r] += sigmoidf_(acc[mi][2 * q][r] * rstd) * pf[r]; v1[r] += sigmoidf_(acc[mi][2 * q + 1][r] * rstd) * pf[4 + r]; }
                    *(f32x4*)(xo + (size_t)row * DM + col0 + q * 32) = v0; *(f32x4*)(xo + (size_t)row * DM + col0 + q * 32 + 4) = v1;
                }
            }
        }
    }
}
__device__ void phase11(const Params& p) {
    float* x = lnd(p.out); const float* g = IN(29);
    const int l = tidx() & 63, gw = VB * 4 + (tidx() >> 6), nw = VG * 4;
    for (int row = gw; row < T_TOK; row += nw) {
        float* xr = x + (size_t)row * DM;
        f32x4 v[4]; float ss = 0.f;
#pragma unroll
        for (int i = 0; i < 4; ++i) { v[i] = *(const f32x4*)(xr + i * 256 + l * 4); ss += v[i][0] * v[i][0] + v[i][1] * v[i][1] + v[i][2] * v[i][2] + v[i][3] * v[i][3]; }
        ss = wave_sum(ss);
        const float rs = rsqrtf(ss * (1.0f / DM) + RMS_EPS);
#pragma unroll
        for (int i = 0; i < 4; ++i) { const f32x4 gg = *(const f32x4*)(g + i * 256 + l * 4); *(f32x4*)(xr + i * 256 + l * 4) = v[i] * rs * gg; }
    }
}

extern __shared__ __attribute__((aligned(16))) unsigned char dyn_lds[];
constexpr int DYN_LDS = 131072;
__global__ void __launch_bounds__(512, 2) mega(Params p) {
    unsigned char* lds = dyn_lds + VHALF * 65536;
    __shared__ uint4 xbw;
    __shared__ int s_item[2];
    const bool single = (p.ph_hi - p.ph_lo) > 1;
    if (threadIdx.x == 0) xbw = make_uint4(0u, 0u, 0u, 0u);
    __syncthreads();
    XcdBarrier xb; xb.bar = (unsigned*)(p.ws + OFF_BAR); xb.x = 0; xb.st = (volatile LAS unsigned*)&xbw;
    if (single) xb = xcd_barrier_post((unsigned*)(p.ws + OFF_BAR), (volatile LAS unsigned*)&xbw);
    if (p.ph_lo < 0) cg::this_grid().sync();
#ifndef PROBE_MASK
#define PROBE_MASK 0
#endif
#ifndef PROBE_DUP
#define PROBE_DUP -1
#endif
    for (int ph = p.ph_lo; ph < p.ph_hi; ++ph)
    for (int rep = 0; rep < ((ph == PROBE_DUP || ((PROBE_MASK >> ph) & 1)) ? 2 : 1); ++rep) {
#ifndef ONLY_PH
#define ONLY_PH -1
#endif
#ifndef SKIP_PH
#define SKIP_PH -1
#endif
#define RUNPH(k, call) if ((ONLY_PH < 0 || ONLY_PH == k) && SKIP_PH != k && ph == k) { call; }
        RUNPH(0, phase0(p)) RUNPH(1, phase1(p, dyn_lds)) RUNPH(2, phase2(p)) RUNPH(3, phase3(p, lds)) RUNPH(4, phase4(p, lds, s_item, rep)) RUNPH(5, phase5(p))
        RUNPH(6, phase6(p, dyn_lds)) RUNPH(7, phase7(p, dyn_lds)) RUNPH(8, phase8(p, dyn_lds)) RUNPH(9, phase9(p, dyn_lds)) RUNPH(10, phase10(p, dyn_lds)) RUNPH(11, phase11(p))
        if (ph + 1 < p.ph_hi || rep == 0) xcd_barrier(xb);
    }
}

extern "C" void kernel_launch(void* const* d_in, const int* in_sizes, int n_in, void* d_out, int out_size, void* d_ws, size_t ws_size, hipStream_t stream) {
    static int grid_blocks = 0;
    if (!grid_blocks) {
        int dev = 0, cus = 0, per_cu = 0;
        hipGetDevice(&dev);
        hipDeviceGetAttribute(&cus, hipDeviceAttributeMultiprocessorCount, dev);
        hipFuncSetAttribute((const void*)mega, hipFuncAttributeMaxDynamicSharedMemorySize, DYN_LDS);
        hipOccupancyMaxActiveBlocksPerMultiprocessor(&per_cu, mega, 512, DYN_LDS);
        if (per_cu > 1) per_cu = 1;
        if (per_cu < 1) per_cu = 1;
        grid_blocks = cus * per_cu;
    }
    if (ws_size < WS_NEED) { fprintf(stderr, "workspace too small: %zu < %zu\n", ws_size, (size_t)WS_NEED); return; }
    Params p{};
    for (int i = 0; i < 30; ++i) p.in[i] = (const float*)d_in[i];
    p.out = (float*)d_out; p.ws = (unsigned char*)d_ws;
    hipMemsetAsync(d_ws, 0, ZERO_BYTES, stream);
#if MK_MULTI
    for (int ph = 0; ph < NPH; ++ph) { p.ph_lo = ph; p.ph_hi = ph + 1; hipLaunchKernelGGL(mega, dim3(grid_blocks), dim3(512), DYN_LDS, stream, p); }
#else
    p.ph_lo = 0; p.ph_hi = NPH;
    void* args[] = {&p};
    hipError_t e = hipLaunchCooperativeKernel((void*)mega, dim3(grid_blocks), dim3(512), args, DYN_LDS, stream);
    if (e != hipSuccess) fprintf(stderr, "cooperative launch failed: %s (grid %d)\n", hipGetErrorString(e), grid_blocks);
#endif
}
```

```cpp
#include <hip/hip_runtime.h>
#include <hip/hip_cooperative_groups.h>
#include <stdint.h>
#include <stdio.h>
namespace cg = cooperative_groups;

#ifndef MK_MULTI
#define MK_MULTI 0
#endif

typedef unsigned short bf16_t;
typedef short bf16x8 __attribute__((ext_vector_type(8)));
typedef float f32x4 __attribute__((ext_vector_type(4)));
typedef unsigned u32x4 __attribute__((ext_vector_type(4)));
typedef unsigned u32x2 __attribute__((ext_vector_type(2)));
#define LAS __attribute__((address_space(3)))

constexpr int T_TOK = 32768, SEQ = 8192, DM = 1024;
constexpr int NPH = 12;
constexpr float RMS_EPS = 1e-6f;
constexpr float QSCALE = 0.10206207261596577f * 1.4426950408889634f;

constexpr size_t MiB = 1ull << 20;
constexpr size_t OFF_BAR = 0, OFF_QUEUE = 16384, ZERO_BYTES = 32768;
constexpr size_t OFF_SS1 = 65536, OFF_SS2 = OFF_SS1 + 131072, OFF_RSQ = OFF_SS2 + 131072, OFF_RSKV = OFF_RSQ + 131072;
constexpr size_t OFF_CS = 1 * MiB;
constexpr size_t OFF_W = 5 * MiB;
constexpr size_t W_IN = OFF_W;
constexpr size_t W_UQ = W_IN + 4608ull * 1024 * 2;
constexpr size_t W_KN = W_UQ + 768ull * 384 * 2;
constexpr size_t W_V = W_KN + 512ull * 256 * 2;
constexpr size_t W_OA = W_V + 512ull * 256 * 2;
constexpr size_t W_W2 = W_OA + 1024ull * 512 * 2;
constexpr size_t W_A2 = W_W2 + 512ull * 64 * 2;
constexpr size_t W_G2 = W_A2 + 512ull * 64 * 2;
constexpr size_t W_OB = W_G2 + 512ull * 128 * 2;
constexpr size_t W_OUT = W_OB + 1024ull * 512 * 2;
constexpr size_t W_UP = W_OUT + 1024ull * 1024 * 2;
constexpr size_t W_DN = W_UP + 4096ull * 1024 * 2;
constexpr size_t W_PG = W_DN + 4096ull * 1024 * 2;
constexpr size_t W_PP = W_PG + 1024ull * 1024 * 2;
constexpr size_t W_END = W_PP + 1024ull * 256 * 2;
static_assert(W_END <= 42 * MiB, "weights region");
constexpr size_t R_A = 42 * MiB;
constexpr size_t R_B = 106 * MiB;
constexpr size_t R_C = 148 * MiB;
constexpr size_t R_D = 260 * MiB;
constexpr size_t R_E = 356 * MiB;
constexpr size_t R_F = 388 * MiB;
constexpr size_t R_G = 420 * MiB;
constexpr size_t R_H = 422 * MiB;
constexpr size_t R_I = 454 * MiB;
constexpr size_t R_PB = 486 * MiB;
constexpr size_t WS_NEED = 502 * MiB;
constexpr size_t R_U = R_B;

struct Params {
    const float* in[30];
    float* out;
    unsigned char* ws;
    int ph_lo, ph_hi;
};

#define GAS __attribute__((address_space(1)))
template <class T> __device__ __forceinline__ T* lnd(T* q) { GAS T* g = (GAS T*)q; asm volatile("" : "+s"(g)); return (T*)g; }
#define IN(k) lnd(p.in[k])
#define VHALF ((int)__builtin_amdgcn_readfirstlane((int)(threadIdx.x >> 8)))
#define VB ((int)blockIdx.x * 2 + VHALF)
#define VG ((int)gridDim.x * 2)
__device__ __forceinline__ int tidx512() { int t = threadIdx.x; asm volatile("" : "+v"(t)); return t; }
__device__ __forceinline__ int tidx() { int t = threadIdx.x & 255; asm volatile("" : "+v"(t)); return t; }
__device__ __forceinline__ unsigned f2bf(float f) { unsigned u = __float_as_uint(f); return (u + 0x7fffu + ((u >> 16) & 1u)) >> 16; }
typedef float f32x2_t __attribute__((ext_vector_type(2)));
typedef __bf16 bf16x2_t __attribute__((ext_vector_type(2)));
__device__ __forceinline__ unsigned pk2(float lo, float hi) { f32x2_t v = {lo, hi}; bf16x2_t b = __builtin_convertvector(v, bf16x2_t); return __builtin_bit_cast(unsigned, b); }
__device__ __forceinline__ float bflo(unsigned w) { return __uint_as_float(w << 16); }
__device__ __forceinline__ float bfhi(unsigned w) { return __uint_as_float(w & 0xffff0000u); }
__device__ __forceinline__ float bf1(bf16_t v) { return __uint_as_float((unsigned)v << 16); }
__device__ __forceinline__ void unpack8(const u32x4 w, float (&f)[8]) {
    f[0] = bflo(w.x); f[1] = bfhi(w.x); f[2] = bflo(w.y); f[3] = bfhi(w.y); f[4] = bflo(w.z); f[5] = bfhi(w.z); f[6] = bflo(w.w); f[7] = bfhi(w.w);
}
__device__ __forceinline__ u32x4 pack8(const float (&f)[8]) { u32x4 w; w.x = pk2(f[0], f[1]); w.y = pk2(f[2], f[3]); w.z = pk2(f[4], f[5]); w.w = pk2(f[6], f[7]); return w; }
__device__ __forceinline__ float sigmoidf_(float x) { return __builtin_amdgcn_rcpf(1.0f + __expf(-x)); }
__device__ __forceinline__ float wave_sum(float v) {
#pragma unroll
    for (int o = 32; o >= 1; o >>= 1) v += __shfl_xor(v, o);
    return v;
}
template <int CTRL> __device__ __forceinline__ float dppf(float v) {
    return __int_as_float(__builtin_amdgcn_update_dpp(0, __float_as_int(v), CTRL, 0xf, 0xf, false));
}
__device__ __forceinline__ float row16_sum(float v) {
    v += dppf<0x128>(v); v += dppf<0x124>(v); v += dppf<0x122>(v); v += dppf<0x121>(v); return v;
}

#define XB_TMO      128
#define XB_XCNT(j)  (256  + 64 * (j))
#define XB_XSUB(j)  (1280 + 64 * (j))
#define XB_XGEN(j)  (2304 + 64 * (j))
#define XB_TOP      3328
#define XB_TOPGEN   3392
#define XCD_BAR_WORDS 3456
#define XB_SPIN_CAP (1u << 22)
__device__ __forceinline__ unsigned xb_ld(unsigned* p) { return __hip_atomic_load(p, __ATOMIC_RELAXED, __HIP_MEMORY_SCOPE_AGENT); }
__device__ __forceinline__ unsigned xb_add(unsigned* p, unsigned v) { return __hip_atomic_fetch_add(p, v, __ATOMIC_RELAXED, __HIP_MEMORY_SCOPE_AGENT); }
__device__ __forceinline__ unsigned xb_xcc_id() { return (unsigned)__builtin_amdgcn_s_getreg((3 << 11) | 20) & 0xFu; }
#define XB_SPIN(cond, bar) do { unsigned _sp = 0; while (cond) { __builtin_amdgcn_s_sleep(1); \
    if ((++_sp & 255u) == 0u) { if (xb_ld(&(bar)[XB_TMO])) break; if (_sp > XB_SPIN_CAP) { atomicAdd(&(bar)[XB_TMO], 1u); break; } } } } while (0)
struct XcdBarrier { unsigned* bar; unsigned x; volatile LAS unsigned* st; };
__device__ __forceinline__ XcdBarrier xcd_barrier_post(unsigned* bar, volatile LAS unsigned* st) {
    XcdBarrier b; b.bar = bar; b.x = xb_xcc_id(); b.st = st;
    if (threadIdx.x == 0) (void)xb_add(&bar[XB_XCNT(b.x)], 1u);
    return b;
}
__device__ __forceinline__ void xcd_barrier_complete(unsigned* bar, unsigned x, unsigned& nloc, unsigned& nx) {
    const unsigned G = gridDim.x * gridDim.y * gridDim.z;
    unsigned sum, cnt, mine, sp = 0u;
    for (;;) {
        sum = 0u; cnt = 0u; mine = 0u;
#pragma unroll
        for (unsigned j = 0; j < 16; ++j) { const unsigned c = xb_ld(&bar[XB_XCNT(j)]); sum += c; cnt += (c > 0u) ? 1u : 0u; mine = (j == x) ? c : mine; }
        if (sum == G) break;
        __builtin_amdgcn_s_sleep(1);
        if ((++sp & 255u) == 0u) { if (xb_ld(&bar[XB_TMO])) break; if (sp > XB_SPIN_CAP) { atomicAdd(&bar[XB_TMO], 1u); break; } }
    }
    nloc = mine > 0u ? mine : 1u; nx = cnt > 0u ? cnt : 1u;
}
__device__ __forceinline__ void xcd_barrier(const XcdBarrier& b) {
    asm volatile("s_waitcnt vmcnt(0)" ::: "memory");
    __syncthreads();
    if (threadIdx.x == 0) {
        unsigned* bar = b.bar;
        __builtin_amdgcn_s_waitcnt(0);
        unsigned nloc = b.st[0], nx = b.st[1];
        if (nloc == 0u) { xcd_barrier_complete(bar, b.x, nloc, nx); b.st[0] = nloc; b.st[1] = nx; }
        const unsigned old = xb_add(&bar[XB_XSUB(b.x)], 1u);
        const unsigned gen = old / nloc;
        if (old + 1u == (gen + 1u) * nloc) {
            __builtin_amdgcn_fence(__ATOMIC_RELEASE, "agent");
            asm volatile("s_waitcnt vmcnt(0)" ::: "memory");
            const unsigned og = xb_add(&bar[XB_TOP], 1u);
            const unsigned tg = og / nx;
            if (og + 1u == (tg + 1u) * nx) xb_add(&bar[XB_TOPGEN], 1u);
            else XB_SPIN(xb_ld(&bar[XB_TOPGEN]) == tg, bar);
            __builtin_amdgcn_fence(__ATOMIC_ACQUIRE, "agent");
            xb_add(&bar[XB_XGEN(b.x)], 1u);
            asm volatile("s_waitcnt vmcnt(0)" ::: "memory");
        } else {
            XB_SPIN(xb_ld(&bar[XB_XGEN(b.x)]) == gen, bar);
            __builtin_amdgcn_fence(__ATOMIC_ACQUIRE, "agent");
            asm volatile("s_waitcnt vmcnt(0)" ::: "memory");
        }
    }
    __syncthreads();
}

__device__ __forceinline__ int sw64(int row) { return (0x78 >> (2 * ((row >> 2) & 3))) & 3; }
__device__ __forceinline__ void gemm_core(const bf16_t* A, int lda, const bf16_t* Bt, int ldb, int K, f32x4 (&acc)[4][4], unsigned char* lds) {
    const int tid = tidx(), l = tid & 63, w = __builtin_amdgcn_readfirstlane(tid >> 6), wr = w >> 1, wc = w & 1, fr = l & 15, fq = l >> 4;
#pragma unroll
    for (int i = 0; i < 4; ++i)
#pragma unroll
        for (int j = 0; j < 4; ++j) acc[i][j] = (f32x4){0.f, 0.f, 0.f, 0.f};
    const int nk = K >> 5;
    const int rin = l >> 2, skc = (l & 3) ^ sw64(rin);
    const bf16_t* ga = A + (size_t)(w * 32 + rin) * lda + skc * 8;
    const bf16_t* gb = Bt + (size_t)(w * 32 + rin) * ldb + skc * 8;
    LAS unsigned char* L = (LAS unsigned char*)lds + w * 2048;
    const unsigned aoff = (unsigned)((wr * 64 + fr) * 64 + ((fq ^ sw64(fr)) * 16)), boff = (unsigned)(8192 + (wc * 64 + fr) * 64 + ((fq ^ sw64(fr)) * 16));
#define GC_ISSUE(kt_) do { LAS unsigned char* Ld_ = L + ((kt_) & 3) * 16384; \
        __builtin_amdgcn_global_load_lds((const unsigned*)(ga + (kt_) * 32), (LAS unsigned*)(Ld_), 16, 0, 0); \
        __builtin_amdgcn_global_load_lds((const unsigned*)(ga + (size_t)16 * lda + (kt_) * 32), (LAS unsigned*)(Ld_ + 1024), 16, 0, 0); \
        __builtin_amdgcn_global_load_lds((const unsigned*)(gb + (kt_) * 32), (LAS unsigned*)(Ld_ + 8192), 16, 0, 0); \
        __builtin_amdgcn_global_load_lds((const unsigned*)(gb + (size_t)16 * ldb + (kt_) * 32), (LAS unsigned*)(Ld_ + 8192 + 1024), 16, 0, 0); } while (0)
    const unsigned lbase = (unsigned)(size_t)(LAS unsigned char*)lds;
    asm volatile("s_waitcnt vmcnt(0)" ::: "memory");
    __syncthreads();
    GC_ISSUE(0);
    if (nk > 1) GC_ISSUE(1);
    if (nk > 2) GC_ISSUE(2);
#define GC_RD(dst, addr, OFF) asm volatile("ds_read_b128 %0, %1 offset:" #OFF : "=v"(dst) : "v"(addr) : "memory")
    for (int kt = 0; kt < nk; ++kt) {
        if (kt + 2 < nk) asm volatile("s_waitcnt vmcnt(8)" ::: "memory");
        else if (kt + 1 < nk) asm volatile("s_waitcnt vmcnt(4)" ::: "memory");
        else asm volatile("s_waitcnt vmcnt(0)" ::: "memory");
        __builtin_amdgcn_s_barrier();
        asm volatile("" ::: "memory");
        if (kt + 3 < nk) GC_ISSUE(kt + 3);
        const unsigned sa = lbase + (unsigned)((kt & 3) * 16384) + aoff, sb = lbase + (unsigned)((kt & 3) * 16384) + boff;
        bf16x8 a0, a1, a2, a3, b0, b1, b2, b3;
        GC_RD(a0, sa, 0); GC_RD(b0, sb, 0); GC_RD(a1, sa, 1024); GC_RD(b1, sb, 1024);
        GC_RD(a2, sa, 2048); GC_RD(b2, sb, 2048); GC_RD(a3, sa, 3072); GC_RD(b3, sb, 3072);
#define GC_MMA(mi, ni, A_, B_) acc[mi][ni] = __builtin_amdgcn_mfma_f32_16x16x32_bf16(B_, A_, acc[mi][ni], 0, 0, 0)
        asm volatile("s_waitcnt lgkmcnt(4)" : "+v"(a0), "+v"(a1), "+v"(b0), "+v"(b1) :: "memory");
        GC_MMA(0, 0, a0, b0); GC_MMA(0, 1, a0, b1); GC_MMA(1, 0, a1, b0); GC_MMA(1, 1, a1, b1);
        asm volatile("s_waitcnt lgkmcnt(2)" : "+v"(a2), "+v"(b2) :: "memory");
        GC_MMA(0, 2, a0, b2); GC_MMA(1, 2, a1, b2); GC_MMA(2, 0, a2, b0); GC_MMA(2, 1, a2, b1); GC_MMA(2, 2, a2, b2);
        asm volatile("s_waitcnt lgkmcnt(0)" : "+v"(a3), "+v"(b3) :: "memory");
        GC_MMA(0, 3, a0, b3); GC_MMA(1, 3, a1, b3); GC_MMA(2, 3, a2, b3); GC_MMA(3, 0, a3, b0); GC_MMA(3, 1, a3, b1); GC_MMA(3, 2, a3, b2); GC_MMA(3, 3, a3, b3);
    }
    __syncthreads();
}
__device__ __forceinline__ bool tile_map(int iter, int MT, int NT, int& rt, int& ct) {
    const int G = gridDim.x;
    if ((G & 7) == 0 && (MT & 63) == 0) {
        const int x = blockIdx.x & 7, lb = (blockIdx.x >> 3) * 2 + VHALF, nlb = (G >> 3) * 2, MTx = MT >> 3;
        const int li = lb + iter * nlb;
        if (li >= MTx * NT) return false;
        const int per = 8 * NT, rg = li / per, r = li - rg * per;
        ct = r >> 3; rt = x * MTx + rg * 8 + (r & 7);
        return true;
    }
    const int it = VB + iter * VG;
    if (it >= MT * NT) return false;
    rt = it / NT; ct = it - rt * NT; return true;
}
__device__ __forceinline__ void gemm8(const bf16_t* A, int lda, const bf16_t* Bt, int ldb, int K, f32x4 (&acc)[8][4], unsigned char* lds) {
    const int tid = tidx512(), l = tid & 63, w = __builtin_amdgcn_readfirstlane(tid >> 6), wr = w >> 2, wc = w & 3, fr = l & 15, fq = l >> 4;
#pragma unroll
    for (int i = 0; i < 8; ++i)
#pragma unroll
        for (int j = 0; j < 4; ++j) acc[i][j] = (f32x4){0.f, 0.f, 0.f, 0.f};
    const int nk = K >> 6;
    const int rin = l >> 3, skc = (l & 7) ^ (rin & 7);
    const bf16_t* ga = A + (size_t)(w * 32 + rin) * lda + skc * 8;
    const bf16_t* gb = Bt + (size_t)(w * 32 + rin) * ldb + skc * 8;
    LAS unsigned char* L = (LAS unsigned char*)lds + w * 4096;
#define G8_ISSUE(kt_) do { LAS unsigned char* Ld_ = L + ((kt_) & 1) * 65536; \
        __builtin_amdgcn_global_load_lds((const unsigned*)(ga + (kt_) * 64), (LAS unsigned*)(Ld_), 16, 0, 0); \
        __builtin_amdgcn_global_load_lds((const unsigned*)(ga + (size_t)8 * lda + (kt_) * 64), (LAS unsigned*)(Ld_ + 1024), 16, 0, 0); \
        __builtin_amdgcn_global_load_lds((const unsigned*)(ga + (size_t)16 * lda + (kt_) * 64), (LAS unsigned*)(Ld_ + 2048), 16, 0, 0); \
        __builtin_amdgcn_global_load_lds((const unsigned*)(ga + (size_t)24 * lda + (kt_) * 64), (LAS unsigned*)(Ld_ + 3072), 16, 0, 0); \
        __builtin_amdgcn_global_load_lds((const unsigned*)(gb + (kt_) * 64), (LAS unsigned*)(Ld_ + 32768), 16, 0, 0); \
        __builtin_amdgcn_global_load_lds((const unsigned*)(gb + (size_t)8 * ldb + (kt_) * 64), (LAS unsigned*)(Ld_ + 32768 + 1024), 16, 0, 0); \
        __builtin_amdgcn_global_load_lds((const unsigned*)(gb + (size_t)16 * ldb + (kt_) * 64), (LAS unsigned*)(Ld_ + 32768 + 2048), 16, 0, 0); \
        __builtin_amdgcn_global_load_lds((const unsigned*)(gb + (size_t)24 * ldb + (kt_) * 64), (LAS unsigned*)(Ld_ + 32768 + 3072), 16, 0, 0); } while (0)
    const unsigned lbase = (unsigned)(size_t)(LAS unsigned char*)lds;
    const unsigned arow = (unsigned)((wr * 128 + fr) * 128), brow = (unsigned)(32768 + (wc * 64 + fr) * 128);
    const unsigned sw0 = (unsigned)(((0 + fq) ^ (fr & 7)) * 16), sw1 = (unsigned)(((4 + fq) ^ (fr & 7)) * 16);
    asm volatile("s_waitcnt vmcnt(0)" ::: "memory");
    __syncthreads();
    G8_ISSUE(0);
#define G8_MMA(mi, ni, A_, B_) acc[mi][ni] = __builtin_amdgcn_mfma_f32_16x16x32_bf16(B_, A_, acc[mi][ni], 0, 0, 0)
#define G8_HALF(sa, sb, F1, F2, F3, F4) do { \
        bf16x8 a0, a1, a2, a3, b0, b1, b2, b3, c0, c1, c2, c3; \
        GC_RD(b0, sb, 0); GC_RD(b1, sb, 2048); GC_RD(b2, sb, 4096); GC_RD(b3, sb, 6144); \
        GC_RD(a0, sa, 0); GC_RD(a1, sa, 2048); GC_RD(a2, sa, 4096); GC_RD(a3, sa, 6144); \
        asm volatile("s_waitcnt lgkmcnt(2)" : "+v"(b0), "+v"(b1), "+v"(b2), "+v"(b3), "+v"(a0), "+v"(a1) :: "memory"); \
        G8_MMA(0, 0, a0, b0); G8_MMA(0, 1, a0, b1); G8_MMA(0, 2, a0, b2); G8_MMA(0, 3, a0, b3); \
        G8_MMA(1, 0, a1, b0); G8_MMA(1, 1, a1, b1); G8_MMA(1, 2, a1, b2); G8_MMA(1, 3, a1, b3); \
        F1; \
        asm volatile("s_waitcnt lgkmcnt(0)" : "+v"(a2), "+v"(a3) :: "memory"); \
        G8_MMA(2, 0, a2, b0); G8_MMA(2, 1, a2, b1); G8_MMA(2, 2, a2, b2); G8_MMA(2, 3, a2, b3); \
        G8_MMA(3, 0, a3, b0); G8_MMA(3, 1, a3, b1); G8_MMA(3, 2, a3, b2); G8_MMA(3, 3, a3, b3); \
        GC_RD(c0, sa, 8192); GC_RD(c1, sa, 10240); GC_RD(c2, sa, 12288); GC_RD(c3, sa, 14336); \
        F2; \
        asm volatile("s_waitcnt lgkmcnt(2)" : "+v"(c0), "+v"(c1) :: "memory"); \
        G8_MMA(4, 0, c0, b0); G8_MMA(4, 1, c0, b1); G8_MMA(4, 2, c0, b2); G8_MMA(4, 3, c0, b3); \
        G8_MMA(5, 0, c1, b0); G8_MMA(5, 1, c1, b1); G8_MMA(5, 2, c1, b2); G8_MMA(5, 3, c1, b3); \
        F3; \
        asm volatile("s_waitcnt lgkmcnt(0)" : "+v"(c2), "+v"(c3) :: "memory"); \
        G8_MMA(6, 0, c2, b0); G8_MMA(6, 1, c2, b1); G8_MMA(6, 2, c2, b2); G8_MMA(6, 3, c2, b3); \
        G8_MMA(7, 0, c3, b0); G8_MMA(7, 1, c3, b1); G8_MMA(7, 2, c3, b2); G8_MMA(7, 3, c3, b3); \
        F4; } while (0)
#define G8_PA(kt_, j) __builtin_amdgcn_global_load_lds((const unsigned*)(ga + (size_t)(8 * (j)) * lda + (kt_) * 64), (LAS unsigned*)(L + ((kt_) & 1) * 65536 + 1024 * (j)), 16, 0, 0)
#define G8_PB(kt_, j) __builtin_amdgcn_global_load_lds((const unsigned*)(gb + (size_t)(8 * (j)) * ldb + (kt_) * 64), (LAS unsigned*)(L + ((kt_) & 1) * 65536 + 32768 + 1024 * (j)), 16, 0, 0)
    for (int kt = 0; kt < nk; ++kt) {
        asm volatile("s_waitcnt vmcnt(0)" ::: "memory");
        __builtin_amdgcn_s_barrier();
        asm volatile("" ::: "memory");
        const bool nxt = kt + 1 < nk;
        const unsigned slot = lbase + (unsigned)((kt & 1) * 65536);
        const unsigned sa0 = slot + arow + sw0, sb0 = slot + brow + sw0, sa1 = slot + arow + sw1, sb1 = slot + brow + sw1;
        __builtin_amdgcn_s_setprio(1);
        G8_HALF(sa0, sb0,
                if (nxt) { G8_PA(kt + 1, 0); G8_PB(kt + 1, 0); },
                if (nxt) { G8_PA(kt + 1, 1); G8_PB(kt + 1, 1); },
                if (nxt) { G8_PA(kt + 1, 2); G8_PB(kt + 1, 2); },
                if (nxt) { G8_PA(kt + 1, 3); G8_PB(kt + 1, 3); });
        G8_HALF(sa1, sb1, (void)0, (void)0, (void)0, (void)0);
        __builtin_amdgcn_s_setprio(0);
    }
    __syncthreads();
}
__device__ __forceinline__ bool tile_map8(int iter, int MT, int NT, int& rt, int& ct) {
    const int G = gridDim.x;
    if ((G & 7) == 0 && (MT & 63) == 0) {
        const int x = blockIdx.x & 7, lb = blockIdx.x >> 3, nlb = G >> 3, MTx = MT >> 3;
        const int li = lb + iter * nlb;
        if (li >= MTx * NT) return false;
        const int per = 4 * NT, rg = li / per, r = li - rg * per;
        ct = r >> 2; rt = x * MTx + rg * 4 + (r & 3);
        return true;
    }
    const int it = (int)blockIdx.x + iter * G;
    if (it >= MT * NT) return false;
    rt = it / NT; ct = it - rt * NT; return true;
}
#define EPI8_IDS const int tid_ = tidx512(), l_ = tid_ & 63, w_ = tid_ >> 6, wr = w_ >> 2, wc = w_ & 3, fr = l_ & 15, fq = l_ >> 4; (void)wr; (void)wc; (void)fr; (void)fq;
#define EPI_IDS const int tid_ = tidx(), l_ = tid_ & 63, w_ = tid_ >> 6, wr = w_ >> 1, wc = w_ & 1, fr = l_ & 15, fq = l_ >> 4; (void)wr; (void)wc; (void)fr; (void)fq;

__device__ void transpose_job(const float* __restrict__ W, int K, int ldw, int rows, int mode, int perm, const float* __restrict__ gs, bf16_t* __restrict__ Wt, int gtid, int gthreads) {
    const int nch = rows * (K >> 3), nnb = rows >> 3;
    for (int id = gtid; id < nch; id += gthreads) {
        const int tile = id >> 6, lane = id & 63;
        const int n = (tile % nnb) * 8 + (lane & 7), kc = (tile / nnb) * 8 + (lane >> 3);
        int nn = n;
        if (perm) { const int j = n & 31; nn = (n & ~31) + ((j >> 2) & 3) * 8 + (j >> 4) * 4 + (j & 3); }
        int col = nn;
        if (mode == 1) col = (nn >> 6) * 128 + (nn & 63); else if (mode == 2) col = (nn >> 6) * 128 + 64 + (nn & 63);
        float v[8];
#pragma unroll
        for (int j = 0; j < 8; ++j) { const int k = kc * 8 + j; float x = W[(size_t)k * ldw + col]; if (gs) x *= gs[k]; v[j] = x; }
        *(u32x4*)(Wt + (size_t)n * K + kc * 8) = pack8(v);
    }
}
__device__ void rmsnorm_rows_bf16(const float* __restrict__ x, const float* __restrict__ g, bf16_t* __restrict__ h) {
    const int l = tidx() & 63, gw = VB * 4 + (tidx() >> 6), nw = VG * 4;
    for (int row = gw; row < T_TOK; row += nw) {
        const float* xr = x + (size_t)row * DM;
        f32x4 v[4]; float ss = 0.f;
#pragma unroll
        for (int i = 0; i < 4; ++i) { v[i] = *(const f32x4*)(xr + i * 256 + l * 4); ss += v[i][0] * v[i][0] + v[i][1] * v[i][1] + v[i][2] * v[i][2] + v[i][3] * v[i][3]; }
        ss = wave_sum(ss);
        const float rs = rsqrtf(ss * (1.0f / DM) + RMS_EPS);
#pragma unroll
        for (int i = 0; i < 4; ++i) {
            const f32x4 gg = *(const f32x4*)(g + i * 256 + l * 4);
            u32x2 o; o.x = pk2(v[i][0] * rs * gg[0], v[i][1] * rs * gg[1]); o.y = pk2(v[i][2] * rs * gg[2], v[i][3] * rs * gg[3]);
            *(u32x2*)(h + (size_t)row * DM + i * 256 + l * 4) = o;
        }
    }
}

__device__ void phase0(const Params& p) {
    unsigned char* ws = lnd(p.ws);
    const int gtid = VB * 256 + tidx(), gth = VG * 256;
    transpose_job(IN(4), 1024, 4512, 4512, 0, 1, nullptr, (bf16_t*)(ws + W_IN), gtid, gth);
    transpose_job(IN(6), 384, 768, 768, 0, 0, IN(5), (bf16_t*)(ws + W_UQ), gtid, gth);
    transpose_job(IN(8), 256, 1024, 512, 1, 1, IN(7), (bf16_t*)(ws + W_KN), gtid, gth);
    transpose_job(IN(8), 256, 1024, 512, 2, 0, IN(7), (bf16_t*)(ws + W_V), gtid, gth);
    transpose_job(IN(9), 512, 1024, 1024, 0, 1, nullptr, (bf16_t*)(ws + W_OA), gtid, gth);
    transpose_job(IN(12), 64, 512, 512, 0, 1, nullptr, (bf16_t*)(ws + W_W2), gtid, gth);
    transpose_job(IN(14), 64, 512, 512, 0, 1, nullptr, (bf16_t*)(ws + W_A2), gtid, gth);
    transpose_job(IN(15), 128, 512, 512, 0, 1, nullptr, (bf16_t*)(ws + W_G2), gtid, gth);
    transpose_job(IN(21), 512, 1024, 1024, 0, 1, nullptr, (bf16_t*)(ws + W_OB), gtid, gth);
    transpose_job(IN(22), 1024, 1024, 1024, 0, 1, nullptr, (bf16_t*)(ws + W_OUT), gtid, gth);
    transpose_job(IN(24), 1024, 4096, 4096, 0, 1, IN(23), (bf16_t*)(ws + W_UP), gtid, gth);
    transpose_job(IN(25), 4096, 1024, 1024, 0, 1, nullptr, (bf16_t*)(ws + W_DN), gtid, gth);
    transpose_job(IN(27), 1024, 1024, 1024, 0, 1, IN(26), (bf16_t*)(ws + W_PG), gtid, gth);
    transpose_job(IN(28), 256, 1024, 1024, 0, 1, nullptr, (bf16_t*)(ws + W_PP), gtid, gth);
    {
        const float* pp = IN(1); bf16_t* pb = (bf16_t*)(ws + R_PB);
        for (int id = gtid; id < T_TOK * 256 / 8; id += gth) {
            const f32x4 a = *(const f32x4*)(pp + (size_t)id * 8), b = *(const f32x4*)(pp + (size_t)id * 8 + 4);
            u32x4 o; o.x = pk2(a[0], a[1]); o.y = pk2(a[2], a[3]); o.z = pk2(b[0], b[1]); o.w = pk2(b[2], b[3]);
            *(u32x4*)(pb + (size_t)id * 8) = o;
        }
    }
    { float* z = (float*)(ws + OFF_SS1); for (int id = gtid; id < 2 * T_TOK; id += gth) z[id] = 0.f; }
    rmsnorm_rows_bf16(IN(0), IN(3), (bf16_t*)(ws + R_A));
}

__device__ void phase1(const Params& p, unsigned char* lds8) {
    unsigned char* ws = lnd(p.ws); EPI8_IDS
    const bf16_t* h = (const bf16_t*)(ws + R_A); const bf16_t* Wt = (const bf16_t*)(ws + W_IN);
    bf16_t* zm = (bf16_t*)(ws + R_B); bf16_t* zr = (bf16_t*)(ws + R_C);
    for (int iter = 0, rt, ct; tile_map8(iter, 128, 10, rt, ct); ++iter) {
        const int m0 = rt * 256, n0 = ct * 256;
        f32x4 acc[8][4];
        gemm8(h + (size_t)m0 * 1024, 1024, Wt + (size_t)n0 * 1024, 1024, 1024, acc, lds8);
#pragma unroll
        for (int mi = 0; mi < 8; ++mi) {
            const int row = m0 + wr * 128 + mi * 16 + fr;
#pragma unroll
            for (int q = 0; q < 2; ++q) {
                const int col = n0 + wc * 64 + q * 32 + fq * 8;
                u32x4 o; o.x = pk2(acc[mi][2 * q][0], acc[mi][2 * q][1]); o.y = pk2(acc[mi][2 * q][2], acc[mi][2 * q][3]);
                o.z = pk2(acc[mi][2 * q + 1][0], acc[mi][2 * q + 1][1]); o.w = pk2(acc[mi][2 * q + 1][2], acc[mi][2 * q + 1][3]);
                if (col < 672) *(u32x4*)(zm + (size_t)row * 672 + col) = o;
                else if (col < 2464) *(u32x4*)(zr + (size_t)row * 1792 + (col - 672)) = o;
            }
        }
    }
}

__device__ void phase2(const Params& p) {
    unsigned char* ws = lnd(p.ws);
    const bf16_t* zm = (const bf16_t*)(ws + R_B); const bf16_t* zr = (const bf16_t*)(ws + R_C);
    float* rsq = (float*)(ws + OFF_RSQ); float* rskv = (float*)(ws + OFF_RSKV); float* cs = (float*)(ws + OFF_CS);
    bf16_t* kpe = (bf16_t*)(ws + R_G);
    bf16_t* lin = (bf16_t*)(ws + R_A + 48 * MiB);
    bf16_t* rs = (bf16_t*)(ws + R_D); bf16_t* ks = rs + (size_t)T_TOK * 512; bf16_t* vs = ks + (size_t)T_TOK * 512;
    const float* mu = IN(10); const int* pos = (const int*)IN(2);
    const int l = tidx() & 63, gw = VB * 4 + (tidx() >> 6), nw = VG * 4;
    for (int tok = gw; tok < T_TOK; tok += nw) {
        const bf16_t* zrow = zm + (size_t)tok * 672;
        float sq = 0.f, skv = 0.f;
        {
            float f[8]; unpack8(*(const u32x4*)(zrow + l * 8), f);
            float s = 0.f;
#pragma unroll
            for (int j = 0; j < 8; ++j) s += f[j] * f[j];
            if (l < 48) sq += s; else skv += s;
            if (l < 16) { unpack8(*(const u32x4*)(zrow + (64 + l) * 8), f); s = 0.f;
#pragma unroll
                for (int j = 0; j < 8; ++j) s += f[j] * f[j];
                skv += s; }
        }
        sq = wave_sum(sq); skv = wave_sum(skv);
        if (l == 0) { rsq[tok] = rsqrtf(sq * (1.0f / 384.0f) + RMS_EPS); rskv[tok] = rsqrtf(skv * (1.0f / 256.0f) + RMS_EPS); }
        if (l < 16) {
            const float invf = powf(10000.0f, -(float)l * (1.0f / 16.0f));
            const float ang = (float)pos[tok] * invf;
            float sn, c; sincosf(ang, &sn, &c);
            cs[(size_t)tok * 32 + l] = c; cs[(size_t)tok * 32 + 16 + l] = sn;
            const float x1 = bf1(zrow[640 + l]), x2 = bf1(zrow[656 + l]);
            kpe[(size_t)tok * 32 + l] = (bf16_t)f2bf(x1 * c - x2 * sn);
            kpe[(size_t)tok * 32 + 16 + l] = (bf16_t)f2bf(x2 * c + x1 * sn);
        }
        const bool first = (tok % SEQ) == 0;
        const bf16_t* cur = zr + (size_t)tok * 1792; const bf16_t* prv = cur - 1792;
#pragma unroll
        for (int ps = 0; ps < 4; ++ps) {
            const int ch = ps * 64 + l;
            if (ch < 224) {
                const int c0 = ch * 8;
                float fc[8], fp[8], zs[8];
                unpack8(*(const u32x4*)(cur + c0), fc);
                if (first) {
#pragma unroll
                    for (int j = 0; j < 8; ++j) fp[j] = 0.f;
                } else unpack8(*(const u32x4*)(prv + c0), fp);
                const f32x4 m0 = *(const f32x4*)(mu + c0), m1 = *(const f32x4*)(mu + c0 + 4);
#pragma unroll
                for (int j = 0; j < 8; ++j) { const float m = j < 4 ? m0[j] : m1[j - 4]; zs[j] = fc[j] + (fp[j] - fc[j]) * m; }
                bf16_t* dst;
                if (c0 < 512) dst = rs + (size_t)tok * 512 + c0;
                else if (c0 < 1024) dst = ks + (size_t)tok * 512 + (c0 - 512);
                else if (c0 < 1536) dst = vs + (size_t)tok * 512 + (c0 - 1024);
                else {
                    dst = lin + (size_t)tok * 256 + (c0 - 1536);
                    if (c0 < 1600) {
#pragma unroll
                        for (int j = 0; j < 8; ++j) zs[j] = tanhf(zs[j]);
                    } else if (c0 >= 1664) {
#pragma unroll
                        for (int j = 0; j < 8; ++j) zs[j] = sigmoidf_(zs[j]);
                    }
                }
                *(u32x4*)dst = pack8(zs);
            }
        }
    }
}

__device__ void phase3(const Params& p, unsigned char* lds) {
    unsigned char* ws = lnd(p.ws); EPI_IDS
    const bf16_t* zm = (const bf16_t*)(ws + R_B);
    const bf16_t* lin = (const bf16_t*)(ws + R_A + 48 * MiB);
    const float* rsq = (const float*)(ws + OFF_RSQ); const float* rskv = (const float*)(ws + OFF_RSKV); const float* cs = (const float*)(ws + OFF_CS);
    bf16_t* qb = (bf16_t*)(ws + R_A); bf16_t* kn = (bf16_t*)(ws + R_E); bf16_t* vt = (bf16_t*)(ws + R_F);
    bf16_t* ks = (bf16_t*)(ws + R_D) + (size_t)T_TOK * 512;
    bf16_t* kk = (bf16_t*)(ws + R_C); bf16_t* bb = kk + (size_t)T_TOK * 512; bf16_t* om = bb + (size_t)T_TOK * 512;
    bf16_t* gg = (bf16_t*)(ws + R_H);
    constexpr int N_Q = 256 * 6, N_KN = 256 * 4, N_VT = 4 * 256, N_L = 256 * 4;
    constexpr int TOT = N_Q + N_KN + N_VT + 3 * N_L;
    for (int it = VB; it < TOT; it += VG) {
        f32x4 acc[4][4];
        if (it < N_Q) {
            const int rt = it / 6, ct = it % 6, m0 = rt * 128, n0 = ct * 128;
            gemm_core(zm + (size_t)m0 * 672, 672, (const bf16_t*)(ws + W_UQ) + (size_t)n0 * 384, 384, 384, acc, lds);
            const int G0 = (n0 + wc * 64) >> 4;
#pragma unroll
            for (int mi = 0; mi < 4; ++mi) {
                const int row = m0 + wr * 64 + mi * 16 + fr;
                const float sc = rsq[row] * QSCALE;
#pragma unroll
                for (int np = 0; np < 4; np += 2) {
                    const int r6 = (G0 + np) % 6;
                    f32x4 a = acc[mi][np] * sc, b = acc[mi][np + 1] * sc;
                    if (r6 == 4) {
                        const f32x4 c = *(const f32x4*)(cs + (size_t)row * 32 + fq * 4), s = *(const f32x4*)(cs + (size_t)row * 32 + 16 + fq * 4);
                        const f32x4 o1 = a * c - b * s, o2 = b * c + a * s; a = o1; b = o2;
                    }
                    const int col = n0 + wc * 64 + np * 16 + fq * 4;
                    u32x2 o; o.x = pk2(a[0], a[1]); o.y = pk2(a[2], a[3]); *(u32x2*)(qb + (size_t)row * 768 + col) = o;
                    o.x = pk2(b[0], b[1]); o.y = pk2(b[2], b[3]); *(u32x2*)(qb + (size_t)row * 768 + col + 16) = o;
                }
            }
        } else if (it < N_Q + N_KN) {
            const int i2 = it - N_Q, rt = i2 >> 2, ct = i2 & 3, m0 = rt * 128, n0 = ct * 128;
            gemm_core(zm + (size_t)m0 * 672 + 384, 672, (const bf16_t*)(ws + W_KN) + (size_t)n0 * 256, 256, 256, acc, lds);
#pragma unroll
            for (int mi = 0; mi < 4; ++mi) {
                const int row = m0 + wr * 64 + mi * 16 + fr; const float sc = rskv[row];
#pragma unroll
                for (int q = 0; q < 2; ++q) {
                    const int col = n0 + wc * 64 + q * 32 + fq * 8; const f32x4 a = acc[mi][2 * q] * sc, c = acc[mi][2 * q + 1] * sc;
                    u32x4 o; o.x = pk2(a[0], a[1]); o.y = pk2(a[2], a[3]); o.z = pk2(c[0], c[1]); o.w = pk2(c[2], c[3]);
                    *(u32x4*)(kn + (size_t)row * 512 + col) = o;
                }
            }
        } else if (it < N_Q + N_KN + N_VT) {
            const int i2 = it - N_Q - N_KN, rt = i2 & 3, ct = i2 >> 2, m0 = rt * 128, n0 = ct * 128;
            gemm_core((const bf16_t*)(ws + W_V) + (size_t)m0 * 256, 256, zm + (size_t)n0 * 672 + 384, 672, 256, acc, lds);
#pragma unroll
            for (int ni = 0; ni < 4; ++ni) {
                const int col = n0 + wc * 64 + ni * 16 + fq * 4; const f32x4 sc = *(const f32x4*)(rskv + col);
#pragma unroll
                for (int mi = 0; mi < 4; ++mi) {
                    const int row = m0 + wr * 64 + mi * 16 + fr; const f32x4 a = acc[mi][ni] * sc;
                    u32x2 o; o.x = pk2(a[0], a[1]); o.y = pk2(a[2], a[3]); *(u32x2*)(vt + (size_t)row * T_TOK + col) = o;
                }
            }
        } else {
            const int i2 = it - N_Q - N_KN - N_VT, which = i2 / N_L, i3 = i2 % N_L, rt = i3 >> 2, ct = i3 & 3, m0 = rt * 128, n0 = ct * 128;
            if (which == 0) {
                gemm_core(lin + (size_t)m0 * 256, 256, (const bf16_t*)(ws + W_W2) + (size_t)n0 * 64, 64, 64, acc, lds);
                const float* w0 = IN(11);
#pragma unroll
                for (int q = 0; q < 2; ++q) {
                    const int col = n0 + wc * 64 + q * 32 + fq * 8; const f32x4 w0a = *(const f32x4*)(w0 + col), w0b = *(const f32x4*)(w0 + col + 4);
#pragma unroll
                    for (int mi = 0; mi < 4; ++mi) {
                        const int row = m0 + wr * 64 + mi * 16 + fr; float o8[8];
#pragma unroll
                        for (int r = 0; r < 8; ++r) {
                            const float x = (r < 4 ? w0a[r & 3] : w0b[r & 3]) + (r < 4 ? acc[mi][2 * q][r & 3] : acc[mi][2 * q + 1][r & 3]);
                            const float e = 0.60653065971f * sigmoidf_(x);
                            o8[r] = e * (1.0f - e * (0.5f - e * (0.16666667f - e * (0.041666667f - e * (0.0083333333f - e * (0.0013888889f - e * 0.0001984127f))))));
                        }
                        *(u32x4*)(om + (size_t)row * 512 + col) = pack8(o8);
                    }
                }
            } else if (which == 1) {
                gemm_core(lin + (size_t)m0 * 256 + 64, 256, (const bf16_t*)(ws + W_A2) + (size_t)n0 * 64, 64, 64, acc, lds);
                const float* a0 = IN(13); const float* k_k = IN(16); const float* k_a = IN(17);
#pragma unroll
                for (int mi = 0; mi < 4; ++mi) {
                    const int row = m0 + wr * 64 + mi * 16 + fr;
                    float ksv[2][8], kkr[2][8], al[2][8]; float ss = 0.f;
#pragma unroll
                    for (int q = 0; q < 2; ++q) {
                        const int col = n0 + wc * 64 + q * 32 + fq * 8;
                        unpack8(*(const u32x4*)(ks + (size_t)row * 512 + col), ksv[q]);
                        const f32x4 a0a = *(const f32x4*)(a0 + col), a0b = *(const f32x4*)(a0 + col + 4), kka = *(const f32x4*)(k_k + col), kkb = *(const f32x4*)(k_k + col + 4);
#pragma unroll
                        for (int r = 0; r < 8; ++r) {
                            const float av = r < 4 ? acc[mi][2 * q][r & 3] : acc[mi][2 * q + 1][r & 3];
                            al[q][r] = sigmoidf_((r < 4 ? a0a[r & 3] : a0b[r & 3]) + av);
                            kkr[q][r] = ksv[q][r] * (r < 4 ? kka[r & 3] : kkb[r & 3]); ss += kkr[q][r] * kkr[q][r];
                        }
                    }
                    ss += __shfl_xor(ss, 16); ss += __shfl_xor(ss, 32);
                    const float inv = 1.0f / fmaxf(sqrtf(ss), 1e-12f);
#pragma unroll
                    for (int q = 0; q < 2; ++q) {
                        const int col = n0 + wc * 64 + q * 32 + fq * 8;
                        const f32x4 kaa = *(const f32x4*)(k_a + col), kab = *(const f32x4*)(k_a + col + 4);
                        float k1[8], b1[8], kp[8];
#pragma unroll
                        for (int r = 0; r < 8; ++r) { k1[r] = kkr[q][r] * inv; b1[r] = k1[r] * al[q][r]; kp[r] = ksv[q][r] * (1.0f + (al[q][r] - 1.0f) * (r < 4 ? kaa[r & 3] : kab[r & 3])); }
                        *(u32x4*)(kk + (size_t)row * 512 + col) = pack8(k1);
                        *(u32x4*)(bb + (size_t)row * 512 + col) = pack8(b1);
                        *(u32x4*)(ks + (size_t)row * 512 + col) = pack8(kp);
                    }
                }
            } else {
                gemm_core(lin + (size_t)m0 * 256 + 128, 256, (const bf16_t*)(ws + W_G2) + (size_t)n0 * 128, 128, 128, acc, lds);
#pragma unroll
                for (int mi = 0; mi < 4; ++mi) {
                    const int row = m0 + wr * 64 + mi * 16 + fr;
#pragma unroll
                    for (int q = 0; q < 2; ++q) {
                        const int col = n0 + wc * 64 + q * 32 + fq * 8; const f32x4 a = acc[mi][2 * q], c = acc[mi][2 * q + 1];
                        u32x4 o; o.x = pk2(a[0], a[1]); o.y = pk2(a[2], a[3]); o.z = pk2(c[0], c[1]); o.w = pk2(c[2], c[3]);
                        *(u32x4*)(gg + (size_t)row * 512 + col) = o;
                    }
                }
            }
        }
    }
}

struct HalfBar { unsigned addr; unsigned target; };
__device__ __forceinline__ void hb_sync(HalfBar& hb) {
    asm volatile("s_waitcnt lgkmcnt(0)" ::: "memory");
    hb.target += 4u;
    const int lane = threadIdx.x & 63;
    if (lane == 0) asm volatile("ds_add_u32 %0, %1" :: "v"(hb.addr), "v"(1u) : "memory");
    for (;;) {
        unsigned v;
        asm volatile("ds_read_b32 %0, %1\n\ts_waitcnt lgkmcnt(0)" : "=v"(v) : "v"(hb.addr) : "memory");
        if ((int)(__builtin_amdgcn_readfirstlane(v) - hb.target) >= 0) break;
        __builtin_amdgcn_s_sleep(1);
    }
    asm volatile("" ::: "memory");
}
#define SCAN_BAR() do { asm volatile("s_waitcnt lgkmcnt(0)" ::: "memory"); __builtin_amdgcn_s_barrier(); asm volatile("" ::: "memory"); } while (0)
constexpr int SCAN_CH = 32;
constexpr int SCAN_NBAR = 2 + (SEQ / SCAN_CH);
__device__ void scan_consumer(const Params& p, int si, unsigned char* lds) {
    unsigned char* ws = lnd(p.ws);
    const int chain = si >> 2, rg = si & 3, b = chain >> 3, h = chain & 7;
    const int tid = tidx(), w = tid >> 6, l = tid & 63, rowA = w * 4 + (l >> 4), kg = l & 15;
    const bf16_t* rs = (const bf16_t*)(ws + R_D); const bf16_t* ks = rs + (size_t)T_TOK * 512; const bf16_t* vs = ks + (size_t)T_TOK * 512;
    const bf16_t* kk = (const bf16_t*)(ws + R_C); const bf16_t* bb = kk + (size_t)T_TOK * 512; const bf16_t* om = bb + (size_t)T_TOK * 512;
    bf16_t* yo = (bf16_t*)(ws + R_I);
    float* ops = (float*)lds;
    float* vb = (float*)(lds + 81920);
    float* yb = (float*)(lds + 86016);
    const size_t tokb = (size_t)b * SEQ;
    const int lrem = tid & 127, lstep = lrem >> 3, lpart = lrem & 7, lhalf = tid >> 7;
    const bf16_t* sp0 = (lhalf ? om : kk) + (tokb + lstep) * 512 + h * 64 + lpart * 8;
    const bf16_t* sp1 = (lhalf ? ks : bb) + (tokb + lstep) * 512 + h * 64 + lpart * 8;
    const bf16_t* sp2 = rs + (tokb + lstep) * 512 + h * 64 + lpart * 8;
    const bf16_t* spv = vs + (tokb + ((tid & 31) >> 1)) * 512 + h * 64 + rg * 16 + (tid & 1) * 8;
    const int ldst0 = lstep * 320 + lhalf * 64 + lpart * 8, ldst1 = lstep * 320 + (2 + lhalf) * 64 + lpart * 8, ldst2 = lstep * 320 + 256 + lpart * 8;
    (void)sp0; (void)sp1; (void)sp2; (void)spv; (void)ldst0; (void)ldst1; (void)ldst2;
    constexpr int NCH = SEQ / SCAN_CH;
    const unsigned lds_ops = (unsigned)(size_t)(LAS unsigned char*)lds, lds_vb = lds_ops + 81920u, lds_yb = lds_ops + 86016u;
#define SC_RD(KK, DD, NB, K_, RR, VV, PA, PV, ST) do { \
        asm volatile("ds_read_b128 %0, %1 offset:%2" : "=v"(KK) : "v"(PA), "i"((ST) * 1280) : "memory"); \
        asm volatile("ds_read_b128 %0, %1 offset:%2" : "=v"(DD) : "v"(PA), "i"((ST) * 1280 + 256) : "memory"); \
        asm volatile("ds_read_b128 %0, %1 offset:%2" : "=v"(NB) : "v"(PA), "i"((ST) * 1280 + 512) : "memory"); \
        asm volatile("ds_read_b128 %0, %1 offset:%2" : "=v"(K_) : "v"(PA), "i"((ST) * 1280 + 768) : "memory"); \
        asm volatile("ds_read_b128 %0, %1 offset:%2" : "=v"(RR) : "v"(PA), "i"((ST) * 1280 + 1024) : "memory"); \
        asm volatile("ds_read_b32 %0, %1 offset:%2" : "=v"(VV) : "v"(PV), "i"((ST) * 64) : "memory"); } while (0)
#define SC_WAIT(N, KK, DD, NB, K_, RR, VV) asm volatile("s_waitcnt lgkmcnt(" #N ")" : "+v"(KK), "+v"(DD), "+v"(NB), "+v"(K_), "+v"(RR), "+v"(VV) :: "memory")
    typedef float f32x2 __attribute__((ext_vector_type(2)));
    f32x2 S01 = {0.f, 0.f}, S23 = {0.f, 0.f};
#define SC_STEP(ST, CKK, CD, CNB, CK, CR, CV, NKK, ND, NNB, NK, NR, NV, WN) do { \
        f32x2 u_ = {0.f, 0.f}; \
        if ((ST) > 0) { u_ = S01 * NR.xy; u_ = S23 * NR.zw + u_; } \
        if ((ST) < 31) SC_RD(NKK, ND, NNB, NK, NR, NV, pa, pv, (ST) + 1); \
        SC_WAIT(WN, CKK, CD, CNB, CK, CR, CV); \
        f32x2 t_ = S01 * CKK.xy; t_ = S23 * CKK.zw + t_; \
        float sa_ = t_.x + t_.y; \
        const f32x2 W01_ = S01 * CD.xy + CK.xy * CV, W23_ = S23 * CD.zw + CK.zw * CV; \
        float y_ = u_.x + u_.y; \
        sa_ += dppf<0x128>(sa_); sa_ += dppf<0x124>(sa_); \
        if ((ST) > 0) y_ += dppf<0x128>(y_); \
        sa_ += dppf<0x122>(sa_); sa_ += dppf<0x121>(sa_); \
        S01 = CNB.xy * sa_ + W01_; S23 = CNB.zw * sa_ + W23_; \
        if ((ST) > 0) asm volatile("ds_write_b32 %0, %1 offset:%2" :: "v"(pw), "v"(y_), "i"(((ST) > 0 ? (ST) - 1 : 0) * 512) : "memory"); } while (0)
    SCAN_BAR();
    SCAN_BAR();
    for (int c = 0; c < NCH; ++c) {
        const int buf = c & 1;
        const unsigned pa = lds_ops + (unsigned)(buf * 40960 + kg * 16), pv = lds_vb + (unsigned)(buf * 2048 + rowA * 4);
        const unsigned pw = lds_yb + (unsigned)(buf * 16384 + (rowA * 8 + (kg & 7)) * 4);
        f32x4 akk, ad, anb, ak, ar, bkk, bd, bnb, bk, br; float av, bv;
        SC_RD(akk, ad, anb, ak, ar, av, pa, pv, 0);
        SC_STEP(0, akk, ad, anb, ak, ar, av, bkk, bd, bnb, bk, br, bv, 6);
        SC_STEP(1, bkk, bd, bnb, bk, br, bv, akk, ad, anb, ak, ar, av, 6);
        SC_STEP(2, akk, ad, anb, ak, ar, av, bkk, bd, bnb, bk, br, bv, 7);
        SC_STEP(3, bkk, bd, bnb, bk, br, bv, akk, ad, anb, ak, ar, av, 7);
        SC_STEP(4, akk, ad, anb, ak, ar, av, bkk, bd, bnb, bk, br, bv, 7);
        SC_STEP(5, bkk, bd, bnb, bk, br, bv, akk, ad, anb, ak, ar, av, 7);
        SC_STEP(6, akk, ad, anb, ak, ar, av, bkk, bd, bnb, bk, br, bv, 7);
        SC_STEP(7, bkk, bd, bnb, bk, br, bv, akk, ad, anb, ak, ar, av, 7);
        SC_STEP(8, akk, ad, anb, ak, ar, av, bkk, bd, bnb, bk, br, bv, 7);
        SC_STEP(9, bkk, bd, bnb, bk, br, bv, akk, ad, anb, ak, ar, av, 7);
        SC_STEP(10, akk, ad, anb, ak, ar, av, bkk, bd, bnb, bk, br, bv, 7);
        SC_STEP(11, bkk, bd, bnb, bk, br, bv, akk, ad, anb, ak, ar, av, 7);
        SC_STEP(12, akk, ad, anb, ak, ar, av, bkk, bd, bnb, bk, br, bv, 7);
        SC_STEP(13, bkk, bd, bnb, bk, br, bv, akk, ad, anb, ak, ar, av, 7);
        SC_STEP(14, akk, ad, anb, ak, ar, av, bkk, bd, bnb, bk, br, bv, 7);
        SC_STEP(15, bkk, bd, bnb, bk, br, bv, akk, ad, anb, ak, ar, av, 7);
        SC_STEP(16, akk, ad, anb, ak, ar, av, bkk, bd, bnb, bk, br, bv, 7);
        SC_STEP(17, bkk, bd, bnb, bk, br, bv, akk, ad, anb, ak, ar, av, 7);
        SC_STEP(18, akk, ad, anb, ak, ar, av, bkk, bd, bnb, bk, br, bv, 7);
        SC_STEP(19, bkk, bd, bnb, bk, br, bv, akk, ad, anb, ak, ar, av, 7);
        SC_STEP(20, akk, ad, anb, ak, ar, av, bkk, bd, bnb, bk, br, bv, 7);
        SC_STEP(21, bkk, bd, bnb, bk, br, bv, akk, ad, anb, ak, ar, av, 7);
        SC_STEP(22, akk, ad, anb, ak, ar, av, bkk, bd, bnb, bk, br, bv, 7);
        SC_STEP(23, bkk, bd, bnb, bk, br, bv, akk, ad, anb, ak, ar, av, 7);
        SC_STEP(24, akk, ad, anb, ak, ar, av, bkk, bd, bnb, bk, br, bv, 7);
        SC_STEP(25, bkk, bd, bnb, bk, br, bv, akk, ad, anb, ak, ar, av, 7);
        SC_STEP(26, akk, ad, anb, ak, ar, av, bkk, bd, bnb, bk, br, bv, 7);
        SC_STEP(27, bkk, bd, bnb, bk, br, bv, akk, ad, anb, ak, ar, av, 7);
        SC_STEP(28, akk, ad, anb, ak, ar, av, bkk, bd, bnb, bk, br, bv, 7);
        SC_STEP(29, bkk, bd, bnb, bk, br, bv, akk, ad, anb, ak, ar, av, 7);
        SC_STEP(30, akk, ad, anb, ak, ar, av, bkk, bd, bnb, bk, br, bv, 7);
        SC_STEP(31, bkk, bd, bnb, bk, br, bv, akk, ad, anb, ak, ar, av, 1);
        {
            f32x2 u_ = S01 * br.xy; u_ = S23 * br.zw + u_;
            float y_ = u_.x + u_.y; y_ += dppf<0x128>(y_);
            asm volatile("ds_write_b32 %0, %1 offset:%2" :: "v"(pw), "v"(y_), "i"(31 * 512) : "memory");
        }
        asm volatile("s_waitcnt lgkmcnt(0)" ::: "memory");
        SCAN_BAR();
#pragma unroll
        for (int hh = 0; hh < 2; ++hh) {
            const int st = (tid >> 4) + 16 * hh, r = tid & 15;
            const float* yr = yb + buf * 4096 + st * 128 + r * 8;
            const f32x4 a0 = *(const f32x4*)(yr), a1 = *(const f32x4*)(yr + 4);
            const f32x4 sm = a0 + a1;
            const float y = (sm[0] + sm[1]) + (sm[2] + sm[3]);
            const unsigned short yv = (unsigned short)f2bf(y);
            const bf16_t* ya = yo + (tokb + (size_t)c * SCAN_CH + st) * 512 + h * 64 + rg * 16 + r;
            asm volatile("global_store_short %0, %1, off" :: "v"(ya), "v"((unsigned)yv) : "memory");
        }
    }
    asm volatile("s_waitcnt vmcnt(0)" ::: "memory");
}
__device__ void scan_producer(const Params& p, int si, unsigned char* lds) {
    unsigned char* ws = lnd(p.ws);
    const int chain = si >> 2, rg = si & 3, b = chain >> 3, h = chain & 7;
    const int tid = tidx(), w = tid >> 6, l = tid & 63, rowA = w * 4 + (l >> 4), kg = l & 15;
    const bf16_t* rs = (const bf16_t*)(ws + R_D); const bf16_t* ks = rs + (size_t)T_TOK * 512; const bf16_t* vs = ks + (size_t)T_TOK * 512;
    const bf16_t* kk = (const bf16_t*)(ws + R_C); const bf16_t* bb = kk + (size_t)T_TOK * 512; const bf16_t* om = bb + (size_t)T_TOK * 512;
    bf16_t* yo = (bf16_t*)(ws + R_I);
    float* ops = (float*)lds;
    float* vb = (float*)(lds + 81920);
    float* yb = (float*)(lds + 86016);
    const size_t tokb = (size_t)b * SEQ;
    const int lrem = tid & 127, lstep = lrem >> 3, lpart = lrem & 7, lhalf = tid >> 7;
    const bf16_t* sp0 = (lhalf ? om : kk) + (tokb + lstep) * 512 + h * 64 + lpart * 8;
    const bf16_t* sp1 = (lhalf ? ks : bb) + (tokb + lstep) * 512 + h * 64 + lpart * 8;
    const bf16_t* sp2 = rs + (tokb + lstep) * 512 + h * 64 + lpart * 8;
    const bf16_t* spv = vs + (tokb + ((tid & 31) >> 1)) * 512 + h * 64 + rg * 16 + (tid & 1) * 8;
    const int ldst0 = lstep * 320 + lhalf * 64 + lpart * 8, ldst1 = lstep * 320 + (2 + lhalf) * 64 + lpart * 8, ldst2 = lstep * 320 + 256 + lpart * 8;
    struct GSet { u32x4 g0, g1, g2, gv, h0, h1, h2, hv; };
    GSet RA, RB, RC;
    auto gload = [&](int c, GSet& R) {
        const size_t o = (size_t)c * SCAN_CH * 512 * 2, o2 = o + (size_t)16 * 512 * 2;
        const char* q0 = (const char*)sp0 + o; const char* q1 = (const char*)sp1 + o; const char* q2 = (const char*)sp2 + o; const char* q3 = (const char*)spv + o;
        const char* r0 = (const char*)sp0 + o2; const char* r1 = (const char*)sp1 + o2; const char* r2 = (const char*)sp2 + o2; const char* r3 = (const char*)spv + o2;
        asm volatile("global_load_dwordx4 %0, %1, off" : "=v"(R.g0) : "v"(q0) : "memory");
        asm volatile("global_load_dwordx4 %0, %1, off" : "=v"(R.g1) : "v"(q1) : "memory");
        asm volatile("global_load_dwordx4 %0, %1, off" : "=v"(R.g2) : "v"(q2) : "memory");
        asm volatile("global_load_dwordx4 %0, %1, off" : "=v"(R.gv) : "v"(q3) : "memory");
        asm volatile("global_load_dwordx4 %0, %1, off" : "=v"(R.h0) : "v"(r0) : "memory");
        asm volatile("global_load_dwordx4 %0, %1, off" : "=v"(R.h1) : "v"(r1) : "memory");
        asm volatile("global_load_dwordx4 %0, %1, off" : "=v"(R.h2) : "v"(r2) : "memory");
        asm volatile("global_load_dwordx4 %0, %1, off" : "=v"(R.hv) : "v"(r3) : "memory");
    };
    auto lstore1 = [&](int buf, int sub, const u32x4& x0, const u32x4& x1, const u32x4& x2, const u32x4& xv) {
        float f[8]; float* ob = ops + buf * 10240 + sub * 5120;
        unpack8(x0, f);
        if (lhalf) {
#pragma unroll
            for (int j = 0; j < 8; ++j) f[j] = 1.0f - f[j];
        }
        *(f32x4*)(ob + ldst0) = (f32x4){f[0], f[1], f[2], f[3]}; *(f32x4*)(ob + ldst0 + 4) = (f32x4){f[4], f[5], f[6], f[7]};
        unpack8(x1, f);
        if (!lhalf) {
#pragma unroll
            for (int j = 0; j < 8; ++j) f[j] = -f[j];
        }
        *(f32x4*)(ob + ldst1) = (f32x4){f[0], f[1], f[2], f[3]}; *(f32x4*)(ob + ldst1 + 4) = (f32x4){f[4], f[5], f[6], f[7]};
        if (tid < 128) { unpack8(x2, f); *(f32x4*)(ob + ldst2) = (f32x4){f[0], f[1], f[2], f[3]}; *(f32x4*)(ob + ldst2 + 4) = (f32x4){f[4], f[5], f[6], f[7]}; }
        if (tid < 32) { unpack8(xv, f); float* vd = vb + buf * 512 + sub * 256 + (tid >> 1) * 16 + (tid & 1) * 8;
            *(f32x4*)(vd) = (f32x4){f[0], f[1], f[2], f[3]}; *(f32x4*)(vd + 4) = (f32x4){f[4], f[5], f[6], f[7]}; }
    };
    auto lstore = [&](int buf, const GSet& R) { lstore1(buf, 0, R.g0, R.g1, R.g2, R.gv); lstore1(buf, 1, R.h0, R.h1, R.h2, R.hv); };
#define SC_VWAIT(N, R) asm volatile("s_waitcnt vmcnt(" #N ")" : "+v"(R.g0), "+v"(R.g1), "+v"(R.g2), "+v"(R.gv), "+v"(R.h0), "+v"(R.h1), "+v"(R.h2), "+v"(R.hv) :: "memory")
    constexpr int NCH = SEQ / SCAN_CH;
    (void)yo; (void)yb; (void)rowA; (void)kg;
    asm volatile("s_waitcnt vmcnt(0)" ::: "memory");
    SCAN_BAR();
    gload(0, RA); SC_VWAIT(0, RA); lstore(0, RA);
    gload(1, RB); gload(2, RC); gload(3, RA);
    SCAN_BAR();
    auto do_chunk = [&](int c, GSet& NX) {
        const int buf = c & 1;
        if (c + 1 < NCH) { SC_VWAIT(16, NX); lstore(buf ^ 1, NX); }
        SCAN_BAR();
        gload(c + 4 < NCH ? c + 4 : NCH - 1, NX);
    };
    for (int c = 0; c < NCH; c += 3) {
        do_chunk(c, RB);
        if (c + 1 < NCH) do_chunk(c + 1, RC);
        if (c + 2 < NCH) do_chunk(c + 2, RA);
    }
    asm volatile("s_waitcnt vmcnt(0)" ::: "memory");
}

__device__ __forceinline__ int pe_sw(int row) { return (0x78 >> (2 * ((row >> 2) & 3))) & 3; }
__device__ void attn_unit(const Params& p, int b, int h, int qblk, unsigned char* lds) {
    unsigned char* ws = lnd(p.ws);
    const bf16_t* Q = (const bf16_t*)(ws + R_A); const bf16_t* KN = (const bf16_t*)(ws + R_E); const bf16_t* VT = (const bf16_t*)(ws + R_F);
    const bf16_t* KP = (const bf16_t*)(ws + R_G); bf16_t* O = (bf16_t*)(ws + R_B);
    const int tid = tidx(), w = tid >> 6, l = tid & 63, fr = l & 15, g = l >> 4;
    const size_t tokb = (size_t)b * SEQ;
    const int q0 = qblk * 128 + w * 32;
    constexpr int BUFB = 21504, KP_OFF = 8192, VT_OFF = 12288;
    bf16x8 qf[2][3];
#pragma unroll
    for (int qi = 0; qi < 2; ++qi)
#pragma unroll
        for (int s = 0; s < 3; ++s) qf[qi][s] = *(const bf16x8*)(Q + (tokb + q0 + qi * 16 + fr) * 768 + h * 96 + s * 32 + g * 8);
    f32x4 o[4][2];
#pragma unroll
    for (int i = 0; i < 4; ++i) { o[i][0] = (f32x4){0.f, 0.f, 0.f, 0.f}; o[i][1] = (f32x4){0.f, 0.f, 0.f, 0.f}; }
    float mrun[2] = {-1e30f, -1e30f}, lsum[2] = {0.f, 0.f};
    const int ntiles = 2 * qblk + 2;
    const int kkey = tid >> 3, kkc = tid & 7;
    const int pkey = tid >> 2, pkc = tid & 3;
    const bf16_t* gkn = KN + (tokb + kkey) * 512 + h * 64 + kkc * 8;
    const bf16_t* gkp = KP + (tokb + pkey) * 32 + pkc * 8;
    const bf16_t* gvt = VT + ((size_t)h * 64 + kkey) * T_TOK + tokb + kkc * 8;
    const unsigned dkn = (unsigned)(kkey * 128 + ((kkc ^ (kkey & 7)) * 16));
    const unsigned dkp = (unsigned)(KP_OFF + pkey * 64 + ((pkc ^ pe_sw(pkey)) * 16));
    const unsigned dvt = (unsigned)(VT_OFF + kkey * 144 + kkc * 16);
    struct KVSet { u32x4 rk0, rk1, rp, rv0, rv1; };
    KVSet SA, SB;
    auto gload = [&](int kt, KVSet& R) {
        R.rk0 = *(const u32x4*)(gkn + (size_t)kt * 64 * 512); R.rk1 = *(const u32x4*)(gkn + ((size_t)kt * 64 + 32) * 512);
        R.rp = *(const u32x4*)(gkp + (size_t)kt * 64 * 32);
        R.rv0 = *(const u32x4*)(gvt + kt * 64); R.rv1 = *(const u32x4*)(gvt + (size_t)32 * T_TOK + kt * 64);
    };
    auto lstore = [&](int buf, const KVSet& R) {
        unsigned char* d = lds + buf * BUFB;
        *(u32x4*)(d + dkn) = R.rk0; *(u32x4*)(d + dkn + 32 * 128) = R.rk1; *(u32x4*)(d + dkp) = R.rp;
        *(u32x4*)(d + dvt) = R.rv0; *(u32x4*)(d + dvt + 32 * 144) = R.rv1;
    };
    const unsigned kfo0 = (unsigned)(fr * 128 + (((0 + g) ^ (fr & 7)) * 16)), kfo1 = (unsigned)(fr * 128 + (((4 + g) ^ (fr & 7)) * 16));
    const unsigned kfo2 = (unsigned)(KP_OFF + fr * 64 + ((g ^ pe_sw(fr)) * 16));
    const unsigned vfo = (unsigned)(VT_OFF + fr * 144 + g * 8);
    __syncthreads();
    gload(0, SA); lstore(0, SA);
    gload(1, SB);
    __syncthreads();
    auto tile_body = [&](int kt, const KVSet& NXT, KVSet& FREE) {
        const unsigned char* d = lds + (kt & 1) * BUFB;
        if (kt + 2 < ntiles) gload(kt + 2, FREE);
        f32x4 s_[4][2];
#pragma unroll
        for (int j = 0; j < 4; ++j) {
            const bf16x8 k0 = *(const bf16x8*)(d + kfo0 + j * 2048), k1 = *(const bf16x8*)(d + kfo1 + j * 2048), k2 = *(const bf16x8*)(d + kfo2 + j * 1024);
#pragma unroll
            for (int qi = 0; qi < 2; ++qi) {
                f32x4 a = {0.f, 0.f, 0.f, 0.f};
                a = __builtin_amdgcn_mfma_f32_16x16x32_bf16(k0, qf[qi][0], a, 0, 0, 0);
                a = __builtin_amdgcn_mfma_f32_16x16x32_bf16(k1, qf[qi][1], a, 0, 0, 0);
                a = __builtin_amdgcn_mfma_f32_16x16x32_bf16(k2, qf[qi][2], a, 0, 0, 0);
                s_[j][qi] = a;
            }
        }
        if (kt * 64 + 63 > q0) {
#pragma unroll
            for (int j = 0; j < 4; ++j)
#pragma unroll
                for (int qi = 0; qi < 2; ++qi)
#pragma unroll
                    for (int r = 0; r < 4; ++r) { const int key = kt * 64 + j * 16 + g * 4 + r, q = q0 + qi * 16 + fr; if (key > q) s_[j][qi][r] = -1e30f; }
        }
        bf16x8 pf[2][2];
#pragma unroll
        for (int qi = 0; qi < 2; ++qi) {
            float mx = -1e30f;
#pragma unroll
            for (int j = 0; j < 4; ++j) mx = fmaxf(mx, fmaxf(fmaxf(s_[j][qi][0], s_[j][qi][1]), fmaxf(s_[j][qi][2], s_[j][qi][3])));
            mx = fmaxf(mx, __shfl_xor(mx, 16)); mx = fmaxf(mx, __shfl_xor(mx, 32));
            const float mn = fmaxf(mrun[qi], mx);
            const float alpha = __builtin_amdgcn_exp2f(mrun[qi] - mn);
            mrun[qi] = mn;
            float psum = 0.f;
#pragma unroll
            for (int j = 0; j < 4; ++j)
#pragma unroll
                for (int r = 0; r < 4; ++r) { const float pv = __builtin_amdgcn_exp2f(s_[j][qi][r] - mn); s_[j][qi][r] = pv; psum += pv; }
            lsum[qi] = lsum[qi] * alpha + psum;
#pragma unroll
            for (int dt = 0; dt < 4; ++dt) o[dt][qi] = o[dt][qi] * alpha;
#pragma unroll
            for (int ksx = 0; ksx < 2; ++ksx) {
                u32x4 pw; pw.x = pk2(s_[2 * ksx][qi][0], s_[2 * ksx][qi][1]); pw.y = pk2(s_[2 * ksx][qi][2], s_[2 * ksx][qi][3]);
                pw.z = pk2(s_[2 * ksx + 1][qi][0], s_[2 * ksx + 1][qi][1]); pw.w = pk2(s_[2 * ksx + 1][qi][2], s_[2 * ksx + 1][qi][3]);
                pf[ksx][qi] = __builtin_bit_cast(bf16x8, pw);
            }
        }
#pragma unroll
        for (int ksx = 0; ksx < 2; ++ksx)
#pragma unroll
            for (int dt = 0; dt < 4; ++dt) {
                const u32x2 v0 = *(const u32x2*)(d + vfo + dt * 16 * 144 + ksx * 64), v1 = *(const u32x2*)(d + vfo + dt * 16 * 144 + ksx * 64 + 32);
                u32x4 vw; vw.x = v0.x; vw.y = v0.y; vw.z = v1.x; vw.w = v1.y;
                const bf16x8 vf = __builtin_bit_cast(bf16x8, vw);
                o[dt][0] = __builtin_amdgcn_mfma_f32_16x16x32_bf16(vf, pf[ksx][0], o[dt][0], 0, 0, 0);
                o[dt][1] = __builtin_amdgcn_mfma_f32_16x16x32_bf16(vf, pf[ksx][1], o[dt][1], 0, 0, 0);
            }
        if (kt + 1 < ntiles) lstore((kt + 1) & 1, NXT);
        __syncthreads();
    };
    for (int kt = 0; kt < ntiles; kt += 2) { tile_body(kt, SB, SA); tile_body(kt + 1, SA, SB); }
#pragma unroll
    for (int qi = 0; qi < 2; ++qi) {
        float lt = lsum[qi]; lt += __shfl_xor(lt, 16); lt += __shfl_xor(lt, 32);
        const float inv = 1.0f / lt;
        const size_t tok = tokb + q0 + qi * 16 + fr;
#pragma unroll
        for (int dt = 0; dt < 4; ++dt) {
            const f32x4 v = o[dt][qi] * inv;
            u32x2 ow; ow.x = pk2(v[0], v[1]); ow.y = pk2(v[2], v[3]);
            *(u32x2*)(O + tok * 512 + h * 64 + dt * 16 + g * 4) = ow;
        }
    }
}

__device__ void phase4(const Params& p, unsigned char* lds, int* s_item, int rep) {
    if (VHALF == 0) {
        for (int si = blockIdx.x; si < 128; si += gridDim.x) {
            __builtin_amdgcn_s_setprio(3);
            scan_consumer(p, si, lds);
            __builtin_amdgcn_s_setprio(0);
        }
    } else {
        for (int si = blockIdx.x; si < 128; si += gridDim.x) scan_producer(p, si, lds - 65536);
    }
    unsigned* queue = (unsigned*)(p.ws + OFF_QUEUE) + 512 * rep;
    const int myx = (int)(xb_xcc_id() & 7u);
    for (;;) {
        __syncthreads();
        if (threadIdx.x == 0) {
            int code = -1;
            for (int k = 0; k < 8; ++k) {
                const int xx = (myx + k) & 7;
                const unsigned it = atomicAdd(queue + xx * 16, 2u);
                if (it < 256u) { code = xx * 256 + (int)it; break; }
            }
            s_item[0] = code;
        }
        __syncthreads();
        const int code = s_item[0];
        if (code < 0) break;
        const int h = code >> 8, it = (code & 255) + VHALF;
        const int qblk = 63 - (it >> 2), b = it & 3;
        attn_unit(p, b, h, qblk, lds);
    }
}

__device__ void phase5(const Params& p) {
    unsigned char* ws = lnd(p.ws);
    const bf16_t* rs = (const bf16_t*)(ws + R_D); const bf16_t* ks = rs + (size_t)T_TOK * 512; const bf16_t* vs = ks + (size_t)T_TOK * 512;
    const bf16_t* yv = (const bf16_t*)(ws + R_I); const bf16_t* gg = (const bf16_t*)(ws + R_H);
    bf16_t* ybp = (bf16_t*)(ws + R_C);
    const float* lnw = IN(19); const float* lnb = IN(20); const float* rk = IN(18);
    const int l = tidx() & 63, gw = VB * 4 + (tidx() >> 6), nw = VG * 4;
    const int c0 = l * 8;
    float wv[8], bv[8], rkv[8];
    { const f32x4 a = *(const f32x4*)(lnw + c0), b = *(const f32x4*)(lnw + c0 + 4), c = *(const f32x4*)(lnb + c0), d = *(const f32x4*)(lnb + c0 + 4), e = *(const f32x4*)(rk + c0), f = *(const f32x4*)(rk + c0 + 4);
#pragma unroll
      for (int j = 0; j < 4; ++j) { wv[j] = a[j]; wv[j + 4] = b[j]; bv[j] = c[j]; bv[j + 4] = d[j]; rkv[j] = e[j]; rkv[j + 4] = f[j]; } }
    for (int tok = gw; tok < T_TOK; tok += nw) {
        const size_t off = (size_t)tok * 512 + c0;
        float y[8], r[8], k[8], v[8], g[8];
        unpack8(*(const u32x4*)(yv + off), y); unpack8(*(const u32x4*)(rs + off), r); unpack8(*(const u32x4*)(ks + off), k);
        unpack8(*(const u32x4*)(vs + off), v); unpack8(*(const u32x4*)(gg + off), g);
        float s = 0.f, bs = 0.f;
#pragma unroll
        for (int j = 0; j < 8; ++j) { s += y[j]; bs += r[j] * k[j] * rkv[j]; }
        s += __shfl_xor(s, 1); s += __shfl_xor(s, 2); s += __shfl_xor(s, 4);
        bs += __shfl_xor(bs, 1); bs += __shfl_xor(bs, 2); bs += __shfl_xor(bs, 4);
        const float mean = s * (1.0f / 64.0f);
        float q = 0.f;
#pragma unroll
        for (int j = 0; j < 8; ++j) { const float d = y[j] - mean; q += d * d; }
        q += __shfl_xor(q, 1); q += __shfl_xor(q, 2); q += __shfl_xor(q, 4);
        const float rstd = rsqrtf(q * (1.0f / 64.0f) + 64e-5f);
        float o[8];
#pragma unroll
        for (int j = 0; j < 8; ++j) o[j] = ((y[j] - mean) * rstd * wv[j] + bv[j] + bs * v[j]) * g[j];
        *(u32x4*)(ybp + off) = pack8(o);
    }
    rmsnorm_rows_bf16(IN(0), IN(3), (bf16_t*)(ws + R_A));
}

__device__ void phase6(const Params& p, unsigned char* lds8) {
    unsigned char* ws = lnd(p.ws); EPI8_IDS
    const bf16_t* h = (const bf16_t*)(ws + R_A); const bf16_t* ob = (const bf16_t*)(ws + R_B); const bf16_t* ybp = (const bf16_t*)(ws + R_C);
    const bf16_t* Wg = (const bf16_t*)(ws + W_IN) + (size_t)2464 * 1024;
    bf16_t* mo = (bf16_t*)(ws + R_D);
    bf16_t* gsc = (bf16_t*)(ws + R_C + 32 * MiB);
    for (int iter = 0, rt, ct; tile_map8(iter, 128, 4, rt, ct); ++iter) {
        const int m0 = rt * 256, n0 = ct * 256;
        const int row0 = m0 + wr * 128 + fr, col0 = n0 + wc * 64 + fq * 8;
        f32x4 acc[8][4];
#pragma unroll 1
        for (int pass = 0; pass < 2; ++pass) {
            gemm8(h + (size_t)m0 * 1024, 1024, Wg + (size_t)(pass * 1024 + n0) * 1024, 1024, 1024, acc, lds8);
#pragma unroll
            for (int mi = 0; mi < 8; ++mi) {
#pragma unroll
                for (int q = 0; q < 2; ++q) {
                    float v[8];
#pragma unroll
                    for (int r = 0; r < 4; ++r) { v[r] = sigmoidf_(acc[mi][2 * q][r]); v[4 + r] = sigmoidf_(acc[mi][2 * q + 1][r]); }
                    *(u32x4*)(gsc + (size_t)(row0 + mi * 16) * 1024 + col0 + q * 32) = pack8(v);
                }
            }
            if (pass == 0) gemm8(ob + (size_t)m0 * 512, 512, (const bf16_t*)(ws + W_OA) + (size_t)n0 * 512, 512, 512, acc, lds8);
            else gemm8(ybp + (size_t)m0 * 512, 512, (const bf16_t*)(ws + W_OB) + (size_t)n0 * 512, 512, 512, acc, lds8);
            {
                u32x4 gn[2], pn[2];
#pragma unroll
                for (int q = 0; q < 2; ++q) { gn[q] = *(const u32x4*)(gsc + (size_t)row0 * 1024 + col0 + q * 32); pn[q] = pass ? *(const u32x4*)(mo + (size_t)row0 * 1024 + col0 + q * 32) : (u32x4){0u, 0u, 0u, 0u}; }
#pragma unroll
                for (int mi = 0; mi < 8; ++mi) {
                    const int row = row0 + mi * 16;
                    u32x4 gc[2], pc[2];
#pragma unroll
                    for (int q = 0; q < 2; ++q) { gc[q] = gn[q]; pc[q] = pn[q]; }
                    if (mi < 7) {
#pragma unroll
                        for (int q = 0; q < 2; ++q) { gn[q] = *(const u32x4*)(gsc + (size_t)(row + 16) * 1024 + col0 + q * 32); pn[q] = pass ? *(const u32x4*)(mo + (size_t)(row + 16) * 1024 + col0 + q * 32) : (u32x4){0u, 0u, 0u, 0u}; }
                    }
#pragma unroll
                    for (int q = 0; q < 2; ++q) {
                        float g[8], pv[8], v[8];
                        unpack8(gc[q], g); unpack8(pc[q], pv);
#pragma unroll
                        for (int r = 0; r < 4; ++r) { v[r] = g[r] * acc[mi][2 * q][r] + pv[r]; v[4 + r] = g[4 + r] * acc[mi][2 * q + 1][r] + pv[4 + r]; }
                        *(u32x4*)(mo + (size_t)row * 1024 + col0 + q * 32) = pack8(v);
                    }
                }
            }
        }
    }
}

__device__ __forceinline__ void epi_residual8(const f32x4 (&acc)[8][4], int m0, int n0, const float* xin, float* xo, bf16_t* xb, float* ssq, const float* ss_in) {
    EPI8_IDS
    const int row0 = m0 + wr * 128 + fr, col0 = n0 + wc * 64 + fq * 8;
    f32x4 xn[4]; float sn = 0.f;
#pragma unroll
    for (int q = 0; q < 2; ++q) { xn[2 * q] = *(const f32x4*)(xin + (size_t)row0 * DM + col0 + q * 32); xn[2 * q + 1] = *(const f32x4*)(xin + (size_t)row0 * DM + col0 + q * 32 + 4); }
    if (ss_in) sn = ss_in[row0];
#pragma unroll
    for (int mi = 0; mi < 8; ++mi) {
        const int row = row0 + mi * 16;
        f32x4 xc[4]; const float sc_in = sn;
#pragma unroll
        for (int i = 0; i < 4; ++i) xc[i] = xn[i];
        if (mi < 7) {
#pragma unroll
            for (int q = 0; q < 2; ++q) { xn[2 * q] = *(const f32x4*)(xin + (size_t)(row + 16) * DM + col0 + q * 32); xn[2 * q + 1] = *(const f32x4*)(xin + (size_t)(row + 16) * DM + col0 + q * 32 + 4); }
            if (ss_in) sn = ss_in[row + 16];
        }
        float sc = 1.0f;
        if (ss_in) { const float r = rsqrtf(sc_in * (1.0f / DM) + RMS_EPS); sc = r * r; }
        float ss = 0.f;
#pragma unroll
        for (int q = 0; q < 2; ++q) {
            const int col = col0 + q * 32;
            const f32x4 v0 = xc[2 * q] + acc[mi][2 * q] * sc, v1 = xc[2 * q + 1] + acc[mi][2 * q + 1] * sc;
            *(f32x4*)(xo + (size_t)row * DM + col) = v0; *(f32x4*)(xo + (size_t)row * DM + col + 4) = v1;
            u32x4 o; o.x = pk2(v0[0], v0[1]); o.y = pk2(v0[2], v0[3]); o.z = pk2(v1[0], v1[1]); o.w = pk2(v1[2], v1[3]);
            *(u32x4*)(xb + (size_t)row * DM + col) = o;
            ss += (v0[0] * v0[0] + v0[1] * v0[1] + v0[2] * v0[2] + v0[3] * v0[3]) + (v1[0] * v1[0] + v1[1] * v1[1] + v1[2] * v1[2] + v1[3] * v1[3]);
        }
        ss += __shfl_xor(ss, 16); ss += __shfl_xor(ss, 32);
        if (fq == 0) atomicAdd(ssq + row, ss);
    }
}

__device__ void phase7(const Params& p, unsigned char* lds8) {
    unsigned char* ws = lnd(p.ws);
    const bf16_t* mo = (const bf16_t*)(ws + R_D);
    for (int iter = 0, rt, ct; tile_map8(iter, 128, 4, rt, ct); ++iter) {
        const int m0 = rt * 256, n0 = ct * 256;
        f32x4 acc[8][4];
        gemm8(mo + (size_t)m0 * 1024, 1024, (const bf16_t*)(ws + W_OUT) + (size_t)n0 * 1024, 1024, 1024, acc, lds8);
        epi_residual8(acc, m0, n0, IN(0), lnd(p.out), (bf16_t*)(ws + R_A), (float*)(ws + OFF_SS1), nullptr);
    }
}
__device__ void phase8(const Params& p, unsigned char* lds8) {
    unsigned char* ws = lnd(p.ws); EPI8_IDS
    const bf16_t* xb = (const bf16_t*)(ws + R_A); bf16_t* u = (bf16_t*)(ws + R_U);
    for (int iter = 0, rt, ct; tile_map8(iter, 128, 16, rt, ct); ++iter) {
        const int m0 = rt * 256, n0 = ct * 256;
        f32x4 acc[8][4];
        gemm8(xb + (size_t)m0 * 1024, 1024, (const bf16_t*)(ws + W_UP) + (size_t)n0 * 1024, 1024, 1024, acc, lds8);
#pragma unroll
        for (int mi = 0; mi < 8; ++mi) {
            const int row = m0 + wr * 128 + mi * 16 + fr;
#pragma unroll
            for (int q = 0; q < 2; ++q) {
                const int col = n0 + wc * 64 + q * 32 + fq * 8;
                float v[8];
#pragma unroll
                for (int r = 0; r < 4; ++r) { const float a = fmaxf(acc[mi][2 * q][r], 0.f), c = fmaxf(acc[mi][2 * q + 1][r], 0.f); v[r] = a * a; v[4 + r] = c * c; }
                *(u32x4*)(u + (size_t)row * 4096 + col) = pack8(v);
            }
        }
    }
}
__device__ void phase9(const Params& p, unsigned char* lds8) {
    unsigned char* ws = lnd(p.ws);
    const bf16_t* u = (const bf16_t*)(ws + R_U);
    for (int iter = 0, rt, ct; tile_map8(iter, 128, 4, rt, ct); ++iter) {
        const int m0 = rt * 256, n0 = ct * 256;
        f32x4 acc[8][4];
        gemm8(u + (size_t)m0 * 4096, 4096, (const bf16_t*)(ws + W_DN) + (size_t)n0 * 4096, 4096, 4096, acc, lds8);
        epi_residual8(acc, m0, n0, lnd(p.out), lnd(p.out), (bf16_t*)(ws + R_A), (float*)(ws + OFF_SS2), (const float*)(ws + OFF_SS1));
    }
}
__device__ void phase10(const Params& p, unsigned char* lds8) {
    unsigned char* ws = lnd(p.ws); EPI8_IDS
    const bf16_t* xb = (const bf16_t*)(ws + R_A); const bf16_t* pb = (const bf16_t*)(ws + R_PB);
    const float* ss2 = (const float*)(ws + OFF_SS2);
    float* xo = lnd(p.out);
    bf16_t* ppb = (bf16_t*)(ws + R_B);
    for (int iter = 0, rt, ct; tile_map8(iter, 128, 4, rt, ct); ++iter) {
        const int m0 = rt * 256, n0 = ct * 256;
        const int row0 = m0 + wr * 128 + fr, col0 = n0 + wc * 64 + fq * 8;
        f32x4 acc[8][4];
        gemm8(pb + (size_t)m0 * 256, 256, (const bf16_t*)(ws + W_PP) + (size_t)n0 * 256, 256, 256, acc, lds8);
#pragma unroll
        for (int mi = 0; mi < 8; ++mi) {
#pragma unroll
            for (int q = 0; q < 2; ++q) {
                u32x4 o; o.x = pk2(acc[mi][2 * q][0], acc[mi][2 * q][1]); o.y = pk2(acc[mi][2 * q][2], acc[mi][2 * q][3]);
                o.z = pk2(acc[mi][2 * q + 1][0], acc[mi][2 * q + 1][1]); o.w = pk2(acc[mi][2 * q + 1][2], acc[mi][2 * q + 1][3]);
                *(u32x4*)(ppb + (size_t)(row0 + mi * 16) * 1024 + col0 + q * 32) = o;
            }
        }
        gemm8(xb + (size_t)m0 * 1024, 1024, (const bf16_t*)(ws + W_PG) + (size_t)n0 * 1024, 1024, 1024, acc, lds8);
        {
            f32x4 xn[4]; u32x4 pn[2]; float sn;
#pragma unroll
            for (int q = 0; q < 2; ++q) { xn[2 * q] = *(const f32x4*)(xo + (size_t)row0 * DM + col0 + q * 32); xn[2 * q + 1] = *(const f32x4*)(xo + (size_t)row0 * DM + col0 + q * 32 + 4);
                                          pn[q] = *(const u32x4*)(ppb + (size_t)row0 * 1024 + col0 + q * 32); }
            sn = ss2[row0];
#pragma unroll
            for (int mi = 0; mi < 8; ++mi) {
                const int row = row0 + mi * 16;
                f32x4 xc[4]; u32x4 pc[2]; const float rstd = rsqrtf(sn * (1.0f / DM) + RMS_EPS);
#pragma unroll
                for (int i = 0; i < 4; ++i) xc[i] = xn[i];
                pc[0] = pn[0]; pc[1] = pn[1];
                if (mi < 7) {
#pragma unroll
                    for (int q = 0; q < 2; ++q) { xn[2 * q] = *(const f32x4*)(xo + (size_t)(row + 16) * DM + col0 + q * 32); xn[2 * q + 1] = *(const f32x4*)(xo + (size_t)(row + 16) * DM + col0 + q * 32 + 4);
                                                  pn[q] = *(const u32x4*)(ppb + (size_t)(row + 16) * 1024 + col0 + q * 32); }
                    sn = ss2[row + 16];
                }
#pragma unroll
                for (int q = 0; q < 2; ++q) {
                    float pf[8]; unpack8(pc[q], pf);
                    f32x4 v0 = xc[2 * q], v1 = xc[2 * q + 1];
#pragma unroll
                    for (int r = 0; r < 4; ++r) { v0[r] += sigmoidf_(acc[mi][2 * q][r] * rstd) * pf[r]; v1[r] += sigmoidf_(acc[mi][2 * q + 1][r] * rstd) * pf[4 + r]; }
                    *(f32x4*)(xo + (size_t)row * DM + col0 + q * 32) = v0; *(f32x4*)(xo + (size_t)row * DM + col0 + q * 32 + 4) = v1;
                }
            }
        }
    }
}
__device__ void phase11(const Params& p) {
    float* x = lnd(p.out); const float* g = IN(29);
    const int l = tidx() & 63, gw = VB * 4 + (tidx() >> 6), nw = VG * 4;
    for (int row = gw; row < T_TOK; row += nw) {
        float* xr = x + (size_t)row * DM;
        f32x4 v[4]; float ss = 0.f;
#pragma unroll
        for (int i = 0; i < 4; ++i) { v[i] = *(const f32x4*)(xr + i * 256 + l * 4); ss += v[i][0] * v[i][0] + v[i][1] * v[i][1] + v[i][2] * v[i][2] + v[i][3] * v[i][3]; }
        ss = wave_sum(ss);
        const float rs = rsqrtf(ss * (1.0f / DM) + RMS_EPS);
#pragma unroll
        for (int i = 0; i < 4; ++i) { const f32x4 gg = *(const f32x4*)(g + i * 256 + l * 4); *(f32x4*)(xr + i * 256 + l * 4) = v[i] * rs * gg; }
    }
}

extern __shared__ __attribute__((aligned(16))) unsigned char dyn_lds[];
constexpr int DYN_LDS = 131072;
__global__ void __launch_bounds__(512, 2) mega(Params p) {
    unsigned char* lds = dyn_lds + VHALF * 65536;
    __shared__ uint4 xbw;
    __shared__ int s_item[2];
    const bool single = (p.ph_hi - p.ph_lo) > 1;
    if (threadIdx.x == 0) xbw = make_uint4(0u, 0u, 0u, 0u);
    __syncthreads();
    XcdBarrier xb; xb.bar = (unsigned*)(p.ws + OFF_BAR); xb.x = 0; xb.st = (volatile LAS unsigned*)&xbw;
    if (single) xb = xcd_barrier_post((unsigned*)(p.ws + OFF_BAR), (volatile LAS unsigned*)&xbw);
    if (p.ph_lo < 0) cg::this_grid().sync();
#ifndef PROBE_MASK
#define PROBE_MASK 0
#endif
#ifndef PROBE_DUP
#define PROBE_DUP -1
#endif
    for (int ph = p.ph_lo; ph < p.ph_hi; ++ph)
    for (int rep = 0; rep < ((ph == PROBE_DUP || ((PROBE_MASK >> ph) & 1)) ? 2 : 1); ++rep) {
#ifndef ONLY_PH
#define ONLY_PH -1
#endif
#ifndef SKIP_PH
#define SKIP_PH -1
#endif
#define RUNPH(k, call) if ((ONLY_PH < 0 || ONLY_PH == k) && SKIP_PH != k && ph == k) { call; }
        RUNPH(0, phase0(p)) RUNPH(1, phase1(p, dyn_lds)) RUNPH(2, phase2(p)) RUNPH(3, phase3(p, lds)) RUNPH(4, phase4(p, lds, s_item, rep)) RUNPH(5, phase5(p))
        RUNPH(6, phase6(p, dyn_lds)) RUNPH(7, phase7(p, dyn_lds)) RUNPH(8, phase8(p, dyn_lds)) RUNPH(9, phase9(p, dyn_lds)) RUNPH(10, phase10(p, dyn_lds)) RUNPH(11, phase11(p))
        if (ph + 1 < p.ph_hi || rep == 0) xcd_barrier(xb);
    }
}

extern "C" void kernel_launch(void* const* d_in, const int* in_sizes, int n_in, void* d_out, int out_size, void* d_ws, size_t ws_size, hipStream_t stream) {
    static int grid_blocks = 0;
    if (!grid_blocks) {
        int dev = 0, cus = 0, per_cu = 0;
        hipGetDevice(&dev);
        hipDeviceGetAttribute(&cus, hipDeviceAttributeMultiprocessorCount, dev);
        hipFuncSetAttribute((const void*)mega, hipFuncAttributeMaxDynamicSharedMemorySize, DYN_LDS);
        hipOccupancyMaxActiveBlocksPerMultiprocessor(&per_cu, mega, 512, DYN_LDS);
        if (per_cu > 1) per_cu = 1;
        if (per_cu < 1) per_cu = 1;
        grid_blocks = cus * per_cu;
    }
    if (ws_size < WS_NEED) { fprintf(stderr, "workspace too small: %zu < %zu\n", ws_size, (size_t)WS_NEED); return; }
    Params p{};
    for (int i = 0; i < 30; ++i) p.in[i] = (const float*)d_in[i];
    p.out = (float*)d_out; p.ws = (unsigned char*)d_ws;
    hipMemsetAsync(d_ws, 0, ZERO_BYTES, stream);
#if MK_MULTI
    for (int ph = 0; ph < NPH; ++ph) { p.ph_lo = ph; p.ph_hi = ph + 1; hipLaunchKernelGGL(mega, dim3(grid_blocks), dim3(512), DYN_LDS, stream, p); }
#else
    p.ph_lo = 0; p.ph_hi = NPH;
    void* args[] = {&p};
    hipError_t e = hipLaunchCooperativeKernel((void*)mega, dim3(grid_blocks), dim3(512), args, DYN_LDS, stream);
    if (e != hipSuccess) fprintf(stderr, "cooperative launch failed: %s (grid %d)\n", hipGetErrorString(e), grid_blocks);
#endif
}
```

```cpp
#include <hip/hip_runtime.h>
#include <hip/hip_cooperative_groups.h>
#include <stdint.h>
#include <stdio.h>
namespace cg = cooperative_groups;

#ifndef MK_MULTI
#define MK_MULTI 0
#endif

typedef unsigned short bf16_t;
typedef short bf16x8 __attribute__((ext_vector_type(8)));
typedef float f32x4 __attribute__((ext_vector_type(4)));
typedef unsigned u32x4 __attribute__((ext_vector_type(4)));
typedef unsigned u32x2 __attribute__((ext_vector_type(2)));
#define LAS __attribute__((address_space(3)))

constexpr int T_TOK = 32768, SEQ = 8192, DM = 1024;
constexpr int NPH = 12;
constexpr float RMS_EPS = 1e-6f;
constexpr float QSCALE = 0.10206207261596577f * 1.4426950408889634f;

constexpr size_t MiB = 1ull << 20;
constexpr size_t OFF_BAR = 0, OFF_QUEUE = 16384, ZERO_BYTES = 32768;
constexpr size_t OFF_SS1 = 65536, OFF_SS2 = OFF_SS1 + 131072, OFF_RSQ = OFF_SS2 + 131072, OFF_RSKV = OFF_RSQ + 131072;
constexpr size_t OFF_CS = 1 * MiB;
constexpr size_t OFF_W = 5 * MiB;
constexpr size_t W_IN = OFF_W;
constexpr size_t W_UQ = W_IN + 4608ull * 1024 * 2;
constexpr size_t W_KN = W_UQ + 768ull * 384 * 2;
constexpr size_t W_V = W_KN + 512ull * 256 * 2;
constexpr size_t W_OA = W_V + 512ull * 256 * 2;
constexpr size_t W_W2 = W_OA + 1024ull * 512 * 2;
constexpr size_t W_A2 = W_W2 + 512ull * 64 * 2;
constexpr size_t W_G2 = W_A2 + 512ull * 64 * 2;
constexpr size_t W_OB = W_G2 + 512ull * 128 * 2;
constexpr size_t W_OUT = W_OB + 1024ull * 512 * 2;
constexpr size_t W_UP = W_OUT + 1024ull * 1024 * 2;
constexpr size_t W_DN = W_UP + 4096ull * 1024 * 2;
constexpr size_t W_PG = W_DN + 4096ull * 1024 * 2;
constexpr size_t W_PP = W_PG + 1024ull * 1024 * 2;
constexpr size_t W_END = W_PP + 1024ull * 256 * 2;
static_assert(W_END <= 42 * MiB, "weights region");
constexpr size_t R_A = 42 * MiB;
constexpr size_t R_B = 106 * MiB;
constexpr size_t R_C = 148 * MiB;
constexpr size_t R_D = 260 * MiB;
constexpr size_t R_E = 356 * MiB;
constexpr size_t R_F = 388 * MiB;
constexpr size_t R_G = 420 * MiB;
constexpr size_t R_H = 422 * MiB;
constexpr size_t R_I = 454 * MiB;
constexpr size_t R_PB = 486 * MiB;
constexpr size_t WS_NEED = 502 * MiB;
constexpr size_t R_U = R_B;

struct Params {
    const float* in[30];
    float* out;
    unsigned char* ws;
    int ph_lo, ph_hi;
};

#define GAS __attribute__((address_space(1)))
template <class T> __device__ __forceinline__ T* lnd(T* q) { GAS T* g = (GAS T*)q; asm volatile("" : "+s"(g)); return (T*)g; }
#define IN(k) lnd(p.in[k])
#define VHALF ((int)__builtin_amdgcn_readfirstlane((int)(threadIdx.x >> 8)))
#define VB ((int)blockIdx.x * 2 + VHALF)
#define VG ((int)gridDim.x * 2)
__device__ __forceinline__ int tidx512() { int t = threadIdx.x; asm volatile("" : "+v"(t)); return t; }
__device__ __forceinline__ int tidx() { int t = threadIdx.x & 255; asm volatile("" : "+v"(t)); return t; }
__device__ __forceinline__ unsigned f2bf(float f) { unsigned u = __float_as_uint(f); return (u + 0x7fffu + ((u >> 16) & 1u)) >> 16; }
typedef float f32x2_t __attribute__((ext_vector_type(2)));
typedef __bf16 bf16x2_t __attribute__((ext_vector_type(2)));
__device__ __forceinline__ unsigned pk2(float lo, float hi) { f32x2_t v = {lo, hi}; bf16x2_t b = __builtin_convertvector(v, bf16x2_t); return __builtin_bit_cast(unsigned, b); }
__device__ __forceinline__ float bflo(unsigned w) { return __uint_as_float(w << 16); }
__device__ __forceinline__ float bfhi(unsigned w) { return __uint_as_float(w & 0xffff0000u); }
__device__ __forceinline__ float bf1(bf16_t v) { return __uint_as_float((unsigned)v << 16); }
__device__ __forceinline__ void unpack8(const u32x4 w, float (&f)[8]) {
    f[0] = bflo(w.x); f[1] = bfhi(w.x); f[2] = bflo(w.y); f[3] = bfhi(w.y); f[4] = bflo(w.z); f[5] = bfhi(w.z); f[6] = bflo(w.w); f[7] = bfhi(w.w);
}
__device__ __forceinline__ u32x4 pack8(const float (&f)[8]) { u32x4 w; w.x = pk2(f[0], f[1]); w.y = pk2(f[2], f[3]); w.z = pk2(f[4], f[5]); w.w = pk2(f[6], f[7]); return w; }
__device__ __forceinline__ float sigmoidf_(float x) { return __builtin_amdgcn_rcpf(1.0f + __expf(-x)); }
__device__ __forceinline__ float wave_sum(float v) {
#pragma unroll
    for (int o = 32; o >= 1; o >>= 1) v += __shfl_xor(v, o);
    return v;
}
template <int CTRL> __device__ __forceinline__ float dppf(float v) {
    return __int_as_float(__builtin_amdgcn_update_dpp(0, __float_as_int(v), CTRL, 0xf, 0xf, false));
}
__device__ __forceinline__ float row16_sum(float v) {
    v += dppf<0x128>(v); v += dppf<0x124>(v); v += dppf<0x122>(v); v += dppf<0x121>(v); return v;
}

#define XB_TMO      128
#define XB_XCNT(j)  (256  + 64 * (j))
#define XB_XSUB(j)  (1280 + 64 * (j))
#define XB_XGEN(j)  (2304 + 64 * (j))
#define XB_TOP      3328
#define XB_TOPGEN   3392
#define XCD_BAR_WORDS 3456
#define XB_SPIN_CAP (1u << 22)
__device__ __forceinline__ unsigned xb_ld(unsigned* p) { return __hip_atomic_load(p, __ATOMIC_RELAXED, __HIP_MEMORY_SCOPE_AGENT); }
__device__ __forceinline__ unsigned xb_add(unsigned* p, unsigned v) { return __hip_atomic_fetch_add(p, v, __ATOMIC_RELAXED, __HIP_MEMORY_SCOPE_AGENT); }
__device__ __forceinline__ unsigned xb_xcc_id() { return (unsigned)__builtin_amdgcn_s_getreg((3 << 11) | 20) & 0xFu; }
#define XB_SPIN(cond, bar) do { unsigned _sp = 0; while (cond) { __builtin_amdgcn_s_sleep(1); \
    if ((++_sp & 255u) == 0u) { if (xb_ld(&(bar)[XB_TMO])) break; if (_sp > XB_SPIN_CAP) { atomicAdd(&(bar)[XB_TMO], 1u); break; } } } } while (0)
struct XcdBarrier { unsigned* bar; unsigned x; volatile LAS unsigned* st; };
__device__ __forceinline__ XcdBarrier xcd_barrier_post(unsigned* bar, volatile LAS unsigned* st) {
    XcdBarrier b; b.bar = bar; b.x = xb_xcc_id(); b.st = st;
    if (threadIdx.x == 0) (void)xb_add(&bar[XB_XCNT(b.x)], 1u);
    return b;
}
__device__ __forceinline__ void xcd_barrier_complete(unsigned* bar, unsigned x, unsigned& nloc, unsigned& nx) {
    const unsigned G = gridDim.x * gridDim.y * gridDim.z;
    unsigned sum, cnt, mine, sp = 0u;
    for (;;) {
        sum = 0u; cnt = 0u; mine = 0u;
#pragma unroll
        for (unsigned j = 0; j < 16; ++j) { const unsigned c = xb_ld(&bar[XB_XCNT(j)]); sum += c; cnt += (c > 0u) ? 1u : 0u; mine = (j == x) ? c : mine; }
        if (sum == G) break;
        __builtin_amdgcn_s_sleep(1);
        if ((++sp & 255u) == 0u) { if (xb_ld(&bar[XB_TMO])) break; if (sp > XB_SPIN_CAP) { atomicAdd(&bar[XB_TMO], 1u); break; } }
    }
    nloc = mine > 0u ? mine : 1u; nx = cnt > 0u ? cnt : 1u;
}
__device__ __forceinline__ void xcd_barrier(const XcdBarrier& b) {
    asm volatile("s_waitcnt vmcnt(0)" ::: "memory");
    __syncthreads();
    if (threadIdx.x == 0) {
        unsigned* bar = b.bar;
        __builtin_amdgcn_s_waitcnt(0);
        unsigned nloc = b.st[0], nx = b.st[1];
        if (nloc == 0u) { xcd_barrier_complete(bar, b.x, nloc, nx); b.st[0] = nloc; b.st[1] = nx; }
        const unsigned old = xb_add(&bar[XB_XSUB(b.x)], 1u);
        const unsigned gen = old / nloc;
        if (old + 1u == (gen + 1u) * nloc) {
            __builtin_amdgcn_fence(__ATOMIC_RELEASE, "agent");
            asm volatile("s_waitcnt vmcnt(0)" ::: "memory");
            const unsigned og = xb_add(&bar[XB_TOP], 1u);
            const unsigned tg = og / nx;
            if (og + 1u == (tg + 1u) * nx) xb_add(&bar[XB_TOPGEN], 1u);
            else XB_SPIN(xb_ld(&bar[XB_TOPGEN]) == tg, bar);
            __builtin_amdgcn_fence(__ATOMIC_ACQUIRE, "agent");
            xb_add(&bar[XB_XGEN(b.x)], 1u);
            asm volatile("s_waitcnt vmcnt(0)" ::: "memory");
        } else {
            XB_SPIN(xb_ld(&bar[XB_XGEN(b.x)]) == gen, bar);
            __builtin_amdgcn_fence(__ATOMIC_ACQUIRE, "agent");
            asm volatile("s_waitcnt vmcnt(0)" ::: "memory");
        }
    }
    __syncthreads();
}

__device__ __forceinline__ int sw64(int row) { return (0x78 >> (2 * ((row >> 2) & 3))) & 3; }
__device__ __forceinline__ void gemm_core(const bf16_t* A, int lda, const bf16_t* Bt, int ldb, int K, f32x4 (&acc)[4][4], unsigned char* lds) {
    const int tid = tidx(), l = tid & 63, w = __builtin_amdgcn_readfirstlane(tid >> 6), wr = w >> 1, wc = w & 1, fr = l & 15, fq = l >> 4;
#pragma unroll
    for (int i = 0; i < 4; ++i)
#pragma unroll
        for (int j = 0; j < 4; ++j) acc[i][j] = (f32x4){0.f, 0.f, 0.f, 0.f};
    const int nk = K >> 5;
    const int rin = l >> 2, skc = (l & 3) ^ sw64(rin);
    const bf16_t* ga = A + (size_t)(w * 32 + rin) * lda + skc * 8;
    const bf16_t* gb = Bt + (size_t)(w * 32 + rin) * ldb + skc * 8;
    LAS unsigned char* L = (LAS unsigned char*)lds + w * 2048;
    const unsigned aoff = (unsigned)((wr * 64 + fr) * 64 + ((fq ^ sw64(fr)) * 16)), boff = (unsigned)(8192 + (wc * 64 + fr) * 64 + ((fq ^ sw64(fr)) * 16));
#define GC_ISSUE(kt_) do { LAS unsigned char* Ld_ = L + ((kt_) & 3) * 16384; \
        __builtin_amdgcn_global_load_lds((const unsigned*)(ga + (kt_) * 32), (LAS unsigned*)(Ld_), 16, 0, 0); \
        __builtin_amdgcn_global_load_lds((const unsigned*)(ga + (size_t)16 * lda + (kt_) * 32), (LAS unsigned*)(Ld_ + 1024), 16, 0, 0); \
        __builtin_amdgcn_global_load_lds((const unsigned*)(gb + (kt_) * 32), (LAS unsigned*)(Ld_ + 8192), 16, 0, 0); \
        __builtin_amdgcn_global_load_lds((const unsigned*)(gb + (size_t)16 * ldb + (kt_) * 32), (LAS unsigned*)(Ld_ + 8192 + 1024), 16, 0, 0); } while (0)
    const unsigned lbase = (unsigned)(size_t)(LAS unsigned char*)lds;
    asm volatile("s_waitcnt vmcnt(0)" ::: "memory");
    __syncthreads();
    GC_ISSUE(0);
    if (nk > 1) GC_ISSUE(1);
    if (nk > 2) GC_ISSUE(2);
#define GC_RD(dst, addr, OFF) asm volatile("ds_read_b128 %0, %1 offset:" #OFF : "=v"(dst) : "v"(addr) : "memory")
    for (int kt = 0; kt < nk; ++kt) {
        if (kt + 2 < nk) asm volatile("s_waitcnt vmcnt(8)" ::: "memory");
        else if (kt + 1 < nk) asm volatile("s_waitcnt vmcnt(4)" ::: "memory");
        else asm volatile("s_waitcnt vmcnt(0)" ::: "memory");
        __builtin_amdgcn_s_barrier();
        asm volatile("" ::: "memory");
        if (kt + 3 < nk) GC_ISSUE(kt + 3);
        const unsigned sa = lbase + (unsigned)((kt & 3) * 16384) + aoff, sb = lbase + (unsigned)((kt & 3) * 16384) + boff;
        bf16x8 a0, a1, a2, a3, b0, b1, b2, b3;
        GC_RD(a0, sa, 0); GC_RD(b0, sb, 0); GC_RD(a1, sa, 1024); GC_RD(b1, sb, 1024);
        GC_RD(a2, sa, 2048); GC_RD(b2, sb, 2048); GC_RD(a3, sa, 3072); GC_RD(b3, sb, 3072);
#define GC_MMA(mi, ni, A_, B_) acc[mi][ni] = __builtin_amdgcn_mfma_f32_16x16x32_bf16(B_, A_, acc[mi][ni], 0, 0, 0)
        asm volatile("s_waitcnt lgkmcnt(4)" : "+v"(a0), "+v"(a1), "+v"(b0), "+v"(b1) :: "memory");
        GC_MMA(0, 0, a0, b0); GC_MMA(0, 1, a0, b1); GC_MMA(1, 0, a1, b0); GC_MMA(1, 1, a1, b1);
        asm volatile("s_waitcnt lgkmcnt(2)" : "+v"(a2), "+v"(b2) :: "memory");
        GC_MMA(0, 2, a0, b2); GC_MMA(1, 2, a1, b2); GC_MMA(2, 0, a2, b0); GC_MMA(2, 1, a2, b1); GC_MMA(2, 2, a2, b2);
        asm volatile("s_waitcnt lgkmcnt(0)" : "+v"(a3), "+v"(b3) :: "memory");
        GC_MMA(0, 3, a0, b3); GC_MMA(1, 3, a1, b3); GC_MMA(2, 3, a2, b3); GC_MMA(3, 0, a3, b0); GC_MMA(3, 1, a3, b1); GC_MMA(3, 2, a3, b2); GC_MMA(3, 3, a3, b3);
    }
    __syncthreads();
}
__device__ __forceinline__ bool tile_map(int iter, int MT, int NT, int& rt, int& ct) {
    const int G = gridDim.x;
    if ((G & 7) == 0 && (MT & 63) == 0) {
        const int x = blockIdx.x & 7, lb = (blockIdx.x >> 3) * 2 + VHALF, nlb = (G >> 3) * 2, MTx = MT >> 3;
        const int li = lb + iter * nlb;
        if (li >= MTx * NT) return false;
        const int per = 8 * NT, rg = li / per, r = li - rg * per;
        ct = r >> 3; rt = x * MTx + rg * 8 + (r & 7);
        return true;
    }
    const int it = VB + iter * VG;
    if (it >= MT * NT) return false;
    rt = it / NT; ct = it - rt * NT; return true;
}
__device__ __forceinline__ void gemm8(const bf16_t* A, int lda, const bf16_t* Bt, int ldb, int K, f32x4 (&acc)[8][4], unsigned char* lds) {
    const int tid = tidx512(), l = tid & 63, w = __builtin_amdgcn_readfirstlane(tid >> 6), wr = w >> 2, wc = w & 3, fr = l & 15, fq = l >> 4;
#pragma unroll
    for (int i = 0; i < 8; ++i)
#pragma unroll
        for (int j = 0; j < 4; ++j) acc[i][j] = (f32x4){0.f, 0.f, 0.f, 0.f};
    const int nk = K >> 6;
    const int rin = l >> 3, skc = (l & 7) ^ (rin & 7);
    const bf16_t* ga = A + (size_t)(w * 32 + rin) * lda + skc * 8;
    const bf16_t* gb = Bt + (size_t)(w * 32 + rin) * ldb + skc * 8;
    LAS unsigned char* L = (LAS unsigned char*)lds + w * 4096;
#define G8_ISSUE(kt_) do { LAS unsigned char* Ld_ = L + ((kt_) & 1) * 65536; \
        __builtin_amdgcn_global_load_lds((const unsigned*)(ga + (kt_) * 64), (LAS unsigned*)(Ld_), 16, 0, 0); \
        __builtin_amdgcn_global_load_lds((const unsigned*)(ga + (size_t)8 * lda + (kt_) * 64), (LAS unsigned*)(Ld_ + 1024), 16, 0, 0); \
        __builtin_amdgcn_global_load_lds((const unsigned*)(ga + (size_t)16 * lda + (kt_) * 64), (LAS unsigned*)(Ld_ + 2048), 16, 0, 0); \
        __builtin_amdgcn_global_load_lds((const unsigned*)(ga + (size_t)24 * lda + (kt_) * 64), (LAS unsigned*)(Ld_ + 3072), 16, 0, 0); \
        __builtin_amdgcn_global_load_lds((const unsigned*)(gb + (kt_) * 64), (LAS unsigned*)(Ld_ + 32768), 16, 0, 0); \
        __builtin_amdgcn_global_load_lds((const unsigned*)(gb + (size_t)8 * ldb + (kt_) * 64), (LAS unsigned*)(Ld_ + 32768 + 1024), 16, 0, 0); \
        __builtin_amdgcn_global_load_lds((const unsigned*)(gb + (size_t)16 * ldb + (kt_) * 64), (LAS unsigned*)(Ld_ + 32768 + 2048), 16, 0, 0); \
        __builtin_amdgcn_global_load_lds((const unsigned*)(gb + (size_t)24 * ldb + (kt_) * 64), (LAS unsigned*)(Ld_ + 32768 + 3072), 16, 0, 0); } while (0)
    const unsigned lbase = (unsigned)(size_t)(LAS unsigned char*)lds;
    const unsigned arow = (unsigned)((wr * 128 + fr) * 128), brow = (unsigned)(32768 + (wc * 64 + fr) * 128);
    const unsigned sw0 = (unsigned)(((0 + fq) ^ (fr & 7)) * 16), sw1 = (unsigned)(((4 + fq) ^ (fr & 7)) * 16);
    asm volatile("s_waitcnt vmcnt(0)" ::: "memory");
    __syncthreads();
    G8_ISSUE(0);
#define G8_MMA(mi, ni, A_, B_) acc[mi][ni] = __builtin_amdgcn_mfma_f32_16x16x32_bf16(B_, A_, acc[mi][ni], 0, 0, 0)
#define G8_HALF(sa, sb, F1, F2, F3, F4) do { \
        bf16x8 a0, a1, a2, a3, b0, b1, b2, b3, c0, c1, c2, c3; \
        GC_RD(b0, sb, 0); GC_RD(b1, sb, 2048); GC_RD(b2, sb, 4096); GC_RD(b3, sb, 6144); \
        GC_RD(a0, sa, 0); GC_RD(a1, sa, 2048); GC_RD(a2, sa, 4096); GC_RD(a3, sa, 6144); \
        asm volatile("s_waitcnt lgkmcnt(2)" : "+v"(b0), "+v"(b1), "+v"(b2), "+v"(b3), "+v"(a0), "+v"(a1) :: "memory"); \
        G8_MMA(0, 0, a0, b0); G8_MMA(0, 1, a0, b1); G8_MMA(0, 2, a0, b2); G8_MMA(0, 3, a0, b3); \
        G8_MMA(1, 0, a1, b0); G8_MMA(1, 1, a1, b1); G8_MMA(1, 2, a1, b2); G8_MMA(1, 3, a1, b3); \
        F1; \
        asm volatile("s_waitcnt lgkmcnt(0)" : "+v"(a2), "+v"(a3) :: "memory"); \
        G8_MMA(2, 0, a2, b0); G8_MMA(2, 1, a2, b1); G8_MMA(2, 2, a2, b2); G8_MMA(2, 3, a2, b3); \
        G8_MMA(3, 0, a3, b0); G8_MMA(3, 1, a3, b1); G8_MMA(3, 2, a3, b2); G8_MMA(3, 3, a3, b3); \
        GC_RD(c0, sa, 8192); GC_RD(c1, sa, 10240); GC_RD(c2, sa, 12288); GC_RD(c3, sa, 14336); \
        F2; \
        asm volatile("s_waitcnt lgkmcnt(2)" : "+v"(c0), "+v"(c1) :: "memory"); \
        G8_MMA(4, 0, c0, b0); G8_MMA(4, 1, c0, b1); G8_MMA(4, 2, c0, b2); G8_MMA(4, 3, c0, b3); \
        G8_MMA(5, 0, c1, b0); G8_MMA(5, 1, c1, b1); G8_MMA(5, 2, c1, b2); G8_MMA(5, 3, c1, b3); \
        F3; \
        asm volatile("s_waitcnt lgkmcnt(0)" : "+v"(c2), "+v"(c3) :: "memory"); \
        G8_MMA(6, 0, c2, b0); G8_MMA(6, 1, c2, b1); G8_MMA(6, 2, c2, b2); G8_MMA(6, 3, c2, b3); \
        G8_MMA(7, 0, c3, b0); G8_MMA(7, 1, c3, b1); G8_MMA(7, 2, c3, b2); G8_MMA(7, 3, c3, b3); \
        F4; } while (0)
#define G8_PA(kt_, j) __builtin_amdgcn_global_load_lds((const unsigned*)(ga + (size_t)(8 * (j)) * lda + (kt_) * 64), (LAS unsigned*)(L + ((kt_) & 1) * 65536 + 1024 * (j)), 16, 0, 0)
#define G8_PB(kt_, j) __builtin_amdgcn_global_load_lds((const unsigned*)(gb + (size_t)(8 * (j)) * ldb + (kt_) * 64), (LAS unsigned*)(L + ((kt_) & 1) * 65536 + 32768 + 1024 * (j)), 16, 0, 0)
    for (int kt = 0; kt < nk; ++kt) {
        asm volatile("s_waitcnt vmcnt(0)" ::: "memory");
        __builtin_amdgcn_s_barrier();
        asm volatile("" ::: "memory");
        const bool nxt = kt + 1 < nk;
        const unsigned slot = lbase + (unsigned)((kt & 1) * 65536);
        const unsigned sa0 = slot + arow + sw0, sb0 = slot + brow + sw0, sa1 = slot + arow + sw1, sb1 = slot + brow + sw1;
        __builtin_amdgcn_s_setprio(1);
        G8_HALF(sa0, sb0,
                if (nxt) { G8_PA(kt + 1, 0); G8_PB(kt + 1, 0); },
                if (nxt) { G8_PA(kt + 1, 1); G8_PB(kt + 1, 1); },
                if (nxt) { G8_PA(kt + 1, 2); G8_PB(kt + 1, 2); },
                if (nxt) { G8_PA(kt + 1, 3); G8_PB(kt + 1, 3); });
        G8_HALF(sa1, sb1, (void)0, (void)0, (void)0, (void)0);
        __builtin_amdgcn_s_setprio(0);
    }
    __syncthreads();
}
__device__ __forceinline__ bool tile_map8(int iter, int MT, int NT, int& rt, int& ct) {
    const int G = gridDim.x;
    if ((G & 7) == 0 && (MT & 63) == 0) {
        const int x = blockIdx.x & 7, lb = blockIdx.x >> 3, nlb = G >> 3, MTx = MT >> 3;
        const int li = lb + iter * nlb;
        if (li >= MTx * NT) return false;
        const int per = 4 * NT, rg = li / per, r = li - rg * per;
        ct = r >> 2; rt = x * MTx + rg * 4 + (r & 3);
        return true;
    }
    const int it = (int)blockIdx.x + iter * G;
    if (it >= MT * NT) return false;
    rt = it / NT; ct = it - rt * NT; return true;
}
#define EPI8_IDS const int tid_ = tidx512(), l_ = tid_ & 63, w_ = tid_ >> 6, wr = w_ >> 2, wc = w_ & 3, fr = l_ & 15, fq = l_ >> 4; (void)wr; (void)wc; (void)fr; (void)fq;
#define EPI_IDS const int tid_ = tidx(), l_ = tid_ & 63, w_ = tid_ >> 6, wr = w_ >> 1, wc = w_ & 1, fr = l_ & 15, fq = l_ >> 4; (void)wr; (void)wc; (void)fr; (void)fq;

__device__ void transpose_job(const float* __restrict__ W, int K, int ldw, int rows, int mode, int perm, const float* __restrict__ gs, bf16_t* __restrict__ Wt, int gtid, int gthreads) {
    const int nch = rows * (K >> 3), nnb = rows >> 3;
    for (int id = gtid; id < nch; id += gthreads) {
        const int tile = id >> 6, lane = id & 63;
        const int n = (tile % nnb) * 8 + (lane & 7), kc = (tile / nnb) * 8 + (lane >> 3);
        int nn = n;
        if (perm) { const int j = n & 31; nn = (n & ~31) + ((j >> 2) & 3) * 8 + (j >> 4) * 4 + (j & 3); }
        int col = nn;
        if (mode == 1) col = (nn >> 6) * 128 + (nn & 63); else if (mode == 2) col = (nn >> 6) * 128 + 64 + (nn & 63);
        float v[8];
#pragma unroll
        for (int j = 0; j < 8; ++j) { const int k = kc * 8 + j; float x = W[(size_t)k * ldw + col]; if (gs) x *= gs[k]; v[j] = x; }
        *(u32x4*)(Wt + (size_t)n * K + kc * 8) = pack8(v);
    }
}
__device__ void rmsnorm_rows_bf16(const float* __restrict__ x, const float* __restrict__ g, bf16_t* __restrict__ h) {
    const int l = tidx() & 63, gw = VB * 4 + (tidx() >> 6), nw = VG * 4;
    for (int row = gw; row < T_TOK; row += 2 * nw) {
        const int row2 = row + nw; const bool has2 = row2 < T_TOK;
        const float* xr = x + (size_t)row * DM; const float* xr2 = x + (size_t)(has2 ? row2 : row) * DM;
        f32x4 v[4], w[4]; float ss = 0.f, ss2 = 0.f;
#pragma unroll
        for (int i = 0; i < 4; ++i) { v[i] = *(const f32x4*)(xr + i * 256 + l * 4); w[i] = *(const f32x4*)(xr2 + i * 256 + l * 4); }
#pragma unroll
        for (int i = 0; i < 4; ++i) { ss += v[i][0] * v[i][0] + v[i][1] * v[i][1] + v[i][2] * v[i][2] + v[i][3] * v[i][3]; ss2 += w[i][0] * w[i][0] + w[i][1] * w[i][1] + w[i][2] * w[i][2] + w[i][3] * w[i][3]; }
        ss = wave_sum(ss); ss2 = wave_sum(ss2);
        const float rs = rsqrtf(ss * (1.0f / DM) + RMS_EPS), rs2 = rsqrtf(ss2 * (1.0f / DM) + RMS_EPS);
#pragma unroll
        for (int i = 0; i < 4; ++i) {
            const f32x4 gg = *(const f32x4*)(g + i * 256 + l * 4);
            u32x2 o; o.x = pk2(v[i][0] * rs * gg[0], v[i][1] * rs * gg[1]); o.y = pk2(v[i][2] * rs * gg[2], v[i][3] * rs * gg[3]);
            *(u32x2*)(h + (size_t)row * DM + i * 256 + l * 4) = o;
            if (has2) { u32x2 o2; o2.x = pk2(w[i][0] * rs2 * gg[0], w[i][1] * rs2 * gg[1]); o2.y = pk2(w[i][2] * rs2 * gg[2], w[i][3] * rs2 * gg[3]);
                        *(u32x2*)(h + (size_t)row2 * DM + i * 256 + l * 4) = o2; }
        }
    }
}

__device__ void phase0(const Params& p) {
    unsigned char* ws = lnd(p.ws);
    const int gtid = VB * 256 + tidx(), gth = VG * 256;
    transpose_job(IN(4), 1024, 4512, 4512, 0, 1, nullptr, (bf16_t*)(ws + W_IN), gtid, gth);
    transpose_job(IN(6), 384, 768, 768, 0, 0, IN(5), (bf16_t*)(ws + W_UQ), gtid, gth);
    transpose_job(IN(8), 256, 1024, 512, 1, 1, IN(7), (bf16_t*)(ws + W_KN), gtid, gth);
    transpose_job(IN(8), 256, 1024, 512, 2, 0, IN(7), (bf16_t*)(ws + W_V), gtid, gth);
    transpose_job(IN(9), 512, 1024, 1024, 0, 1, nullptr, (bf16_t*)(ws + W_OA), gtid, gth);
    transpose_job(IN(12), 64, 512, 512, 0, 1, nullptr, (bf16_t*)(ws + W_W2), gtid, gth);
    transpose_job(IN(14), 64, 512, 512, 0, 1, nullptr, (bf16_t*)(ws + W_A2), gtid, gth);
    transpose_job(IN(15), 128, 512, 512, 0, 1, nullptr, (bf16_t*)(ws + W_G2), gtid, gth);
    transpose_job(IN(21), 512, 1024, 1024, 0, 1, nullptr, (bf16_t*)(ws + W_OB), gtid, gth);
    transpose_job(IN(22), 1024, 1024, 1024, 0, 1, nullptr, (bf16_t*)(ws + W_OUT), gtid, gth);
    transpose_job(IN(24), 1024, 4096, 4096, 0, 1, IN(23), (bf16_t*)(ws + W_UP), gtid, gth);
    transpose_job(IN(25), 4096, 1024, 1024, 0, 1, nullptr, (bf16_t*)(ws + W_DN), gtid, gth);
    transpose_job(IN(27), 1024, 1024, 1024, 0, 1, IN(26), (bf16_t*)(ws + W_PG), gtid, gth);
    transpose_job(IN(28), 256, 1024, 1024, 0, 1, nullptr, (bf16_t*)(ws + W_PP), gtid, gth);
    {
        const float* pp = IN(1); bf16_t* pb = (bf16_t*)(ws + R_PB);
        for (int id = gtid; id < T_TOK * 256 / 8; id += gth) {
            const f32x4 a = *(const f32x4*)(pp + (size_t)id * 8), b = *(const f32x4*)(pp + (size_t)id * 8 + 4);
            u32x4 o; o.x = pk2(a[0], a[1]); o.y = pk2(a[2], a[3]); o.z = pk2(b[0], b[1]); o.w = pk2(b[2], b[3]);
            *(u32x4*)(pb + (size_t)id * 8) = o;
        }
    }
    { float* z = (float*)(ws + OFF_SS1); for (int id = gtid; id < 2 * T_TOK; id += gth) z[id] = 0.f; }
    rmsnorm_rows_bf16(IN(0), IN(3), (bf16_t*)(ws + R_A));
}

__device__ void phase1(const Params& p, unsigned char* lds8) {
    unsigned char* ws = lnd(p.ws); EPI8_IDS
    const bf16_t* h = (const bf16_t*)(ws + R_A); const bf16_t* Wt = (const bf16_t*)(ws + W_IN);
    bf16_t* zm = (bf16_t*)(ws + R_B); bf16_t* zr = (bf16_t*)(ws + R_C);
    for (int iter = 0, rt, ct; tile_map8(iter, 128, 10, rt, ct); ++iter) {
        const int m0 = rt * 256, n0 = ct * 256;
        f32x4 acc[8][4];
        gemm8(h + (size_t)m0 * 1024, 1024, Wt + (size_t)n0 * 1024, 1024, 1024, acc, lds8);
#pragma unroll
        for (int mi = 0; mi < 8; ++mi) {
            const int row = m0 + wr * 128 + mi * 16 + fr;
#pragma unroll
            for (int q = 0; q < 2; ++q) {
                const int col = n0 + wc * 64 + q * 32 + fq * 8;
                u32x4 o; o.x = pk2(acc[mi][2 * q][0], acc[mi][2 * q][1]); o.y = pk2(acc[mi][2 * q][2], acc[mi][2 * q][3]);
                o.z = pk2(acc[mi][2 * q + 1][0], acc[mi][2 * q + 1][1]); o.w = pk2(acc[mi][2 * q + 1][2], acc[mi][2 * q + 1][3]);
                if (col < 672) *(u32x4*)(zm + (size_t)row * 672 + col) = o;
                else if (col < 2464) *(u32x4*)(zr + (size_t)row * 1792 + (col - 672)) = o;
            }
        }
    }
}

__device__ void phase2(const Params& p) {
    unsigned char* ws = lnd(p.ws);
    const bf16_t* zm = (const bf16_t*)(ws + R_B); const bf16_t* zr = (const bf16_t*)(ws + R_C);
    float* rsq = (float*)(ws + OFF_RSQ); float* rskv = (float*)(ws + OFF_RSKV); float* cs = (float*)(ws + OFF_CS);
    bf16_t* kpe = (bf16_t*)(ws + R_G);
    bf16_t* lin = (bf16_t*)(ws + R_A + 48 * MiB);
    bf16_t* rs = (bf16_t*)(ws + R_D); bf16_t* ks = rs + (size_t)T_TOK * 512; bf16_t* vs = ks + (size_t)T_TOK * 512;
    const float* mu = IN(10); const int* pos = (const int*)IN(2);
    const int l = tidx() & 63, gw = VB * 4 + (tidx() >> 6), nw = VG * 4;
    for (int tok = gw; tok < T_TOK; tok += nw) {
        const bf16_t* zrow = zm + (size_t)tok * 672;
        float sq = 0.f, skv = 0.f;
        {
            float f[8]; unpack8(*(const u32x4*)(zrow + l * 8), f);
            float s = 0.f;
#pragma unroll
            for (int j = 0; j < 8; ++j) s += f[j] * f[j];
            if (l < 48) sq += s; else skv += s;
            if (l < 16) { unpack8(*(const u32x4*)(zrow + (64 + l) * 8), f); s = 0.f;
#pragma unroll
                for (int j = 0; j < 8; ++j) s += f[j] * f[j];
                skv += s; }
        }
        sq = wave_sum(sq); skv = wave_sum(skv);
        if (l == 0) { rsq[tok] = rsqrtf(sq * (1.0f / 384.0f) + RMS_EPS); rskv[tok] = rsqrtf(skv * (1.0f / 256.0f) + RMS_EPS); }
        if (l < 16) {
            const float invf = powf(10000.0f, -(float)l * (1.0f / 16.0f));
            const float ang = (float)pos[tok] * invf;
            float sn, c; sincosf(ang, &sn, &c);
            cs[(size_t)tok * 32 + l] = c; cs[(size_t)tok * 32 + 16 + l] = sn;
            const float x1 = bf1(zrow[640 + l]), x2 = bf1(zrow[656 + l]);
            kpe[(size_t)tok * 32 + l] = (bf16_t)f2bf(x1 * c - x2 * sn);
            kpe[(size_t)tok * 32 + 16 + l] = (bf16_t)f2bf(x2 * c + x1 * sn);
        }
        const bool first = (tok % SEQ) == 0;
        const bf16_t* cur = zr + (size_t)tok * 1792; const bf16_t* prv = cur - 1792;
#pragma unroll
        for (int ps = 0; ps < 4; ++ps) {
            const int ch = ps * 64 + l;
            if (ch < 224) {
                const int c0 = ch * 8;
                float fc[8], fp[8], zs[8];
                unpack8(*(const u32x4*)(cur + c0), fc);
                if (first) {
#pragma unroll
                    for (int j = 0; j < 8; ++j) fp[j] = 0.f;
                } else unpack8(*(const u32x4*)(prv + c0), fp);
                const f32x4 m0 = *(const f32x4*)(mu + c0), m1 = *(const f32x4*)(mu + c0 + 4);
#pragma unroll
                for (int j = 0; j < 8; ++j) { const float m = j < 4 ? m0[j] : m1[j - 4]; zs[j] = fc[j] + (fp[j] - fc[j]) * m; }
                bf16_t* dst;
                if (c0 < 512) dst = rs + (size_t)tok * 512 + c0;
                else if (c0 < 1024) dst = ks + (size_t)tok * 512 + (c0 - 512);
                else if (c0 < 1536) dst = vs + (size_t)tok * 512 + (c0 - 1024);
                else {
                    dst = lin + (size_t)tok * 256 + (c0 - 1536);
                    if (c0 < 1600) {
#pragma unroll
                        for (int j = 0; j < 8; ++j) zs[j] = tanhf(zs[j]);
                    } else if (c0 >= 1664) {
#pragma unroll
                        for (int j = 0; j < 8; ++j) zs[j] = sigmoidf_(zs[j]);
                    }
                }
                *(u32x4*)dst = pack8(zs);
            }
        }
    }
}

__device__ void phase3(const Params& p, unsigned char* lds) {
    unsigned char* ws = lnd(p.ws); EPI_IDS
    const bf16_t* zm = (const bf16_t*)(ws + R_B);
    const bf16_t* lin = (const bf16_t*)(ws + R_A + 48 * MiB);
    const float* rsq = (const float*)(ws + OFF_RSQ); const float* rskv = (const float*)(ws + OFF_RSKV); const float* cs = (const float*)(ws + OFF_CS);
    bf16_t* qb = (bf16_t*)(ws + R_A); bf16_t* kn = (bf16_t*)(ws + R_E); bf16_t* vt = (bf16_t*)(ws + R_F);
    bf16_t* ks = (bf16_t*)(ws + R_D) + (size_t)T_TOK * 512;
    bf16_t* kk = (bf16_t*)(ws + R_C); bf16_t* bb = kk + (size_t)T_TOK * 512; bf16_t* om = bb + (size_t)T_TOK * 512;
    bf16_t* gg = (bf16_t*)(ws + R_H);
    constexpr int N_Q = 256 * 6, N_KN = 256 * 4, N_VT = 4 * 256, N_L = 256 * 4;
    constexpr int TOT = N_Q + N_KN + N_VT + 3 * N_L;
    for (int it = VB; it < TOT; it += VG) {
        f32x4 acc[4][4];
        if (it < N_Q) {
            const int rt = it / 6, ct = it % 6, m0 = rt * 128, n0 = ct * 128;
            gemm_core(zm + (size_t)m0 * 672, 672, (const bf16_t*)(ws + W_UQ) + (size_t)n0 * 384, 384, 384, acc, lds);
            const int G0 = (n0 + wc * 64) >> 4;
#pragma unroll
            for (int mi = 0; mi < 4; ++mi) {
                const int row = m0 + wr * 64 + mi * 16 + fr;
                const float sc = rsq[row] * QSCALE;
#pragma unroll
                for (int np = 0; np < 4; np += 2) {
                    const int r6 = (G0 + np) % 6;
                    f32x4 a = acc[mi][np] * sc, b = acc[mi][np + 1] * sc;
                    if (r6 == 4) {
                        const f32x4 c = *(const f32x4*)(cs + (size_t)row * 32 + fq * 4), s = *(const f32x4*)(cs + (size_t)row * 32 + 16 + fq * 4);
                        const f32x4 o1 = a * c - b * s, o2 = b * c + a * s; a = o1; b = o2;
                    }
                    const int col = n0 + wc * 64 + np * 16 + fq * 4;
                    u32x2 o; o.x = pk2(a[0], a[1]); o.y = pk2(a[2], a[3]); *(u32x2*)(qb + (size_t)row * 768 + col) = o;
                    o.x = pk2(b[0], b[1]); o.y = pk2(b[2], b[3]); *(u32x2*)(qb + (size_t)row * 768 + col + 16) = o;
                }
            }
        } else if (it < N_Q + N_KN) {
            const int i2 = it - N_Q, rt = i2 >> 2, ct = i2 & 3, m0 = rt * 128, n0 = ct * 128;
            gemm_core(zm + (size_t)m0 * 672 + 384, 672, (const bf16_t*)(ws + W_KN) + (size_t)n0 * 256, 256, 256, acc, lds);
#pragma unroll
            for (int mi = 0; mi < 4; ++mi) {
                const int row = m0 + wr * 64 + mi * 16 + fr; const float sc = rskv[row];
#pragma unroll
                for (int q = 0; q < 2; ++q) {
                    const int col = n0 + wc * 64 + q * 32 + fq * 8; const f32x4 a = acc[mi][2 * q] * sc, c = acc[mi][2 * q + 1] * sc;
                    u32x4 o; o.x = pk2(a[0], a[1]); o.y = pk2(a[2], a[3]); o.z = pk2(c[0], c[1]); o.w = pk2(c[2], c[3]);
                    *(u32x4*)(kn + (size_t)row * 512 + col) = o;
                }
            }
        } else if (it < N_Q + N_KN + N_VT) {
            const int i2 = it - N_Q - N_KN, rt = i2 & 3, ct = i2 >> 2, m0 = rt * 128, n0 = ct * 128;
            gemm_core((const bf16_t*)(ws + W_V) + (size_t)m0 * 256, 256, zm + (size_t)n0 * 672 + 384, 672, 256, acc, lds);
#pragma unroll
            for (int ni = 0; ni < 4; ++ni) {
                const int col = n0 + wc * 64 + ni * 16 + fq * 4; const f32x4 sc = *(const f32x4*)(rskv + col);
#pragma unroll
                for (int mi = 0; mi < 4; ++mi) {
                    const int row = m0 + wr * 64 + mi * 16 + fr; const f32x4 a = acc[mi][ni] * sc;
                    u32x2 o; o.x = pk2(a[0], a[1]); o.y = pk2(a[2], a[3]); *(u32x2*)(vt + (size_t)row * T_TOK + col) = o;
                }
            }
        } else {
            const int i2 = it - N_Q - N_KN - N_VT, which = i2 / N_L, i3 = i2 % N_L, rt = i3 >> 2, ct = i3 & 3, m0 = rt * 128, n0 = ct * 128;
            if (which == 0) {
                gemm_core(lin + (size_t)m0 * 256, 256, (const bf16_t*)(ws + W_W2) + (size_t)n0 * 64, 64, 64, acc, lds);
                const float* w0 = IN(11);
#pragma unroll
                for (int q = 0; q < 2; ++q) {
                    const int col = n0 + wc * 64 + q * 32 + fq * 8; const f32x4 w0a = *(const f32x4*)(w0 + col), w0b = *(const f32x4*)(w0 + col + 4);
#pragma unroll
                    for (int mi = 0; mi < 4; ++mi) {
                        const int row = m0 + wr * 64 + mi * 16 + fr; float o8[8];
#pragma unroll
                        for (int r = 0; r < 8; ++r) {
                            const float x = (r < 4 ? w0a[r & 3] : w0b[r & 3]) + (r < 4 ? acc[mi][2 * q][r & 3] : acc[mi][2 * q + 1][r & 3]);
                            const float e = 0.60653065971f * sigmoidf_(x);
                            o8[r] = e * (1.0f - e * (0.5f - e * (0.16666667f - e * (0.041666667f - e * (0.0083333333f - e * (0.0013888889f - e * 0.0001984127f))))));
                        }
                        *(u32x4*)(om + (size_t)row * 512 + col) = pack8(o8);
                    }
                }
            } else if (which == 1) {
                gemm_core(lin + (size_t)m0 * 256 + 64, 256, (const bf16_t*)(ws + W_A2) + (size_t)n0 * 64, 64, 64, acc, lds);
                const float* a0 = IN(13); const float* k_k = IN(16); const float* k_a = IN(17);
#pragma unroll
                for (int mi = 0; mi < 4; ++mi) {
                    const int row = m0 + wr * 64 + mi * 16 + fr;
                    float ksv[2][8], kkr[2][8], al[2][8]; float ss = 0.f;
#pragma unroll
                    for (int q = 0; q < 2; ++q) {
                        const int col = n0 + wc * 64 + q * 32 + fq * 8;
                        unpack8(*(const u32x4*)(ks + (size_t)row * 512 + col), ksv[q]);
                        const f32x4 a0a = *(const f32x4*)(a0 + col), a0b = *(const f32x4*)(a0 + col + 4), kka = *(const f32x4*)(k_k + col), kkb = *(const f32x4*)(k_k + col + 4);
#pragma unroll
                        for (int r = 0; r < 8; ++r) {
                            const float av = r < 4 ? acc[mi][2 * q][r & 3] : acc[mi][2 * q + 1][r & 3];
                            al[q][r] = sigmoidf_((r < 4 ? a0a[r & 3] : a0b[r & 3]) + av);
                            kkr[q][r] = ksv[q][r] * (r < 4 ? kka[r & 3] : kkb[r & 3]); ss += kkr[q][r] * kkr[q][r];
                        }
                    }
                    ss += __shfl_xor(ss, 16); ss += __shfl_xor(ss, 32);
                    const float inv = 1.0f / fmaxf(sqrtf(ss), 1e-12f);
#pragma unroll
                    for (int q = 0; q < 2; ++q) {
                        const int col = n0 + wc * 64 + q * 32 + fq * 8;
                        const f32x4 kaa = *(const f32x4*)(k_a + col), kab = *(const f32x4*)(k_a + col + 4);
                        float k1[8], b1[8], kp[8];
#pragma unroll
                        for (int r = 0; r < 8; ++r) { k1[r] = kkr[q][r] * inv; b1[r] = k1[r] * al[q][r]; kp[r] = ksv[q][r] * (1.0f + (al[q][r] - 1.0f) * (r < 4 ? kaa[r & 3] : kab[r & 3])); }
                        *(u32x4*)(kk + (size_t)row * 512 + col) = pack8(k1);
                        *(u32x4*)(bb + (size_t)row * 512 + col) = pack8(b1);
                        *(u32x4*)(ks + (size_t)row * 512 + col) = pack8(kp);
                    }
                }
            } else {
                gemm_core(lin + (size_t)m0 * 256 + 128, 256, (const bf16_t*)(ws + W_G2) + (size_t)n0 * 128, 128, 128, acc, lds);
#pragma unroll
                for (int mi = 0; mi < 4; ++mi) {
                    const int row = m0 + wr * 64 + mi * 16 + fr;
#pragma unroll
                    for (int q = 0; q < 2; ++q) {
                        const int col = n0 + wc * 64 + q * 32 + fq * 8; const f32x4 a = acc[mi][2 * q], c = acc[mi][2 * q + 1];
                        u32x4 o; o.x = pk2(a[0], a[1]); o.y = pk2(a[2], a[3]); o.z = pk2(c[0], c[1]); o.w = pk2(c[2], c[3]);
                        *(u32x4*)(gg + (size_t)row * 512 + col) = o;
                    }
                }
            }
        }
    }
}

struct HalfBar { unsigned addr; unsigned target; };
__device__ __forceinline__ void hb_sync(HalfBar& hb) {
    asm volatile("s_waitcnt lgkmcnt(0)" ::: "memory");
    hb.target += 4u;
    const int lane = threadIdx.x & 63;
    if (lane == 0) asm volatile("ds_add_u32 %0, %1" :: "v"(hb.addr), "v"(1u) : "memory");
    for (;;) {
        unsigned v;
        asm volatile("ds_read_b32 %0, %1\n\ts_waitcnt lgkmcnt(0)" : "=v"(v) : "v"(hb.addr) : "memory");
        if ((int)(__builtin_amdgcn_readfirstlane(v) - hb.target) >= 0) break;
        __builtin_amdgcn_s_sleep(1);
    }
    asm volatile("" ::: "memory");
}
#define SCAN_BAR() do { asm volatile("s_waitcnt lgkmcnt(0)" ::: "memory"); __builtin_amdgcn_s_barrier(); asm volatile("" ::: "memory"); } while (0)
constexpr int SCAN_CH = 32;
constexpr int SCAN_NBAR = 2 + (SEQ / SCAN_CH);
__device__ void scan_consumer(const Params& p, int si, unsigned char* lds) {
    unsigned char* ws = lnd(p.ws);
    const int chain = si >> 2, rg = si & 3, b = chain >> 3, h = chain & 7;
    const int tid = tidx(), w = tid >> 6, l = tid & 63, rowA = w * 4 + (l >> 4), kg = l & 15;
    const bf16_t* rs = (const bf16_t*)(ws + R_D); const bf16_t* ks = rs + (size_t)T_TOK * 512; const bf16_t* vs = ks + (size_t)T_TOK * 512;
    const bf16_t* kk = (const bf16_t*)(ws + R_C); const bf16_t* bb = kk + (size_t)T_TOK * 512; const bf16_t* om = bb + (size_t)T_TOK * 512;
    bf16_t* yo = (bf16_t*)(ws + R_I);
    float* ops = (float*)lds;
    float* vb = (float*)(lds + 81920);
    float* yb = (float*)(lds + 86016);
    const size_t tokb = (size_t)b * SEQ;
    const int lrem = tid & 127, lstep = lrem >> 3, lpart = lrem & 7, lhalf = tid >> 7;
    const bf16_t* sp0 = (lhalf ? om : kk) + (tokb + lstep) * 512 + h * 64 + lpart * 8;
    const bf16_t* sp1 = (lhalf ? ks : bb) + (tokb + lstep) * 512 + h * 64 + lpart * 8;
    const bf16_t* sp2 = rs + (tokb + lstep) * 512 + h * 64 + lpart * 8;
    const bf16_t* spv = vs + (tokb + ((tid & 31) >> 1)) * 512 + h * 64 + rg * 16 + (tid & 1) * 8;
    const int ldst0 = lstep * 320 + lhalf * 64 + lpart * 8, ldst1 = lstep * 320 + (2 + lhalf) * 64 + lpart * 8, ldst2 = lstep * 320 + 256 + lpart * 8;
    (void)sp0; (void)sp1; (void)sp2; (void)spv; (void)ldst0; (void)ldst1; (void)ldst2;
    constexpr int NCH = SEQ / SCAN_CH;
    const unsigned lds_ops = (unsigned)(size_t)(LAS unsigned char*)lds, lds_vb = lds_ops + 81920u, lds_yb = lds_ops + 86016u;
#define SC_RD(KK, DD, NB, K_, RR, VV, PA, PV, ST) do { \
        asm volatile("ds_read_b128 %0, %1 offset:%2" : "=v"(KK) : "v"(PA), "i"((ST) * 1280) : "memory"); \
        asm volatile("ds_read_b128 %0, %1 offset:%2" : "=v"(DD) : "v"(PA), "i"((ST) * 1280 + 256) : "memory"); \
        asm volatile("ds_read_b128 %0, %1 offset:%2" : "=v"(NB) : "v"(PA), "i"((ST) * 1280 + 512) : "memory"); \
        asm volatile("ds_read_b128 %0, %1 offset:%2" : "=v"(K_) : "v"(PA), "i"((ST) * 1280 + 768) : "memory"); \
        asm volatile("ds_read_b128 %0, %1 offset:%2" : "=v"(RR) : "v"(PA), "i"((ST) * 1280 + 1024) : "memory"); \
        asm volatile("ds_read_b32 %0, %1 offset:%2" : "=v"(VV) : "v"(PV), "i"((ST) * 64) : "memory"); } while (0)
#define SC_WAIT(N, KK, DD, NB, K_, RR, VV) asm volatile("s_waitcnt lgkmcnt(" #N ")" : "+v"(KK), "+v"(DD), "+v"(NB), "+v"(K_), "+v"(RR), "+v"(VV) :: "memory")
    typedef float f32x2 __attribute__((ext_vector_type(2)));
    f32x2 S01 = {0.f, 0.f}, S23 = {0.f, 0.f};
#define SC_STEP(ST, CKK, CD, CNB, CK, CR, CV, NKK, ND, NNB, NK, NR, NV, WN) do { \
        f32x2 u_ = {0.f, 0.f}; \
        if ((ST) > 0) { u_ = S01 * NR.xy; u_ = S23 * NR.zw + u_; } \
        if ((ST) < 31) SC_RD(NKK, ND, NNB, NK, NR, NV, pa, pv, (ST) + 1); \
        SC_WAIT(WN, CKK, CD, CNB, CK, CR, CV); \
        f32x2 t_ = S01 * CKK.xy; t_ = S23 * CKK.zw + t_; \
        float sa_ = t_.x + t_.y; \
        const f32x2 W01_ = S01 * CD.xy + CK.xy * CV, W23_ = S23 * CD.zw + CK.zw * CV; \
        float y_ = u_.x + u_.y; \
        sa_ += dppf<0x128>(sa_); sa_ += dppf<0x124>(sa_); \
        if ((ST) > 0) y_ += dppf<0x128>(y_); \
        sa_ += dppf<0x122>(sa_); sa_ += dppf<0x121>(sa_); \
        S01 = CNB.xy * sa_ + W01_; S23 = CNB.zw * sa_ + W23_; \
        if ((ST) > 0) asm volatile("ds_write_b32 %0, %1 offset:%2" :: "v"(pw), "v"(y_), "i"(((ST) > 0 ? (ST) - 1 : 0) * 512) : "memory"); } while (0)
    SCAN_BAR();
    SCAN_BAR();
    for (int c = 0; c < NCH; ++c) {
        const int buf = c & 1;
        const unsigned pa = lds_ops + (unsigned)(buf * 40960 + kg * 16), pv = lds_vb + (unsigned)(buf * 2048 + rowA * 4);
        const unsigned pw = lds_yb + (unsigned)(buf * 16384 + (rowA * 8 + (kg & 7)) * 4);
        f32x4 akk, ad, anb, ak, ar, bkk, bd, bnb, bk, br; float av, bv;
        SC_RD(akk, ad, anb, ak, ar, av, pa, pv, 0);
        SC_STEP(0, akk, ad, anb, ak, ar, av, bkk, bd, bnb, bk, br, bv, 6);
        SC_STEP(1, bkk, bd, bnb, bk, br, bv, akk, ad, anb, ak, ar, av, 6);
        SC_STEP(2, akk, ad, anb, ak, ar, av, bkk, bd, bnb, bk, br, bv, 7);
        SC_STEP(3, bkk, bd, bnb, bk, br, bv, akk, ad, anb, ak, ar, av, 7);
        SC_STEP(4, akk, ad, anb, ak, ar, av, bkk, bd, bnb, bk, br, bv, 7);
        SC_STEP(5, bkk, bd, bnb, bk, br, bv, akk, ad, anb, ak, ar, av, 7);
        SC_STEP(6, akk, ad, anb, ak, ar, av, bkk, bd, bnb, bk, br, bv, 7);
        SC_STEP(7, bkk, bd, bnb, bk, br, bv, akk, ad, anb, ak, ar, av, 7);
        SC_STEP(8, akk, ad, anb, ak, ar, av, bkk, bd, bnb, bk, br, bv, 7);
        SC_STEP(9, bkk, bd, bnb, bk, br, bv, akk, ad, anb, ak, ar, av, 7);
        SC_STEP(10, akk, ad, anb, ak, ar, av, bkk, bd, bnb, bk, br, bv, 7);
        SC_STEP(11, bkk, bd, bnb, bk, br, bv, akk, ad, anb, ak, ar, av, 7);
        SC_STEP(12, akk, ad, anb, ak, ar, av, bkk, bd, bnb, bk, br, bv, 7);
        SC_STEP(13, bkk, bd, bnb, bk, br, bv, akk, ad, anb, ak, ar, av, 7);
        SC_STEP(14, akk, ad, anb, ak, ar, av, bkk, bd, bnb, bk, br, bv, 7);
        SC_STEP(15, bkk, bd, bnb, bk, br, bv, akk, ad, anb, ak, ar, av, 7);
        SC_STEP(16, akk, ad, anb, ak, ar, av, bkk, bd, bnb, bk, br, bv, 7);
        SC_STEP(17, bkk, bd, bnb, bk, br, bv, akk, ad, anb, ak, ar, av, 7);
        SC_STEP(18, akk, ad, anb, ak, ar, av, bkk, bd, bnb, bk, br, bv, 7);
        SC_STEP(19, bkk, bd, bnb, bk, br, bv, akk, ad, anb, ak, ar, av, 7);
        SC_STEP(20, akk, ad, anb, ak, ar, av, bkk, bd, bnb, bk, br, bv, 7);
        SC_STEP(21, bkk, bd, bnb, bk, br, bv, akk, ad, anb, ak, ar, av, 7);
        SC_STEP(22, akk, ad, anb, ak, ar, av, bkk, bd, bnb, bk, br, bv, 7);
        SC_STEP(23, bkk, bd, bnb, bk, br, bv, akk, ad, anb, ak, ar, av, 7);
        SC_STEP(24, akk, ad, anb, ak, ar, av, bkk, bd, bnb, bk, br, bv, 7);
        SC_STEP(25, bkk, bd, bnb, bk, br, bv, akk, ad, anb, ak, ar, av, 7);
        SC_STEP(26, akk, ad, anb, ak, ar, av, bkk, bd, bnb, bk, br, bv, 7);
        SC_STEP(27, bkk, bd, bnb, bk, br, bv, akk, ad, anb, ak, ar, av, 7);
        SC_STEP(28, akk, ad, anb, ak, ar, av, bkk, bd, bnb, bk, br, bv, 7);
        SC_STEP(29, bkk, bd, bnb, bk, br, bv, akk, ad, anb, ak, ar, av, 7);
        SC_STEP(30, akk, ad, anb, ak, ar, av, bkk, bd, bnb, bk, br, bv, 7);
        SC_STEP(31, bkk, bd, bnb, bk, br, bv, akk, ad, anb, ak, ar, av, 1);
        {
            f32x2 u_ = S01 * br.xy; u_ = S23 * br.zw + u_;
            float y_ = u_.x + u_.y; y_ += dppf<0x128>(y_);
            asm volatile("ds_write_b32 %0, %1 offset:%2" :: "v"(pw), "v"(y_), "i"(31 * 512) : "memory");
        }
        asm volatile("s_waitcnt lgkmcnt(0)" ::: "memory");
        SCAN_BAR();
#pragma unroll
        for (int hh = 0; hh < 2; ++hh) {
            const int st = (tid >> 4) + 16 * hh, r = tid & 15;
            const float* yr = yb + buf * 4096 + st * 128 + r * 8;
            const f32x4 a0 = *(const f32x4*)(yr), a1 = *(const f32x4*)(yr + 4);
            const f32x4 sm = a0 + a1;
            const float y = (sm[0] + sm[1]) + (sm[2] + sm[3]);
            const unsigned short yv = (unsigned short)f2bf(y);
            const bf16_t* ya = yo + (tokb + (size_t)c * SCAN_CH + st) * 512 + h * 64 + rg * 16 + r;
            asm volatile("global_store_short %0, %1, off" :: "v"(ya), "v"((unsigned)yv) : "memory");
        }
    }
    asm volatile("s_waitcnt vmcnt(0)" ::: "memory");
}
__device__ void scan_producer(const Params& p, int si, unsigned char* lds) {
    unsigned char* ws = lnd(p.ws);
    const int chain = si >> 2, rg = si & 3, b = chain >> 3, h = chain & 7;
    const int tid = tidx(), w = tid >> 6, l = tid & 63, rowA = w * 4 + (l >> 4), kg = l & 15;
    const bf16_t* rs = (const bf16_t*)(ws + R_D); const bf16_t* ks = rs + (size_t)T_TOK * 512; const bf16_t* vs = ks + (size_t)T_TOK * 512;
    const bf16_t* kk = (const bf16_t*)(ws + R_C); const bf16_t* bb = kk + (size_t)T_TOK * 512; const bf16_t* om = bb + (size_t)T_TOK * 512;
    bf16_t* yo = (bf16_t*)(ws + R_I);
    float* ops = (float*)lds;
    float* vb = (float*)(lds + 81920);
    float* yb = (float*)(lds + 86016);
    const size_t tokb = (size_t)b * SEQ;
    const int lrem = tid & 127, lstep = lrem >> 3, lpart = lrem & 7, lhalf = tid >> 7;
    const bf16_t* sp0 = (lhalf ? om : kk) + (tokb + lstep) * 512 + h * 64 + lpart * 8;
    const bf16_t* sp1 = (lhalf ? ks : bb) + (tokb + lstep) * 512 + h * 64 + lpart * 8;
    const bf16_t* sp2 = rs + (tokb + lstep) * 512 + h * 64 + lpart * 8;
    const bf16_t* spv = vs + (tokb + ((tid & 31) >> 1)) * 512 + h * 64 + rg * 16 + (tid & 1) * 8;
    const int ldst0 = lstep * 320 + lhalf * 64 + lpart * 8, ldst1 = lstep * 320 + (2 + lhalf) * 64 + lpart * 8, ldst2 = lstep * 320 + 256 + lpart * 8;
    struct GSet { u32x4 g0, g1, g2, gv, h0, h1, h2, hv; };
    GSet RA, RB, RC;
    auto gload = [&](int c, GSet& R) {
        const size_t o = (size_t)c * SCAN_CH * 512 * 2, o2 = o + (size_t)16 * 512 * 2;
        const char* q0 = (const char*)sp0 + o; const char* q1 = (const char*)sp1 + o; const char* q2 = (const char*)sp2 + o; const char* q3 = (const char*)spv + o;
        const char* r0 = (const char*)sp0 + o2; const char* r1 = (const char*)sp1 + o2; const char* r2 = (const char*)sp2 + o2; const char* r3 = (const char*)spv + o2;
        asm volatile("global_load_dwordx4 %0, %1, off" : "=v"(R.g0) : "v"(q0) : "memory");
        asm volatile("global_load_dwordx4 %0, %1, off" : "=v"(R.g1) : "v"(q1) : "memory");
        asm volatile("global_load_dwordx4 %0, %1, off" : "=v"(R.g2) : "v"(q2) : "memory");
        asm volatile("global_load_dwordx4 %0, %1, off" : "=v"(R.gv) : "v"(q3) : "memory");
        asm volatile("global_load_dwordx4 %0, %1, off" : "=v"(R.h0) : "v"(r0) : "memory");
        asm volatile("global_load_dwordx4 %0, %1, off" : "=v"(R.h1) : "v"(r1) : "memory");
        asm volatile("global_load_dwordx4 %0, %1, off" : "=v"(R.h2) : "v"(r2) : "memory");
        asm volatile("global_load_dwordx4 %0, %1, off" : "=v"(R.hv) : "v"(r3) : "memory");
    };
    auto lstore1 = [&](int buf, int sub, const u32x4& x0, const u32x4& x1, const u32x4& x2, const u32x4& xv) {
        float f[8]; float* ob = ops + buf * 10240 + sub * 5120;
        unpack8(x0, f);
        if (lhalf) {
#pragma unroll
            for (int j = 0; j < 8; ++j) f[j] = 1.0f - f[j];
        }
        *(f32x4*)(ob + ldst0) = (f32x4){f[0], f[1], f[2], f[3]}; *(f32x4*)(ob + ldst0 + 4) = (f32x4){f[4], f[5], f[6], f[7]};
        unpack8(x1, f);
        if (!lhalf) {
#pragma unroll
            for (int j = 0; j < 8; ++j) f[j] = -f[j];
        }
        *(f32x4*)(ob + ldst1) = (f32x4){f[0], f[1], f[2], f[3]}; *(f32x4*)(ob + ldst1 + 4) = (f32x4){f[4], f[5], f[6], f[7]};
        if (tid < 128) { unpack8(x2, f); *(f32x4*)(ob + ldst2) = (f32x4){f[0], f[1], f[2], f[3]}; *(f32x4*)(ob + ldst2 + 4) = (f32x4){f[4], f[5], f[6], f[7]}; }
        if (tid < 32) { unpack8(xv, f); float* vd = vb + buf * 512 + sub * 256 + (tid >> 1) * 16 + (tid & 1) * 8;
            *(f32x4*)(vd) = (f32x4){f[0], f[1], f[2], f[3]}; *(f32x4*)(vd + 4) = (f32x4){f[4], f[5], f[6], f[7]}; }
    };
    auto lstore = [&](int buf, const GSet& R) { lstore1(buf, 0, R.g0, R.g1, R.g2, R.gv); lstore1(buf, 1, R.h0, R.h1, R.h2, R.hv); };
#define SC_VWAIT(N, R) asm volatile("s_waitcnt vmcnt(" #N ")" : "+v"(R.g0), "+v"(R.g1), "+v"(R.g2), "+v"(R.gv), "+v"(R.h0), "+v"(R.h1), "+v"(R.h2), "+v"(R.hv) :: "memory")
    constexpr int NCH = SEQ / SCAN_CH;
    (void)yo; (void)yb; (void)rowA; (void)kg;
    asm volatile("s_waitcnt vmcnt(0)" ::: "memory");
    SCAN_BAR();
    gload(0, RA); SC_VWAIT(0, RA); lstore(0, RA);
    gload(1, RB); gload(2, RC); gload(3, RA);
    SCAN_BAR();
    auto do_chunk = [&](int c, GSet& NX) {
        const int buf = c & 1;
        if (c + 1 < NCH) { SC_VWAIT(16, NX); lstore(buf ^ 1, NX); }
        SCAN_BAR();
        gload(c + 4 < NCH ? c + 4 : NCH - 1, NX);
    };
    for (int c = 0; c < NCH; c += 3) {
        do_chunk(c, RB);
        if (c + 1 < NCH) do_chunk(c + 1, RC);
        if (c + 2 < NCH) do_chunk(c + 2, RA);
    }
    asm volatile("s_waitcnt vmcnt(0)" ::: "memory");
}

__device__ __forceinline__ int pe_sw(int row) { return (0x78 >> (2 * ((row >> 2) & 3))) & 3; }
__device__ void attn_unit(const Params& p, int b, int h, int qblk, unsigned char* lds) {
    unsigned char* ws = lnd(p.ws);
    const bf16_t* Q = (const bf16_t*)(ws + R_A); const bf16_t* KN = (const bf16_t*)(ws + R_E); const bf16_t* VT = (const bf16_t*)(ws + R_F);
    const bf16_t* KP = (const bf16_t*)(ws + R_G); bf16_t* O = (bf16_t*)(ws + R_B);
    const int tid = tidx(), w = tid >> 6, l = tid & 63, fr = l & 15, g = l >> 4;
    const size_t tokb = (size_t)b * SEQ;
    const int q0 = qblk * 128 + w * 32;
    constexpr int BUFB = 21504, KP_OFF = 8192, VT_OFF = 12288;
    bf16x8 qf[2][3];
#pragma unroll
    for (int qi = 0; qi < 2; ++qi)
#pragma unroll
        for (int s = 0; s < 3; ++s) qf[qi][s] = *(const bf16x8*)(Q + (tokb + q0 + qi * 16 + fr) * 768 + h * 96 + s * 32 + g * 8);
    f32x4 o[4][2];
#pragma unroll
    for (int i = 0; i < 4; ++i) { o[i][0] = (f32x4){0.f, 0.f, 0.f, 0.f}; o[i][1] = (f32x4){0.f, 0.f, 0.f, 0.f}; }
    float mrun[2] = {-1e30f, -1e30f}, lsum[2] = {0.f, 0.f};
    const int ntiles = 2 * qblk + 2;
    const int kkey = tid >> 3, kkc = tid & 7;
    const int pkey = tid >> 2, pkc = tid & 3;
    const bf16_t* gkn = KN + (tokb + kkey) * 512 + h * 64 + kkc * 8;
    const bf16_t* gkp = KP + (tokb + pkey) * 32 + pkc * 8;
    const bf16_t* gvt = VT + ((size_t)h * 64 + kkey) * T_TOK + tokb + kkc * 8;
    const unsigned dkn = (unsigned)(kkey * 128 + ((kkc ^ (kkey & 7)) * 16));
    const unsigned dkp = (unsigned)(KP_OFF + pkey * 64 + ((pkc ^ pe_sw(pkey)) * 16));
    const unsigned dvt = (unsigned)(VT_OFF + kkey * 144 + kkc * 16);
    struct KVSet { u32x4 rk0, rk1, rp, rv0, rv1; };
    KVSet SA, SB;
    auto gload = [&](int kt, KVSet& R) {
        R.rk0 = *(const u32x4*)(gkn + (size_t)kt * 64 * 512); R.rk1 = *(const u32x4*)(gkn + ((size_t)kt * 64 + 32) * 512);
        R.rp = *(const u32x4*)(gkp + (size_t)kt * 64 * 32);
        R.rv0 = *(const u32x4*)(gvt + kt * 64); R.rv1 = *(const u32x4*)(gvt + (size_t)32 * T_TOK + kt * 64);
    };
    auto lstore = [&](int buf, const KVSet& R) {
        unsigned char* d = lds + buf * BUFB;
        *(u32x4*)(d + dkn) = R.rk0; *(u32x4*)(d + dkn + 32 * 128) = R.rk1; *(u32x4*)(d + dkp) = R.rp;
        *(u32x4*)(d + dvt) = R.rv0; *(u32x4*)(d + dvt + 32 * 144) = R.rv1;
    };
    const unsigned kfo0 = (unsigned)(fr * 128 + (((0 + g) ^ (fr & 7)) * 16)), kfo1 = (unsigned)(fr * 128 + (((4 + g) ^ (fr & 7)) * 16));
    const unsigned kfo2 = (unsigned)(KP_OFF + fr * 64 + ((g ^ pe_sw(fr)) * 16));
    const unsigned vfo = (unsigned)(VT_OFF + fr * 144 + g * 8);
    __syncthreads();
    gload(0, SA); lstore(0, SA);
    gload(1, SB);
    __syncthreads();
    auto tile_body = [&](int kt, const KVSet& NXT, KVSet& FREE) {
        const unsigned char* d = lds + (kt & 1) * BUFB;
        if (kt + 2 < ntiles) gload(kt + 2, FREE);
        f32x4 s_[4][2];
#pragma unroll
        for (int j = 0; j < 4; ++j) {
            const bf16x8 k0 = *(const bf16x8*)(d + kfo0 + j * 2048), k1 = *(const bf16x8*)(d + kfo1 + j * 2048), k2 = *(const bf16x8*)(d + kfo2 + j * 1024);
#pragma unroll
            for (int qi = 0; qi < 2; ++qi) {
                f32x4 a = {0.f, 0.f, 0.f, 0.f};
                a = __builtin_amdgcn_mfma_f32_16x16x32_bf16(k0, qf[qi][0], a, 0, 0, 0);
                a = __builtin_amdgcn_mfma_f32_16x16x32_bf16(k1, qf[qi][1], a, 0, 0, 0);
                a = __builtin_amdgcn_mfma_f32_16x16x32_bf16(k2, qf[qi][2], a, 0, 0, 0);
                s_[j][qi] = a;
            }
        }
        if (kt * 64 + 63 > q0) {
#pragma unroll
            for (int j = 0; j < 4; ++j)
#pragma unroll
                for (int qi = 0; qi < 2; ++qi)
#pragma unroll
                    for (int r = 0; r < 4; ++r) { const int key = kt * 64 + j * 16 + g * 4 + r, q = q0 + qi * 16 + fr; if (key > q) s_[j][qi][r] = -1e30f; }
        }
        bf16x8 pf[2][2];
#pragma unroll
        for (int qi = 0; qi < 2; ++qi) {
            float mx = -1e30f;
#pragma unroll
            for (int j = 0; j < 4; ++j) mx = fmaxf(mx, fmaxf(fmaxf(s_[j][qi][0], s_[j][qi][1]), fmaxf(s_[j][qi][2], s_[j][qi][3])));
            mx = fmaxf(mx, __shfl_xor(mx, 16)); mx = fmaxf(mx, __shfl_xor(mx, 32));
            const float mn = fmaxf(mrun[qi], mx);
            const float alpha = __builtin_amdgcn_exp2f(mrun[qi] - mn);
            mrun[qi] = mn;
            float psum = 0.f;
#pragma unroll
            for (int j = 0; j < 4; ++j)
#pragma unroll
                for (int r = 0; r < 4; ++r) { const float pv = __builtin_amdgcn_exp2f(s_[j][qi][r] - mn); s_[j][qi][r] = pv; psum += pv; }
            lsum[qi] = lsum[qi] * alpha + psum;
#pragma unroll
            for (int dt = 0; dt < 4; ++dt) o[dt][qi] = o[dt][qi] * alpha;
#pragma unroll
            for (int ksx = 0; ksx < 2; ++ksx) {
                u32x4 pw; pw.x = pk2(s_[2 * ksx][qi][0], s_[2 * ksx][qi][1]); pw.y = pk2(s_[2 * ksx][qi][2], s_[2 * ksx][qi][3]);
                pw.z = pk2(s_[2 * ksx + 1][qi][0], s_[2 * ksx + 1][qi][1]); pw.w = pk2(s_[2 * ksx + 1][qi][2], s_[2 * ksx + 1][qi][3]);
                pf[ksx][qi] = __builtin_bit_cast(bf16x8, pw);
            }
        }
#pragma unroll
        for (int ksx = 0; ksx < 2; ++ksx)
#pragma unroll
            for (int dt = 0; dt < 4; ++dt) {
                const u32x2 v0 = *(const u32x2*)(d + vfo + dt * 16 * 144 + ksx * 64), v1 = *(const u32x2*)(d + vfo + dt * 16 * 144 + ksx * 64 + 32);
                u32x4 vw; vw.x = v0.x; vw.y = v0.y; vw.z = v1.x; vw.w = v1.y;
                const bf16x8 vf = __builtin_bit_cast(bf16x8, vw);
                o[dt][0] = __builtin_amdgcn_mfma_f32_16x16x32_bf16(vf, pf[ksx][0], o[dt][0], 0, 0, 0);
                o[dt][1] = __builtin_amdgcn_mfma_f32_16x16x32_bf16(vf, pf[ksx][1], o[dt][1], 0, 0, 0);
            }
        if (kt + 1 < ntiles) lstore((kt + 1) & 1, NXT);
        __syncthreads();
    };
    for (int kt = 0; kt < ntiles; kt += 2) { tile_body(kt, SB, SA); tile_body(kt + 1, SA, SB); }
#pragma unroll
    for (int qi = 0; qi < 2; ++qi) {
        float lt = lsum[qi]; lt += __shfl_xor(lt, 16); lt += __shfl_xor(lt, 32);
        const float inv = 1.0f / lt;
        const size_t tok = tokb + q0 + qi * 16 + fr;
#pragma unroll
        for (int dt = 0; dt < 4; ++dt) {
            const f32x4 v = o[dt][qi] * inv;
            u32x2 ow; ow.x = pk2(v[0], v[1]); ow.y = pk2(v[2], v[3]);
            *(u32x2*)(O + tok * 512 + h * 64 + dt * 16 + g * 4) = ow;
        }
    }
}

__device__ void phase4(const Params& p, unsigned char* lds, int* s_item, int rep) {
    if (VHALF == 0) {
        for (int si = blockIdx.x; si < 128; si += gridDim.x) {
            __builtin_amdgcn_s_setprio(3);
            scan_consumer(p, si, lds);
            __builtin_amdgcn_s_setprio(0);
        }
    } else {
        for (int si = blockIdx.x; si < 128; si += gridDim.x) scan_producer(p, si, lds - 65536);
    }
    unsigned* queue = (unsigned*)(p.ws + OFF_QUEUE) + 512 * rep;
    const int myx = (int)(xb_xcc_id() & 7u);
    for (;;) {
        __syncthreads();
        if (threadIdx.x == 0) {
            int code = -1;
            for (int k = 0; k < 8; ++k) {
                const int xx = (myx + k) & 7;
                const unsigned it = atomicAdd(queue + xx * 16, 2u);
                if (it < 256u) { code = xx * 256 + (int)it; break; }
            }
            s_item[0] = code;
        }
        __syncthreads();
        const int code = s_item[0];
        if (code < 0) break;
        const int h = code >> 8, it = (code & 255) + VHALF;
        const int qblk = 63 - (it >> 2), b = it & 3;
        attn_unit(p, b, h, qblk, lds);
    }
}

__device__ void phase5(const Params& p) {
    unsigned char* ws = lnd(p.ws);
    const bf16_t* rs = (const bf16_t*)(ws + R_D); const bf16_t* ks = rs + (size_t)T_TOK * 512; const bf16_t* vs = ks + (size_t)T_TOK * 512;
    const bf16_t* yv = (const bf16_t*)(ws + R_I); const bf16_t* gg = (const bf16_t*)(ws + R_H);
    bf16_t* ybp = (bf16_t*)(ws + R_C);
    const float* lnw = IN(19); const float* lnb = IN(20); const float* rk = IN(18);
    const int l = tidx() & 63, gw = VB * 4 + (tidx() >> 6), nw = VG * 4;
    const int c0 = l * 8;
    float wv[8], bv[8], rkv[8];
    { const f32x4 a = *(const f32x4*)(lnw + c0), b = *(const f32x4*)(lnw + c0 + 4), c = *(const f32x4*)(lnb + c0), d = *(const f32x4*)(lnb + c0 + 4), e = *(const f32x4*)(rk + c0), f = *(const f32x4*)(rk + c0 + 4);
#pragma unroll
      for (int j = 0; j < 4; ++j) { wv[j] = a[j]; wv[j + 4] = b[j]; bv[j] = c[j]; bv[j + 4] = d[j]; rkv[j] = e[j]; rkv[j + 4] = f[j]; } }
    for (int tok = gw; tok < T_TOK; tok += nw) {
        const size_t off = (size_t)tok * 512 + c0;
        float y[8], r[8], k[8], v[8], g[8];
        unpack8(*(const u32x4*)(yv + off), y); unpack8(*(const u32x4*)(rs + off), r); unpack8(*(const u32x4*)(ks + off), k);
        unpack8(*(const u32x4*)(vs + off), v); unpack8(*(const u32x4*)(gg + off), g);
        float s = 0.f, bs = 0.f;
#pragma unroll
        for (int j = 0; j < 8; ++j) { s += y[j]; bs += r[j] * k[j] * rkv[j]; }
        s += __shfl_xor(s, 1); s += __shfl_xor(s, 2); s += __shfl_xor(s, 4);
        bs += __shfl_xor(bs, 1); bs += __shfl_xor(bs, 2); bs += __shfl_xor(bs, 4);
        const float mean = s * (1.0f / 64.0f);
        float q = 0.f;
#pragma unroll
        for (int j = 0; j < 8; ++j) { const float d = y[j] - mean; q += d * d; }
        q += __shfl_xor(q, 1); q += __shfl_xor(q, 2); q += __shfl_xor(q, 4);
        const float rstd = rsqrtf(q * (1.0f / 64.0f) + 64e-5f);
        float o[8];
#pragma unroll
        for (int j = 0; j < 8; ++j) o[j] = ((y[j] - mean) * rstd * wv[j] + bv[j] + bs * v[j]) * g[j];
        *(u32x4*)(ybp + off) = pack8(o);
    }
    rmsnorm_rows_bf16(IN(0), IN(3), (bf16_t*)(ws + R_A));
}

__device__ void phase6(const Params& p, unsigned char* lds8) {
    unsigned char* ws = lnd(p.ws); EPI8_IDS
    const bf16_t* h = (const bf16_t*)(ws + R_A); const bf16_t* ob = (const bf16_t*)(ws + R_B); const bf16_t* ybp = (const bf16_t*)(ws + R_C);
    const bf16_t* Wg = (const bf16_t*)(ws + W_IN) + (size_t)2464 * 1024;
    bf16_t* mo = (bf16_t*)(ws + R_D);
    bf16_t* gsc = (bf16_t*)(ws + R_C + 32 * MiB);
    for (int iter = 0, rt, ct; tile_map8(iter, 128, 4, rt, ct); ++iter) {
        const int m0 = rt * 256, n0 = ct * 256;
        const int row0 = m0 + wr * 128 + fr, col0 = n0 + wc * 64 + fq * 8;
        f32x4 acc[8][4];
#pragma unroll 1
        for (int pass = 0; pass < 2; ++pass) {
            gemm8(h + (size_t)m0 * 1024, 1024, Wg + (size_t)(pass * 1024 + n0) * 1024, 1024, 1024, acc, lds8);
#pragma unroll
            for (int mi = 0; mi < 8; ++mi) {
#pragma unroll
                for (int q = 0; q < 2; ++q) {
                    float v[8];
#pragma unroll
                    for (int r = 0; r < 4; ++r) { v[r] = sigmoidf_(acc[mi][2 * q][r]); v[4 + r] = sigmoidf_(acc[mi][2 * q + 1][r]); }
                    *(u32x4*)(gsc + (size_t)(row0 + mi * 16) * 1024 + col0 + q * 32) = pack8(v);
                }
            }
            if (pass == 0) gemm8(ob + (size_t)m0 * 512, 512, (const bf16_t*)(ws + W_OA) + (size_t)n0 * 512, 512, 512, acc, lds8);
            else gemm8(ybp + (size_t)m0 * 512, 512, (const bf16_t*)(ws + W_OB) + (size_t)n0 * 512, 512, 512, acc, lds8);
            {
                u32x4 gn[2], pn[2];
#pragma unroll
                for (int q = 0; q < 2; ++q) { gn[q] = *(const u32x4*)(gsc + (size_t)row0 * 1024 + col0 + q * 32); pn[q] = pass ? *(const u32x4*)(mo + (size_t)row0 * 1024 + col0 + q * 32) : (u32x4){0u, 0u, 0u, 0u}; }
#pragma unroll
                for (int mi = 0; mi < 8; ++mi) {
                    const int row = row0 + mi * 16;
                    u32x4 gc[2], pc[2];
#pragma unroll
                    for (int q = 0; q < 2; ++q) { gc[q] = gn[q]; pc[q] = pn[q]; }
                    if (mi < 7) {
#pragma unroll
                        for (int q = 0; q < 2; ++q) { gn[q] = *(const u32x4*)(gsc + (size_t)(row + 16) * 1024 + col0 + q * 32); pn[q] = pass ? *(const u32x4*)(mo + (size_t)(row + 16) * 1024 + col0 + q * 32) : (u32x4){0u, 0u, 0u, 0u}; }
                    }
#pragma unroll
                    for (int q = 0; q < 2; ++q) {
                        float g[8], pv[8], v[8];
                        unpack8(gc[q], g); unpack8(pc[q], pv);
#pragma unroll
                        for (int r = 0; r < 4; ++r) { v[r] = g[r] * acc[mi][2 * q][r] + pv[r]; v[4 + r] = g[4 + r] * acc[mi][2 * q + 1][r] + pv[4 + r]; }
                        *(u32x4*)(mo + (size_t)row * 1024 + col0 + q * 32) = pack8(v);
                    }
                }
            }
        }
    }
}

__device__ __forceinline__ void epi_residual8(const f32x4 (&acc)[8][4], int m0, int n0, const float* xin, float* xo, bf16_t* xb, float* ssq, const float* ss_in) {
    EPI8_IDS
    const int row0 = m0 + wr * 128 + fr, col0 = n0 + wc * 64 + fq * 8;
    f32x4 xn[4]; float sn = 0.f;
#pragma unroll
    for (int q = 0; q < 2; ++q) { xn[2 * q] = *(const f32x4*)(xin + (size_t)row0 * DM + col0 + q * 32); xn[2 * q + 1] = *(const f32x4*)(xin + (size_t)row0 * DM + col0 + q * 32 + 4); }
    if (ss_in) sn = ss_in[row0];
#pragma unroll
    for (int mi = 0; mi < 8; ++mi) {
        const int row = row0 + mi * 16;
        f32x4 xc[4]; const float sc_in = sn;
#pragma unroll
        for (int i = 0; i < 4; ++i) xc[i] = xn[i];
        if (mi < 7) {
#pragma unroll
            for (int q = 0; q < 2; ++q) { xn[2 * q] = *(const f32x4*)(xin + (size_t)(row + 16) * DM + col0 + q * 32); xn[2 * q + 1] = *(const f32x4*)(xin + (size_t)(row + 16) * DM + col0 + q * 32 + 4); }
            if (ss_in) sn = ss_in[row + 16];
        }
        float sc = 1.0f;
        if (ss_in) { const float r = rsqrtf(sc_in * (1.0f / DM) + RMS_EPS); sc = r * r; }
        float ss = 0.f;
#pragma unroll
        for (int q = 0; q < 2; ++q) {
            const int col = col0 + q * 32;
            const f32x4 v0 = xc[2 * q] + acc[mi][2 * q] * sc, v1 = xc[2 * q + 1] + acc[mi][2 * q + 1] * sc;
            *(f32x4*)(xo + (size_t)row * DM + col) = v0; *(f32x4*)(xo + (size_t)row * DM + col + 4) = v1;
            u32x4 o; o.x = pk2(v0[0], v0[1]); o.y = pk2(v0[2], v0[3]); o.z = pk2(v1[0], v1[1]); o.w = pk2(v1[2], v1[3]);
            *(u32x4*)(xb + (size_t)row * DM + col) = o;
            ss += (v0[0] * v0[0] + v0[1] * v0[1] + v0[2] * v0[2] + v0[3] * v0[3]) + (v1[0] * v1[0] + v1[1] * v1[1] + v1[2] * v1[2] + v1[3] * v1[3]);
        }
        ss += __shfl_xor(ss, 16); ss += __shfl_xor(ss, 32);
        if (fq == 0) atomicAdd(ssq + row, ss);
    }
}

__device__ void phase7(const Params& p, unsigned char* lds8) {
    unsigned char* ws = lnd(p.ws);
    const bf16_t* mo = (const bf16_t*)(ws + R_D);
    for (int iter = 0, rt, ct; tile_map8(iter, 128, 4, rt, ct); ++iter) {
        const int m0 = rt * 256, n0 = ct * 256;
        f32x4 acc[8][4];
        gemm8(mo + (size_t)m0 * 1024, 1024, (const bf16_t*)(ws + W_OUT) + (size_t)n0 * 1024, 1024, 1024, acc, lds8);
        epi_residual8(acc, m0, n0, IN(0), lnd(p.out), (bf16_t*)(ws + R_A), (float*)(ws + OFF_SS1), nullptr);
    }
}
__device__ void phase8(const Params& p, unsigned char* lds8) {
    unsigned char* ws = lnd(p.ws); EPI8_IDS
    const bf16_t* xb = (const bf16_t*)(ws + R_A); bf16_t* u = (bf16_t*)(ws + R_U);
    for (int iter = 0, rt, ct; tile_map8(iter, 128, 16, rt, ct); ++iter) {
        const int m0 = rt * 256, n0 = ct * 256;
        f32x4 acc[8][4];
        gemm8(xb + (size_t)m0 * 1024, 1024, (const bf16_t*)(ws + W_UP) + (size_t)n0 * 1024, 1024, 1024, acc, lds8);
#pragma unroll
        for (int mi = 0; mi < 8; ++mi) {
            const int row = m0 + wr * 128 + mi * 16 + fr;
#pragma unroll
            for (int q = 0; q < 2; ++q) {
                const int col = n0 + wc * 64 + q * 32 + fq * 8;
                float v[8];
#pragma unroll
                for (int r = 0; r < 4; ++r) { const float a = fmaxf(acc[mi][2 * q][r], 0.f), c = fmaxf(acc[mi][2 * q + 1][r], 0.f); v[r] = a * a; v[4 + r] = c * c; }
                *(u32x4*)(u + (size_t)row * 4096 + col) = pack8(v);
            }
        }
    }
}
__device__ void phase9(const Params& p, unsigned char* lds8) {
    unsigned char* ws = lnd(p.ws);
    const bf16_t* u = (const bf16_t*)(ws + R_U);
    for (int iter = 0, rt, ct; tile_map8(iter, 128, 4, rt, ct); ++iter) {
        const int m0 = rt * 256, n0 = ct * 256;
        f32x4 acc[8][4];
        gemm8(u + (size_t)m0 * 4096, 4096, (const bf16_t*)(ws + W_DN) + (size_t)n0 * 4096, 4096, 4096, acc, lds8);
        epi_residual8(acc, m0, n0, lnd(p.out), lnd(p.out), (bf16_t*)(ws + R_A), (float*)(ws + OFF_SS2), (const float*)(ws + OFF_SS1));
    }
}
__device__ void phase10(const Params& p, unsigned char* lds8) {
    unsigned char* ws = lnd(p.ws); EPI8_IDS
    const bf16_t* xb = (const bf16_t*)(ws + R_A); const bf16_t* pb = (const bf16_t*)(ws + R_PB);
    const float* ss2 = (const float*)(ws + OFF_SS2);
    float* xo = lnd(p.out);
    bf16_t* ppb = (bf16_t*)(ws + R_B);
    for (int iter = 0, rt, ct; tile_map8(iter, 128, 4, rt, ct); ++iter) {
        const int m0 = rt * 256, n0 = ct * 256;
        const int row0 = m0 + wr * 128 + fr, col0 = n0 + wc * 64 + fq * 8;
        f32x4 acc[8][4];
        gemm8(pb + (size_t)m0 * 256, 256, (const bf16_t*)(ws + W_PP) + (size_t)n0 * 256, 256, 256, acc, lds8);
#pragma unroll
        for (int mi = 0; mi < 8; ++mi) {
#pragma unroll
            for (int q = 0; q < 2; ++q) {
                u32x4 o; o.x = pk2(acc[mi][2 * q][0], acc[mi][2 * q][1]); o.y = pk2(acc[mi][2 * q][2], acc[mi][2 * q][3]);
                o.z = pk2(acc[mi][2 * q + 1][0], acc[mi][2 * q + 1][1]); o.w = pk2(acc[mi][2 * q + 1][2], acc[mi][2 * q + 1][3]);
                *(u32x4*)(ppb + (size_t)(row0 + mi * 16) * 1024 + col0 + q * 32) = o;
            }
        }
        gemm8(xb + (size_t)m0 * 1024, 1024, (const bf16_t*)(ws + W_PG) + (size_t)n0 * 1024, 1024, 1024, acc, lds8);
        {
            f32x4 xn[4]; u32x4 pn[2]; float sn;
#pragma unroll
            for (int q = 0; q < 2; ++q) { xn[2 * q] = *(const f32x4*)(xo + (size_t)row0 * DM + col0 + q * 32); xn[2 * q + 1] = *(const f32x4*)(xo + (size_t)row0 * DM + col0 + q * 32 + 4);
                                          pn[q] = *(const u32x4*)(ppb + (size_t)row0 * 1024 + col0 + q * 32); }
            sn = ss2[row0];
#pragma unroll
            for (int mi = 0; mi < 8; ++mi) {
                const int row = row0 + mi * 16;
                f32x4 xc[4]; u32x4 pc[2]; const float rstd = rsqrtf(sn * (1.0f / DM) + RMS_EPS);
#pragma unroll
                for (int i = 0; i < 4; ++i) xc[i] = xn[i];
                pc[0] = pn[0]; pc[1] = pn[1];
                if (mi < 7) {
#pragma unroll
                    for (int q = 0; q < 2; ++q) { xn[2 * q] = *(const f32x4*)(xo + (size_t)(row + 16) * DM + col0 + q * 32); xn[2 * q + 1] = *(const f32x4*)(xo + (size_t)(row + 16) * DM + col0 + q * 32 + 4);
                                                  pn[q] = *(const u32x4*)(ppb + (size_t)(row + 16) * 1024 + col0 + q * 32); }
                    sn = ss2[row + 16];
                }
#pragma unroll
                for (int q = 0; q < 2; ++q) {
                    float pf[8]; unpack8(pc[q], pf);
                    f32x4 v0 = xc[2 * q], v1 = xc[2 * q + 1];
#pragma unroll
                    for (int r = 0; r < 4; ++r) { v0[r] += sigmoidf_(acc[mi][2 * q][r] * rstd) * pf[r]; v1[r] += sigmoidf_(acc[mi][2 * q + 1][r] * rstd) * pf[4 + r]; }
                    *(f32x4*)(xo + (size_t)row * DM + col0 + q * 32) = v0; *(f32x4*)(xo + (size_t)row * DM + col0 + q * 32 + 4) = v1;
                }
            }
        }
    }
}
__device__ void phase11(const Params& p) {
    float* x = lnd(p.out); const float* g = IN(29);
    const int l = tidx() & 63, gw = VB * 4 + (tidx() >> 6), nw = VG * 4;
    for (int row = gw; row < T_TOK; row += 2 * nw) {
        const int row2 = row + nw; const bool has2 = row2 < T_TOK;
        float* xr = x + (size_t)row * DM; float* xr2 = x + (size_t)(has2 ? row2 : row) * DM;
        f32x4 v[4], w[4]; float ss = 0.f, ss2 = 0.f;
#pragma unroll
        for (int i = 0; i < 4; ++i) { v[i] = *(const f32x4*)(xr + i * 256 + l * 4); w[i] = *(const f32x4*)(xr2 + i * 256 + l * 4); }
#pragma unroll
        for (int i = 0; i < 4; ++i) { ss += v[i][0] * v[i][0] + v[i][1] * v[i][1] + v[i][2] * v[i][2] + v[i][3] * v[i][3]; ss2 += w[i][0] * w[i][0] + w[i][1] * w[i][1] + w[i][2] * w[i][2] + w[i][3] * w[i][3]; }
        ss = wave_sum(ss); ss2 = wave_sum(ss2);
        const float rs = rsqrtf(ss * (1.0f / DM) + RMS_EPS), rs2 = rsqrtf(ss2 * (1.0f / DM) + RMS_EPS);
#pragma unroll
        for (int i = 0; i < 4; ++i) {
            const f32x4 gg = *(const f32x4*)(g + i * 256 + l * 4);
            *(f32x4*)(xr + i * 256 + l * 4) = v[i] * rs * gg;
            if (has2) *(f32x4*)(xr2 + i * 256 + l * 4) = w[i] * rs2 * gg;
        }
    }
}

extern __shared__ __attribute__((aligned(16))) unsigned char dyn_lds[];
constexpr int DYN_LDS = 131072;
__global__ void __launch_bounds__(512, 2) mega(Params p) {
    unsigned char* lds = dyn_lds + VHALF * 65536;
    __shared__ uint4 xbw;
    __shared__ int s_item[2];
    const bool single = (p.ph_hi - p.ph_lo) > 1;
    if (threadIdx.x == 0) xbw = make_uint4(0u, 0u, 0u, 0u);
    __syncthreads();
    XcdBarrier xb; xb.bar = (unsigned*)(p.ws + OFF_BAR); xb.x = 0; xb.st = (volatile LAS unsigned*)&xbw;
    if (single) xb = xcd_barrier_post((unsigned*)(p.ws + OFF_BAR), (volatile LAS unsigned*)&xbw);
    if (p.ph_lo < 0) cg::this_grid().sync();
#ifndef PROBE_MASK
#define PROBE_MASK 0
#endif
#ifndef PROBE_DUP
#define PROBE_DUP -1
#endif
    for (int ph = p.ph_lo; ph < p.ph_hi; ++ph)
    for (int rep = 0; rep < ((ph == PROBE_DUP || ((PROBE_MASK >> ph) & 1)) ? 2 : 1); ++rep) {
#ifndef ONLY_PH
#define ONLY_PH -1
#endif
#ifndef SKIP_PH
#define SKIP_PH -1
#endif
#define RUNPH(k, call) if ((ONLY_PH < 0 || ONLY_PH == k) && SKIP_PH != k && ph == k) { call; }
        RUNPH(0, phase0(p)) RUNPH(1, phase1(p, dyn_lds)) RUNPH(2, phase2(p)) RUNPH(3, phase3(p, lds)) RUNPH(4, phase4(p, lds, s_item, rep)) RUNPH(5, phase5(p))
        RUNPH(6, phase6(p, dyn_lds)) RUNPH(7, phase7(p, dyn_lds)) RUNPH(8, phase8(p, dyn_lds)) RUNPH(9, phase9(p, dyn_lds)) RUNPH(10, phase10(p, dyn_lds)) RUNPH(11, phase11(p))
        if (ph + 1 < p.ph_hi || rep == 0) xcd_barrier(xb);
    }
}

extern "C" void kernel_launch(void* const* d_in, const int* in_sizes, int n_in, void* d_out, int out_size, void* d_ws, size_t ws_size, hipStream_t stream) {
    static int grid_blocks = 0;
    if (!grid_blocks) {
        int dev = 0, cus = 0, per_cu = 0;
        hipGetDevice(&dev);
        hipDeviceGetAttribute(&cus, hipDeviceAttributeMultiprocessorCount, dev);
        hipFuncSetAttribute((const void*)mega, hipFuncAttributeMaxDynamicSharedMemorySize, DYN_LDS);
        hipOccupancyMaxActiveBlocksPerMultiprocessor(&per_cu, mega, 512, DYN_LDS);
        if (per_cu > 1) per_cu = 1;
        if (per_cu < 1) per_cu = 1;
        grid_blocks = cus * per_cu;
    }
    if (ws_size < WS_NEED) { fprintf(stderr, "workspace too small: %zu < %zu\n", ws_size, (size_t)WS_NEED); return; }
    Params p{};
    for (int i = 0; i < 30; ++i) p.in[i] = (const float*)d_in[i];
    p.out = (float*)d_out; p.ws = (unsigned char*)d_ws;
    hipMemsetAsync(d_ws, 0, ZERO_BYTES, stream);
#if MK_MULTI
    for (int ph = 0; ph < NPH; ++ph) { p.ph_lo = ph; p.ph_hi = ph + 1; hipLaunchKernelGGL(mega, dim3(grid_blocks), dim3(512), DYN_LDS, stream, p); }
#else
    p.ph_lo = 0; p.ph_hi = NPH;
    void* args[] = {&p};
    hipError_t e = hipLaunchCooperativeKernel((void*)mega, dim3(grid_blocks), dim3(512), args, DYN_LDS, stream);
    if (e != hipSuccess) fprintf(stderr, "cooperative launch failed: %s (grid %d)\n", hipGetErrorString(e), grid_blocks);
#endif
}
```

```cpp
#include <hip/hip_runtime.h>
#include <hip/hip_cooperative_groups.h>
#include <stdint.h>
#include <stdio.h>
namespace cg = cooperative_groups;

#ifndef MK_MULTI
#define MK_MULTI 0
#endif

typedef unsigned short bf16_t;
typedef short bf16x8 __attribute__((ext_vector_type(8)));
typedef float f32x4 __attribute__((ext_vector_type(4)));
typedef unsigned u32x4 __attribute__((ext_vector_type(4)));
typedef unsigned u32x2 __attribute__((ext_vector_type(2)));
#define LAS __attribute__((address_space(3)))

constexpr int T_TOK = 32768, SEQ = 8192, DM = 1024;
constexpr int NPH = 12;
constexpr float RMS_EPS = 1e-6f;
constexpr float QSCALE = 0.10206207261596577f * 1.4426950408889634f;

constexpr size_t MiB = 1ull << 20;
constexpr size_t OFF_BAR = 0, OFF_QUEUE = 16384, ZERO_BYTES = 32768;
constexpr size_t OFF_SS1 = 65536, OFF_SS2 = OFF_SS1 + 131072, OFF_RSQ = OFF_SS2 + 131072, OFF_RSKV = OFF_RSQ + 131072;
constexpr size_t OFF_CS = 1 * MiB;
constexpr size_t OFF_W = 5 * MiB;
constexpr size_t W_IN = OFF_W;
constexpr size_t W_UQ = W_IN + 4608ull * 1024 * 2;
constexpr size_t W_KN = W_UQ + 768ull * 384 * 2;
constexpr size_t W_V = W_KN + 512ull * 256 * 2;
constexpr size_t W_OA = W_V + 512ull * 256 * 2;
constexpr size_t W_W2 = W_OA + 1024ull * 512 * 2;
constexpr size_t W_A2 = W_W2 + 512ull * 64 * 2;
constexpr size_t W_G2 = W_A2 + 512ull * 64 * 2;
constexpr size_t W_OB = W_G2 + 512ull * 128 * 2;
constexpr size_t W_OUT = W_OB + 1024ull * 512 * 2;
constexpr size_t W_UP = W_OUT + 1024ull * 1024 * 2;
constexpr size_t W_DN = W_UP + 4096ull * 1024 * 2;
constexpr size_t W_PG = W_DN + 4096ull * 1024 * 2;
constexpr size_t W_PP = W_PG + 1024ull * 1024 * 2;
constexpr size_t W_END = W_PP + 1024ull * 256 * 2;
static_assert(W_END <= 42 * MiB, "weights region");
constexpr size_t R_A = 42 * MiB;
constexpr size_t R_B = 106 * MiB;
constexpr size_t R_C = 148 * MiB;
constexpr size_t R_D = 260 * MiB;
constexpr size_t R_E = 356 * MiB;
constexpr size_t R_F = 388 * MiB;
constexpr size_t R_G = 420 * MiB;
constexpr size_t R_H = 422 * MiB;
constexpr size_t R_I = 454 * MiB;
constexpr size_t R_PB = 486 * MiB;
constexpr size_t WS_NEED = 502 * MiB;
constexpr size_t R_U = R_B;

struct Params {
    const float* in[30];
    float* out;
    unsigned char* ws;
    int ph_lo, ph_hi;
};

#define GAS __attribute__((address_space(1)))
template <class T> __device__ __forceinline__ T* lnd(T* q) { GAS T* g = (GAS T*)q; asm volatile("" : "+s"(g)); return (T*)g; }
#define IN(k) lnd(p.in[k])
#define VHALF ((int)__builtin_amdgcn_readfirstlane((int)(threadIdx.x >> 8)))
#define VB ((int)blockIdx.x * 2 + VHALF)
#define VG ((int)gridDim.x * 2)
__device__ __forceinline__ int tidx512() { int t = threadIdx.x; asm volatile("" : "+v"(t)); return t; }
__device__ __forceinline__ int tidx() { int t = threadIdx.x & 255; asm volatile("" : "+v"(t)); return t; }
__device__ __forceinline__ unsigned f2bf(float f) { unsigned u = __float_as_uint(f); return (u + 0x7fffu + ((u >> 16) & 1u)) >> 16; }
typedef float f32x2_t __attribute__((ext_vector_type(2)));
typedef __bf16 bf16x2_t __attribute__((ext_vector_type(2)));
__device__ __forceinline__ unsigned pk2(float lo, float hi) { f32x2_t v = {lo, hi}; bf16x2_t b = __builtin_convertvector(v, bf16x2_t); return __builtin_bit_cast(unsigned, b); }
__device__ __forceinline__ float bflo(unsigned w) { return __uint_as_float(w << 16); }
__device__ __forceinline__ float bfhi(unsigned w) { return __uint_as_float(w & 0xffff0000u); }
__device__ __forceinline__ float bf1(bf16_t v) { return __uint_as_float((unsigned)v << 16); }
__device__ __forceinline__ void unpack8(const u32x4 w, float (&f)[8]) {
    f[0] = bflo(w.x); f[1] = bfhi(w.x); f[2] = bflo(w.y); f[3] = bfhi(w.y); f[4] = bflo(w.z); f[5] = bfhi(w.z); f[6] = bflo(w.w); f[7] = bfhi(w.w);
}
__device__ __forceinline__ u32x4 pack8(const float (&f)[8]) { u32x4 w; w.x = pk2(f[0], f[1]); w.y = pk2(f[2], f[3]); w.z = pk2(f[4], f[5]); w.w = pk2(f[6], f[7]); return w; }
__device__ __forceinline__ float sigmoidf_(float x) { return __builtin_amdgcn_rcpf(1.0f + __expf(-x)); }
__device__ __forceinline__ float wave_sum(float v) {
#pragma unroll
    for (int o = 32; o >= 1; o >>= 1) v += __shfl_xor(v, o);
    return v;
}
template <int CTRL> __device__ __forceinline__ float dppf(float v) {
    return __int_as_float(__builtin_amdgcn_update_dpp(0, __float_as_int(v), CTRL, 0xf, 0xf, false));
}
__device__ __forceinline__ float row16_sum(float v) {
    v += dppf<0x128>(v); v += dppf<0x124>(v); v += dppf<0x122>(v); v += dppf<0x121>(v); return v;
}

#define XB_TMO      128
#define XB_XCNT(j)  (256  + 64 * (j))
#define XB_XSUB(j)  (1280 + 64 * (j))
#define XB_XGEN(j)  (2304 + 64 * (j))
#define XB_TOP      3328
#define XB_TOPGEN   3392
#define XCD_BAR_WORDS 3456
#define XB_SPIN_CAP (1u << 22)
__device__ __forceinline__ unsigned xb_ld(unsigned* p) { return __hip_atomic_load(p, __ATOMIC_RELAXED, __HIP_MEMORY_SCOPE_AGENT); }
__device__ __forceinline__ unsigned xb_add(unsigned* p, unsigned v) { return __hip_atomic_fetch_add(p, v, __ATOMIC_RELAXED, __HIP_MEMORY_SCOPE_AGENT); }
__device__ __forceinline__ unsigned xb_xcc_id() { return (unsigned)__builtin_amdgcn_s_getreg((3 << 11) | 20) & 0xFu; }
#define XB_SPIN(cond, bar) do { unsigned _sp = 0; while (cond) { __builtin_amdgcn_s_sleep(1); \
    if ((++_sp & 255u) == 0u) { if (xb_ld(&(bar)[XB_TMO])) break; if (_sp > XB_SPIN_CAP) { atomicAdd(&(bar)[XB_TMO], 1u); break; } } } } while (0)
struct XcdBarrier { unsigned* bar; unsigned x; volatile LAS unsigned* st; };
__device__ __forceinline__ XcdBarrier xcd_barrier_post(unsigned* bar, volatile LAS unsigned* st) {
    XcdBarrier b; b.bar = bar; b.x = xb_xcc_id(); b.st = st;
    if (threadIdx.x == 0) (void)xb_add(&bar[XB_XCNT(b.x)], 1u);
    return b;
}
__device__ __forceinline__ void xcd_barrier_complete(unsigned* bar, unsigned x, unsigned& nloc, unsigned& nx) {
    const unsigned G = gridDim.x * gridDim.y * gridDim.z;
    unsigned sum, cnt, mine, sp = 0u;
    for (;;) {
        sum = 0u; cnt = 0u; mine = 0u;
#pragma unroll
        for (unsigned j = 0; j < 16; ++j) { const unsigned c = xb_ld(&bar[XB_XCNT(j)]); sum += c; cnt += (c > 0u) ? 1u : 0u; mine = (j == x) ? c : mine; }
        if (sum == G) break;
        __builtin_amdgcn_s_sleep(1);
        if ((++sp & 255u) == 0u) { if (xb_ld(&bar[XB_TMO])) break; if (sp > XB_SPIN_CAP) { atomicAdd(&bar[XB_TMO], 1u); break; } }
    }
    nloc = mine > 0u ? mine : 1u; nx = cnt > 0u ? cnt : 1u;
}
__device__ __forceinline__ void xcd_barrier(const XcdBarrier& b) {
    asm volatile("s_waitcnt vmcnt(0)" ::: "memory");
    __syncthreads();
    if (threadIdx.x == 0) {
        unsigned* bar = b.bar;
        __builtin_amdgcn_s_waitcnt(0);
        unsigned nloc = b.st[0], nx = b.st[1];
        if (nloc == 0u) { xcd_barrier_complete(bar, b.x, nloc, nx); b.st[0] = nloc; b.st[1] = nx; }
        const unsigned old = xb_add(&bar[XB_XSUB(b.x)], 1u);
        const unsigned gen = old / nloc;
        if (old + 1u == (gen + 1u) * nloc) {
            __builtin_amdgcn_fence(__ATOMIC_RELEASE, "agent");
            asm volatile("s_waitcnt vmcnt(0)" ::: "memory");
            const unsigned og = xb_add(&bar[XB_TOP], 1u);
            const unsigned tg = og / nx;
            if (og + 1u == (tg + 1u) * nx) xb_add(&bar[XB_TOPGEN], 1u);
            else XB_SPIN(xb_ld(&bar[XB_TOPGEN]) == tg, bar);
            __builtin_amdgcn_fence(__ATOMIC_ACQUIRE, "agent");
            xb_add(&bar[XB_XGEN(b.x)], 1u);
            asm volatile("s_waitcnt vmcnt(0)" ::: "memory");
        } else {
            XB_SPIN(xb_ld(&bar[XB_XGEN(b.x)]) == gen, bar);
            __builtin_amdgcn_fence(__ATOMIC_ACQUIRE, "agent");
            asm volatile("s_waitcnt vmcnt(0)" ::: "memory");
        }
    }
    __syncthreads();
}

__device__ __forceinline__ int sw64(int row) { return (0x78 >> (2 * ((row >> 2) & 3))) & 3; }
__device__ __forceinline__ void gemm_core(const bf16_t* A, int lda, const bf16_t* Bt, int ldb, int K, f32x4 (&acc)[4][4], unsigned char* lds) {
    const int tid = tidx(), l = tid & 63, w = __builtin_amdgcn_readfirstlane(tid >> 6), wr = w >> 1, wc = w & 1, fr = l & 15, fq = l >> 4;
#pragma unroll
    for (int i = 0; i < 4; ++i)
#pragma unroll
        for (int j = 0; j < 4; ++j) acc[i][j] = (f32x4){0.f, 0.f, 0.f, 0.f};
    const int nk = K >> 5;
    const int rin = l >> 2, skc = (l & 3) ^ sw64(rin);
    const bf16_t* ga = A + (size_t)(w * 32 + rin) * lda + skc * 8;
    const bf16_t* gb = Bt + (size_t)(w * 32 + rin) * ldb + skc * 8;
    LAS unsigned char* L = (LAS unsigned char*)lds + w * 2048;
    const unsigned aoff = (unsigned)((wr * 64 + fr) * 64 + ((fq ^ sw64(fr)) * 16)), boff = (unsigned)(8192 + (wc * 64 + fr) * 64 + ((fq ^ sw64(fr)) * 16));
#define GC_ISSUE(kt_) do { LAS unsigned char* Ld_ = L + ((kt_) & 3) * 16384; \
        __builtin_amdgcn_global_load_lds((const unsigned*)(ga + (kt_) * 32), (LAS unsigned*)(Ld_), 16, 0, 0); \
        __builtin_amdgcn_global_load_lds((const unsigned*)(ga + (size_t)16 * lda + (kt_) * 32), (LAS unsigned*)(Ld_ + 1024), 16, 0, 0); \
        __builtin_amdgcn_global_load_lds((const unsigned*)(gb + (kt_) * 32), (LAS unsigned*)(Ld_ + 8192), 16, 0, 0); \
        __builtin_amdgcn_global_load_lds((const unsigned*)(gb + (size_t)16 * ldb + (kt_) * 32), (LAS unsigned*)(Ld_ + 8192 + 1024), 16, 0, 0); } while (0)
    const unsigned lbase = (unsigned)(size_t)(LAS unsigned char*)lds;
    asm volatile("s_waitcnt vmcnt(0)" ::: "memory");
    __syncthreads();
    GC_ISSUE(0);
    if (nk > 1) GC_ISSUE(1);
    if (nk > 2) GC_ISSUE(2);
#define GC_RD(dst, addr, OFF) asm volatile("ds_read_b128 %0, %1 offset:" #OFF : "=v"(dst) : "v"(addr) : "memory")
    for (int kt = 0; kt < nk; ++kt) {
        if (kt + 2 < nk) asm volatile("s_waitcnt vmcnt(8)" ::: "memory");
        else if (kt + 1 < nk) asm volatile("s_waitcnt vmcnt(4)" ::: "memory");
        else asm volatile("s_waitcnt vmcnt(0)" ::: "memory");
        __builtin_amdgcn_s_barrier();
        asm volatile("" ::: "memory");
        if (kt + 3 < nk) GC_ISSUE(kt + 3);
        const unsigned sa = lbase + (unsigned)((kt & 3) * 16384) + aoff, sb = lbase + (unsigned)((kt & 3) * 16384) + boff;
        bf16x8 a0, a1, a2, a3, b0, b1, b2, b3;
        GC_RD(a0, sa, 0); GC_RD(b0, sb, 0); GC_RD(a1, sa, 1024); GC_RD(b1, sb, 1024);
        GC_RD(a2, sa, 2048); GC_RD(b2, sb, 2048); GC_RD(a3, sa, 3072); GC_RD(b3, sb, 3072);
#define GC_MMA(mi, ni, A_, B_) acc[mi][ni] = __builtin_amdgcn_mfma_f32_16x16x32_bf16(B_, A_, acc[mi][ni], 0, 0, 0)
        asm volatile("s_waitcnt lgkmcnt(4)" : "+v"(a0), "+v"(a1), "+v"(b0), "+v"(b1) :: "memory");
        GC_MMA(0, 0, a0, b0); GC_MMA(0, 1, a0, b1); GC_MMA(1, 0, a1, b0); GC_MMA(1, 1, a1, b1);
        asm volatile("s_waitcnt lgkmcnt(2)" : "+v"(a2), "+v"(b2) :: "memory");
        GC_MMA(0, 2, a0, b2); GC_MMA(1, 2, a1, b2); GC_MMA(2, 0, a2, b0); GC_MMA(2, 1, a2, b1); GC_MMA(2, 2, a2, b2);
        asm volatile("s_waitcnt lgkmcnt(0)" : "+v"(a3), "+v"(b3) :: "memory");
        GC_MMA(0, 3, a0, b3); GC_MMA(1, 3, a1, b3); GC_MMA(2, 3, a2, b3); GC_MMA(3, 0, a3, b0); GC_MMA(3, 1, a3, b1); GC_MMA(3, 2, a3, b2); GC_MMA(3, 3, a3, b3);
    }
    __syncthreads();
}
__device__ __forceinline__ bool tile_map(int iter, int MT, int NT, int& rt, int& ct) {
    const int G = gridDim.x;
    if ((G & 7) == 0 && (MT & 63) == 0) {
        const int x = blockIdx.x & 7, lb = (blockIdx.x >> 3) * 2 + VHALF, nlb = (G >> 3) * 2, MTx = MT >> 3;
        const int li = lb + iter * nlb;
        if (li >= MTx * NT) return false;
        const int per = 8 * NT, rg = li / per, r = li - rg * per;
        ct = r >> 3; rt = x * MTx + rg * 8 + (r & 7);
        return true;
    }
    const int it = VB + iter * VG;
    if (it >= MT * NT) return false;
    rt = it / NT; ct = it - rt * NT; return true;
}
__device__ __forceinline__ void gemm8(const bf16_t* A, int lda, const bf16_t* Bt, int ldb, int K, f32x4 (&acc)[8][4], unsigned char* lds) {
    const int tid = tidx512(), l = tid & 63, w = __builtin_amdgcn_readfirstlane(tid >> 6), wr = w >> 2, wc = w & 3, fr = l & 15, fq = l >> 4;
#pragma unroll
    for (int i = 0; i < 8; ++i)
#pragma unroll
        for (int j = 0; j < 4; ++j) acc[i][j] = (f32x4){0.f, 0.f, 0.f, 0.f};
    const int nk = K >> 6;
    const int rin = l >> 3, skc = (l & 7) ^ (rin & 7);
    const bf16_t* ga = A + (size_t)(w * 32 + rin) * lda + skc * 8;
    const bf16_t* gb = Bt + (size_t)(w * 32 + rin) * ldb + skc * 8;
    LAS unsigned char* L = (LAS unsigned char*)lds + w * 4096;
#define G8_ISSUE(kt_) do { LAS unsigned char* Ld_ = L + ((kt_) & 1) * 65536; \
        __builtin_amdgcn_global_load_lds((const unsigned*)(ga + (kt_) * 64), (LAS unsigned*)(Ld_), 16, 0, 0); \
        __builtin_amdgcn_global_load_lds((const unsigned*)(ga + (size_t)8 * lda + (kt_) * 64), (LAS unsigned*)(Ld_ + 1024), 16, 0, 0); \
        __builtin_amdgcn_global_load_lds((const unsigned*)(ga + (size_t)16 * lda + (kt_) * 64), (LAS unsigned*)(Ld_ + 2048), 16, 0, 0); \
        __builtin_amdgcn_global_load_lds((const unsigned*)(ga + (size_t)24 * lda + (kt_) * 64), (LAS unsigned*)(Ld_ + 3072), 16, 0, 0); \
        __builtin_amdgcn_global_load_lds((const unsigned*)(gb + (kt_) * 64), (LAS unsigned*)(Ld_ + 32768), 16, 0, 0); \
        __builtin_amdgcn_global_load_lds((const unsigned*)(gb + (size_t)8 * ldb + (kt_) * 64), (LAS unsigned*)(Ld_ + 32768 + 1024), 16, 0, 0); \
        __builtin_amdgcn_global_load_lds((const unsigned*)(gb + (size_t)16 * ldb + (kt_) * 64), (LAS unsigned*)(Ld_ + 32768 + 2048), 16, 0, 0); \
        __builtin_amdgcn_global_load_lds((const unsigned*)(gb + (size_t)24 * ldb + (kt_) * 64), (LAS unsigned*)(Ld_ + 32768 + 3072), 16, 0, 0); } while (0)
    const unsigned lbase = (unsigned)(size_t)(LAS unsigned char*)lds;
    const unsigned arow = (unsigned)((wr * 128 + fr) * 128), brow = (unsigned)(32768 + (wc * 64 + fr) * 128);
    const unsigned sw0 = (unsigned)(((0 + fq) ^ (fr & 7)) * 16), sw1 = (unsigned)(((4 + fq) ^ (fr & 7)) * 16);
    asm volatile("s_waitcnt vmcnt(0)" ::: "memory");
    __syncthreads();
    G8_ISSUE(0);
#define G8_MMA(mi, ni, A_, B_) acc[mi][ni] = __builtin_amdgcn_mfma_f32_16x16x32_bf16(B_, A_, acc[mi][ni], 0, 0, 0)
#define G8_HALF(sa, sb, F1, F2, F3, F4) do { \
        bf16x8 a0, a1, a2, a3, b0, b1, b2, b3, c0, c1, c2, c3; \
        GC_RD(b0, sb, 0); GC_RD(b1, sb, 2048); GC_RD(b2, sb, 4096); GC_RD(b3, sb, 6144); \
        GC_RD(a0, sa, 0); GC_RD(a1, sa, 2048); GC_RD(a2, sa, 4096); GC_RD(a3, sa, 6144); \
        asm volatile("s_waitcnt lgkmcnt(2)" : "+v"(b0), "+v"(b1), "+v"(b2), "+v"(b3), "+v"(a0), "+v"(a1) :: "memory"); \
        G8_MMA(0, 0, a0, b0); G8_MMA(0, 1, a0, b1); G8_MMA(0, 2, a0, b2); G8_MMA(0, 3, a0, b3); \
        G8_MMA(1, 0, a1, b0); G8_MMA(1, 1, a1, b1); G8_MMA(1, 2, a1, b2); G8_MMA(1, 3, a1, b3); \
        F1; \
        asm volatile("s_waitcnt lgkmcnt(0)" : "+v"(a2), "+v"(a3) :: "memory"); \
        G8_MMA(2, 0, a2, b0); G8_MMA(2, 1, a2, b1); G8_MMA(2, 2, a2, b2); G8_MMA(2, 3, a2, b3); \
        G8_MMA(3, 0, a3, b0); G8_MMA(3, 1, a3, b1); G8_MMA(3, 2, a3, b2); G8_MMA(3, 3, a3, b3); \
        GC_RD(c0, sa, 8192); GC_RD(c1, sa, 10240); GC_RD(c2, sa, 12288); GC_RD(c3, sa, 14336); \
        F2; \
        asm volatile("s_waitcnt lgkmcnt(2)" : "+v"(c0), "+v"(c1) :: "memory"); \
        G8_MMA(4, 0, c0, b0); G8_MMA(4, 1, c0, b1); G8_MMA(4, 2, c0, b2); G8_MMA(4, 3, c0, b3); \
        G8_MMA(5, 0, c1, b0); G8_MMA(5, 1, c1, b1); G8_MMA(5, 2, c1, b2); G8_MMA(5, 3, c1, b3); \
        F3; \
        asm volatile("s_waitcnt lgkmcnt(0)" : "+v"(c2), "+v"(c3) :: "memory"); \
        G8_MMA(6, 0, c2, b0); G8_MMA(6, 1, c2, b1); G8_MMA(6, 2, c2, b2); G8_MMA(6, 3, c2, b3); \
        G8_MMA(7, 0, c3, b0); G8_MMA(7, 1, c3, b1); G8_MMA(7, 2, c3, b2); G8_MMA(7, 3, c3, b3); \
        F4; } while (0)
#define G8_PA(kt_, j) __builtin_amdgcn_global_load_lds((const unsigned*)(ga + (size_t)(8 * (j)) * lda + (kt_) * 64), (LAS unsigned*)(L + ((kt_) & 1) * 65536 + 1024 * (j)), 16, 0, 0)
#define G8_PB(kt_, j) __builtin_amdgcn_global_load_lds((const unsigned*)(gb + (size_t)(8 * (j)) * ldb + (kt_) * 64), (LAS unsigned*)(L + ((kt_) & 1) * 65536 + 32768 + 1024 * (j)), 16, 0, 0)
    for (int kt = 0; kt < nk; ++kt) {
        asm volatile("s_waitcnt vmcnt(0)" ::: "memory");
        __builtin_amdgcn_s_barrier();
        asm volatile("" ::: "memory");
        const bool nxt = kt + 1 < nk;
        const unsigned slot = lbase + (unsigned)((kt & 1) * 65536);
        const unsigned sa0 = slot + arow + sw0, sb0 = slot + brow + sw0, sa1 = slot + arow + sw1, sb1 = slot + brow + sw1;
        __builtin_amdgcn_s_setprio(1);
        G8_HALF(sa0, sb0,
                if (nxt) { G8_PA(kt + 1, 0); G8_PB(kt + 1, 0); },
                if (nxt) { G8_PA(kt + 1, 1); G8_PB(kt + 1, 1); },
                if (nxt) { G8_PA(kt + 1, 2); G8_PB(kt + 1, 2); },
                if (nxt) { G8_PA(kt + 1, 3); G8_PB(kt + 1, 3); });
        G8_HALF(sa1, sb1, (void)0, (void)0, (void)0, (void)0);
        __builtin_amdgcn_s_setprio(0);
    }
    __syncthreads();
}
__device__ __forceinline__ bool tile_map8(int iter, int MT, int NT, int& rt, int& ct) {
    const int G = gridDim.x;
    if ((G & 7) == 0 && (MT & 63) == 0) {
        const int x = blockIdx.x & 7, lb = blockIdx.x >> 3, nlb = G >> 3, MTx = MT >> 3;
        const int li = lb + iter * nlb;
        if (li >= MTx * NT) return false;
        const int per = 4 * NT, rg = li / per, r = li - rg * per;
        ct = r >> 2; rt = x * MTx + rg * 4 + (r & 3);
        return true;
    }
    const int it = (int)blockIdx.x + iter * G;
    if (it >= MT * NT) return false;
    rt = it / NT; ct = it - rt * NT; return true;
}
#define EPI8_IDS const int tid_ = tidx512(), l_ = tid_ & 63, w_ = tid_ >> 6, wr = w_ >> 2, wc = w_ & 3, fr = l_ & 15, fq = l_ >> 4; (void)wr; (void)wc; (void)fr; (void)fq;
#define EPI_IDS const int tid_ = tidx(), l_ = tid_ & 63, w_ = tid_ >> 6, wr = w_ >> 1, wc = w_ & 1, fr = l_ & 15, fq = l_ >> 4; (void)wr; (void)wc; (void)fr; (void)fq;

__device__ void transpose_job(const float* __restrict__ W, int K, int ldw, int rows, int mode, int perm, const float* __restrict__ gs, bf16_t* __restrict__ Wt, int gtid, int gthreads) {
    const int nch = rows * (K >> 3), nnb = rows >> 3;
    for (int id = gtid; id < nch; id += gthreads) {
        const int tile = id >> 6, lane = id & 63;
        const int n = (tile % nnb) * 8 + (lane & 7), kc = (tile / nnb) * 8 + (lane >> 3);
        int nn = n;
        if (perm) { const int j = n & 31; nn = (n & ~31) + ((j >> 2) & 3) * 8 + (j >> 4) * 4 + (j & 3); }
        int col = nn;
        if (mode == 1) col = (nn >> 6) * 128 + (nn & 63); else if (mode == 2) col = (nn >> 6) * 128 + 64 + (nn & 63);
        float v[8];
#pragma unroll
        for (int j = 0; j < 8; ++j) { const int k = kc * 8 + j; float x = W[(size_t)k * ldw + col]; if (gs) x *= gs[k]; v[j] = x; }
        *(u32x4*)(Wt + (size_t)n * K + kc * 8) = pack8(v);
    }
}
__device__ void rmsnorm_rows_bf16(const float* __restrict__ x, const float* __restrict__ g, bf16_t* __restrict__ h) {
    const int l = tidx() & 63, gw = VB * 4 + (tidx() >> 6), nw = VG * 4;
    for (int row = gw; row < T_TOK; row += 2 * nw) {
        const int row2 = row + nw; const bool has2 = row2 < T_TOK;
        const float* xr = x + (size_t)row * DM; const float* xr2 = x + (size_t)(has2 ? row2 : row) * DM;
        f32x4 v[4], w[4]; float ss = 0.f, ss2 = 0.f;
#pragma unroll
        for (int i = 0; i < 4; ++i) { v[i] = *(const f32x4*)(xr + i * 256 + l * 4); w[i] = *(const f32x4*)(xr2 + i * 256 + l * 4); }
#pragma unroll
        for (int i = 0; i < 4; ++i) { ss += v[i][0] * v[i][0] + v[i][1] * v[i][1] + v[i][2] * v[i][2] + v[i][3] * v[i][3]; ss2 += w[i][0] * w[i][0] + w[i][1] * w[i][1] + w[i][2] * w[i][2] + w[i][3] * w[i][3]; }
        ss = wave_sum(ss); ss2 = wave_sum(ss2);
        const float rs = rsqrtf(ss * (1.0f / DM) + RMS_EPS), rs2 = rsqrtf(ss2 * (1.0f / DM) + RMS_EPS);
#pragma unroll
        for (int i = 0; i < 4; ++i) {
            const f32x4 gg = *(const f32x4*)(g + i * 256 + l * 4);
            u32x2 o; o.x = pk2(v[i][0] * rs * gg[0], v[i][1] * rs * gg[1]); o.y = pk2(v[i][2] * rs * gg[2], v[i][3] * rs * gg[3]);
            *(u32x2*)(h + (size_t)row * DM + i * 256 + l * 4) = o;
            if (has2) { u32x2 o2; o2.x = pk2(w[i][0] * rs2 * gg[0], w[i][1] * rs2 * gg[1]); o2.y = pk2(w[i][2] * rs2 * gg[2], w[i][3] * rs2 * gg[3]);
                        *(u32x2*)(h + (size_t)row2 * DM + i * 256 + l * 4) = o2; }
        }
    }
}

__device__ void phase0(const Params& p) {
    unsigned char* ws = lnd(p.ws);
    const int gtid = VB * 256 + tidx(), gth = VG * 256;
    transpose_job(IN(4), 1024, 4512, 4512, 0, 1, nullptr, (bf16_t*)(ws + W_IN), gtid, gth);
    transpose_job(IN(6), 384, 768, 768, 0, 0, IN(5), (bf16_t*)(ws + W_UQ), gtid, gth);
    transpose_job(IN(8), 256, 1024, 512, 1, 1, IN(7), (bf16_t*)(ws + W_KN), gtid, gth);
    transpose_job(IN(8), 256, 1024, 512, 2, 0, IN(7), (bf16_t*)(ws + W_V), gtid, gth);
    transpose_job(IN(9), 512, 1024, 1024, 0, 1, nullptr, (bf16_t*)(ws + W_OA), gtid, gth);
    transpose_job(IN(12), 64, 512, 512, 0, 1, nullptr, (bf16_t*)(ws + W_W2), gtid, gth);
    transpose_job(IN(14), 64, 512, 512, 0, 1, nullptr, (bf16_t*)(ws + W_A2), gtid, gth);
    transpose_job(IN(15), 128, 512, 512, 0, 1, nullptr, (bf16_t*)(ws + W_G2), gtid, gth);
    transpose_job(IN(21), 512, 1024, 1024, 0, 1, nullptr, (bf16_t*)(ws + W_OB), gtid, gth);
    transpose_job(IN(22), 1024, 1024, 1024, 0, 1, nullptr, (bf16_t*)(ws + W_OUT), gtid, gth);
    transpose_job(IN(24), 1024, 4096, 4096, 0, 1, IN(23), (bf16_t*)(ws + W_UP), gtid, gth);
    transpose_job(IN(25), 4096, 1024, 1024, 0, 1, nullptr, (bf16_t*)(ws + W_DN), gtid, gth);
    transpose_job(IN(27), 1024, 1024, 1024, 0, 1, IN(26), (bf16_t*)(ws + W_PG), gtid, gth);
    transpose_job(IN(28), 256, 1024, 1024, 0, 1, nullptr, (bf16_t*)(ws + W_PP), gtid, gth);
    {
        const float* pp = IN(1); bf16_t* pb = (bf16_t*)(ws + R_PB);
        for (int id = gtid; id < T_TOK * 256 / 8; id += gth) {
            const f32x4 a = *(const f32x4*)(pp + (size_t)id * 8), b = *(const f32x4*)(pp + (size_t)id * 8 + 4);
            u32x4 o; o.x = pk2(a[0], a[1]); o.y = pk2(a[2], a[3]); o.z = pk2(b[0], b[1]); o.w = pk2(b[2], b[3]);
            *(u32x4*)(pb + (size_t)id * 8) = o;
        }
    }
    { float* z = (float*)(ws + OFF_SS1); for (int id = gtid; id < 2 * T_TOK; id += gth) z[id] = 0.f; }
    rmsnorm_rows_bf16(IN(0), IN(3), (bf16_t*)(ws + R_A));
}

__device__ void phase1(const Params& p, unsigned char* lds8) {
    unsigned char* ws = lnd(p.ws); EPI8_IDS
    const bf16_t* h = (const bf16_t*)(ws + R_A); const bf16_t* Wt = (const bf16_t*)(ws + W_IN);
    bf16_t* zm = (bf16_t*)(ws + R_B); bf16_t* zr = (bf16_t*)(ws + R_C);
    for (int iter = 0, rt, ct; tile_map8(iter, 128, 10, rt, ct); ++iter) {
        const int m0 = rt * 256, n0 = ct * 256;
        f32x4 acc[8][4];
        gemm8(h + (size_t)m0 * 1024, 1024, Wt + (size_t)n0 * 1024, 1024, 1024, acc, lds8);
#pragma unroll
        for (int mi = 0; mi < 8; ++mi) {
            const int row = m0 + wr * 128 + mi * 16 + fr;
#pragma unroll
            for (int q = 0; q < 2; ++q) {
                const int col = n0 + wc * 64 + q * 32 + fq * 8;
                u32x4 o; o.x = pk2(acc[mi][2 * q][0], acc[mi][2 * q][1]); o.y = pk2(acc[mi][2 * q][2], acc[mi][2 * q][3]);
                o.z = pk2(acc[mi][2 * q + 1][0], acc[mi][2 * q + 1][1]); o.w = pk2(acc[mi][2 * q + 1][2], acc[mi][2 * q + 1][3]);
                if (col < 672) *(u32x4*)(zm + (size_t)row * 672 + col) = o;
                else if (col < 2464) *(u32x4*)(zr + (size_t)row * 1792 + (col - 672)) = o;
            }
        }
    }
}

__device__ void phase2(const Params& p) {
    unsigned char* ws = lnd(p.ws);
    const bf16_t* zm = (const bf16_t*)(ws + R_B); const bf16_t* zr = (const bf16_t*)(ws + R_C);
    float* rsq = (float*)(ws + OFF_RSQ); float* rskv = (float*)(ws + OFF_RSKV); float* cs = (float*)(ws + OFF_CS);
    bf16_t* kpe = (bf16_t*)(ws + R_G);
    bf16_t* lin = (bf16_t*)(ws + R_A + 48 * MiB);
    bf16_t* rs = (bf16_t*)(ws + R_D); bf16_t* ks = rs + (size_t)T_TOK * 512; bf16_t* vs = ks + (size_t)T_TOK * 512;
    const float* mu = IN(10); const int* pos = (const int*)IN(2);
    const int l = tidx() & 63, gw = VB * 4 + (tidx() >> 6), nw = VG * 4;
    for (int tok = gw; tok < T_TOK; tok += nw) {
        const bf16_t* zrow = zm + (size_t)tok * 672;
        float sq = 0.f, skv = 0.f;
        {
            float f[8]; unpack8(*(const u32x4*)(zrow + l * 8), f);
            float s = 0.f;
#pragma unroll
            for (int j = 0; j < 8; ++j) s += f[j] * f[j];
            if (l < 48) sq += s; else skv += s;
            if (l < 16) { unpack8(*(const u32x4*)(zrow + (64 + l) * 8), f); s = 0.f;
#pragma unroll
                for (int j = 0; j < 8; ++j) s += f[j] * f[j];
                skv += s; }
        }
        sq = wave_sum(sq); skv = wave_sum(skv);
        if (l == 0) { rsq[tok] = rsqrtf(sq * (1.0f / 384.0f) + RMS_EPS); rskv[tok] = rsqrtf(skv * (1.0f / 256.0f) + RMS_EPS); }
        if (l < 16) {
            const float invf = powf(10000.0f, -(float)l * (1.0f / 16.0f));
            const float ang = (float)pos[tok] * invf;
            float sn, c; sincosf(ang, &sn, &c);
            cs[(size_t)tok * 32 + l] = c; cs[(size_t)tok * 32 + 16 + l] = sn;
            const float x1 = bf1(zrow[640 + l]), x2 = bf1(zrow[656 + l]);
            kpe[(size_t)tok * 32 + l] = (bf16_t)f2bf(x1 * c - x2 * sn);
            kpe[(size_t)tok * 32 + 16 + l] = (bf16_t)f2bf(x2 * c + x1 * sn);
        }
        const bool first = (tok % SEQ) == 0;
        const bf16_t* cur = zr + (size_t)tok * 1792; const bf16_t* prv = cur - 1792;
#pragma unroll
        for (int ps = 0; ps < 4; ++ps) {
            const int ch = ps * 64 + l;
            if (ch < 224) {
                const int c0 = ch * 8;
                float fc[8], fp[8], zs[8];
                unpack8(*(const u32x4*)(cur + c0), fc);
                if (first) {
#pragma unroll
                    for (int j = 0; j < 8; ++j) fp[j] = 0.f;
                } else unpack8(*(const u32x4*)(prv + c0), fp);
                const f32x4 m0 = *(const f32x4*)(mu + c0), m1 = *(const f32x4*)(mu + c0 + 4);
#pragma unroll
                for (int j = 0; j < 8; ++j) { const float m = j < 4 ? m0[j] : m1[j - 4]; zs[j] = fc[j] + (fp[j] - fc[j]) * m; }
                bf16_t* dst;
                if (c0 < 512) dst = rs + (size_t)tok * 512 + c0;
                else if (c0 < 1024) dst = ks + (size_t)tok * 512 + (c0 - 512);
                else if (c0 < 1536) dst = vs + (size_t)tok * 512 + (c0 - 1024);
                else {
                    dst = lin + (size_t)tok * 256 + (c0 - 1536);
                    if (c0 < 1600) {
#pragma unroll
                        for (int j = 0; j < 8; ++j) zs[j] = tanhf(zs[j]);
                    } else if (c0 >= 1664) {
#pragma unroll
                        for (int j = 0; j < 8; ++j) zs[j] = sigmoidf_(zs[j]);
                    }
                }
                *(u32x4*)dst = pack8(zs);
            }
        }
    }
}

__device__ void phase3(const Params& p, unsigned char* lds) {
    unsigned char* ws = lnd(p.ws); EPI_IDS
    const bf16_t* zm = (const bf16_t*)(ws + R_B);
    const bf16_t* lin = (const bf16_t*)(ws + R_A + 48 * MiB);
    const float* rsq = (const float*)(ws + OFF_RSQ); const float* rskv = (const float*)(ws + OFF_RSKV); const float* cs = (const float*)(ws + OFF_CS);
    bf16_t* qb = (bf16_t*)(ws + R_A); bf16_t* kn = (bf16_t*)(ws + R_E); bf16_t* vt = (bf16_t*)(ws + R_F);
    bf16_t* ks = (bf16_t*)(ws + R_D) + (size_t)T_TOK * 512;
    bf16_t* kk = (bf16_t*)(ws + R_C); bf16_t* bb = kk + (size_t)T_TOK * 512; bf16_t* om = bb + (size_t)T_TOK * 512;
    bf16_t* gg = (bf16_t*)(ws + R_H);
    constexpr int N_Q = 256 * 6, N_KN = 256 * 4, N_VT = 4 * 256, N_L = 256 * 4;
    constexpr int TOT = N_Q + N_KN + N_VT + 3 * N_L;
    for (int it = VB; it < TOT; it += VG) {
        f32x4 acc[4][4];
        if (it < N_Q) {
            const int rt = it / 6, ct = it % 6, m0 = rt * 128, n0 = ct * 128;
            gemm_core(zm + (size_t)m0 * 672, 672, (const bf16_t*)(ws + W_UQ) + (size_t)n0 * 384, 384, 384, acc, lds);
            const int G0 = (n0 + wc * 64) >> 4;
#pragma unroll
            for (int mi = 0; mi < 4; ++mi) {
                const int row = m0 + wr * 64 + mi * 16 + fr;
                const float sc = rsq[row] * QSCALE;
#pragma unroll
                for (int np = 0; np < 4; np += 2) {
                    const int r6 = (G0 + np) % 6;
                    f32x4 a = acc[mi][np] * sc, b = acc[mi][np + 1] * sc;
                    if (r6 == 4) {
                        const f32x4 c = *(const f32x4*)(cs + (size_t)row * 32 + fq * 4), s = *(const f32x4*)(cs + (size_t)row * 32 + 16 + fq * 4);
                        const f32x4 o1 = a * c - b * s, o2 = b * c + a * s; a = o1; b = o2;
                    }
                    const int col = n0 + wc * 64 + np * 16 + fq * 4;
                    u32x2 o; o.x = pk2(a[0], a[1]); o.y = pk2(a[2], a[3]); *(u32x2*)(qb + (size_t)row * 768 + col) = o;
                    o.x = pk2(b[0], b[1]); o.y = pk2(b[2], b[3]); *(u32x2*)(qb + (size_t)row * 768 + col + 16) = o;
                }
            }
        } else if (it < N_Q + N_KN) {
            const int i2 = it - N_Q, rt = i2 >> 2, ct = i2 & 3, m0 = rt * 128, n0 = ct * 128;
            gemm_core(zm + (size_t)m0 * 672 + 384, 672, (const bf16_t*)(ws + W_KN) + (size_t)n0 * 256, 256, 256, acc, lds);
#pragma unroll
            for (int mi = 0; mi < 4; ++mi) {
                const int row = m0 + wr * 64 + mi * 16 + fr; const float sc = rskv[row];
#pragma unroll
                for (int q = 0; q < 2; ++q) {
                    const int col = n0 + wc * 64 + q * 32 + fq * 8; const f32x4 a = acc[mi][2 * q] * sc, c = acc[mi][2 * q + 1] * sc;
                    u32x4 o; o.x = pk2(a[0], a[1]); o.y = pk2(a[2], a[3]); o.z = pk2(c[0], c[1]); o.w = pk2(c[2], c[3]);
                    *(u32x4*)(kn + (size_t)row * 512 + col) = o;
                }
            }
        } else if (it < N_Q + N_KN + N_VT) {
            const int i2 = it - N_Q - N_KN, rt = i2 & 3, ct = i2 >> 2, m0 = rt * 128, n0 = ct * 128;
            gemm_core((const bf16_t*)(ws + W_V) + (size_t)m0 * 256, 256, zm + (size_t)n0 * 672 + 384, 672, 256, acc, lds);
#pragma unroll
            for (int ni = 0; ni < 4; ++ni) {
                const int col = n0 + wc * 64 + ni * 16 + fq * 4; const f32x4 sc = *(const f32x4*)(rskv + col);
#pragma unroll
                for (int mi = 0; mi < 4; ++mi) {
                    const int row = m0 + wr * 64 + mi * 16 + fr; const f32x4 a = acc[mi][ni] * sc;
                    u32x2 o; o.x = pk2(a[0], a[1]); o.y = pk2(a[2], a[3]); *(u32x2*)(vt + (size_t)row * T_TOK + col) = o;
                }
            }
        } else {
            const int i2 = it - N_Q - N_KN - N_VT, which = i2 / N_L, i3 = i2 % N_L, rt = i3 >> 2, ct = i3 & 3, m0 = rt * 128, n0 = ct * 128;
            if (which == 0) {
                gemm_core(lin + (size_t)m0 * 256, 256, (const bf16_t*)(ws + W_W2) + (size_t)n0 * 64, 64, 64, acc, lds);
                const float* w0 = IN(11);
#pragma unroll
                for (int q = 0; q < 2; ++q) {
                    const int col = n0 + wc * 64 + q * 32 + fq * 8; const f32x4 w0a = *(const f32x4*)(w0 + col), w0b = *(const f32x4*)(w0 + col + 4);
#pragma unroll
                    for (int mi = 0; mi < 4; ++mi) {
                        const int row = m0 + wr * 64 + mi * 16 + fr; float o8[8];
#pragma unroll
                        for (int r = 0; r < 8; ++r) {
                            const float x = (r < 4 ? w0a[r & 3] : w0b[r & 3]) + (r < 4 ? acc[mi][2 * q][r & 3] : acc[mi][2 * q + 1][r & 3]);
                            const float e = 0.60653065971f * sigmoidf_(x);
                            o8[r] = e * (1.0f - e * (0.5f - e * (0.16666667f - e * (0.041666667f - e * (0.0083333333f - e * (0.0013888889f - e * 0.0001984127f))))));
                        }
                        *(u32x4*)(om + (size_t)row * 512 + col) = pack8(o8);
                    }
                }
            } else if (which == 1) {
                gemm_core(lin + (size_t)m0 * 256 + 64, 256, (const bf16_t*)(ws + W_A2) + (size_t)n0 * 64, 64, 64, acc, lds);
                const float* a0 = IN(13); const float* k_k = IN(16); const float* k_a = IN(17);
#pragma unroll
                for (int mi = 0; mi < 4; ++mi) {
                    const int row = m0 + wr * 64 + mi * 16 + fr;
                    float ksv[2][8], kkr[2][8], al[2][8]; float ss = 0.f;
#pragma unroll
                    for (int q = 0; q < 2; ++q) {
                        const int col = n0 + wc * 64 + q * 32 + fq * 8;
                        unpack8(*(const u32x4*)(ks + (size_t)row * 512 + col), ksv[q]);
                        const f32x4 a0a = *(const f32x4*)(a0 + col), a0b = *(const f32x4*)(a0 + col + 4), kka = *(const f32x4*)(k_k + col), kkb = *(const f32x4*)(k_k + col + 4);
#pragma unroll
                        for (int r = 0; r < 8; ++r) {
                            const float av = r < 4 ? acc[mi][2 * q][r & 3] : acc[mi][2 * q + 1][r & 3];
                            al[q][r] = sigmoidf_((r < 4 ? a0a[r & 3] : a0b[r & 3]) + av);
                            kkr[q][r] = ksv[q][r] * (r < 4 ? kka[r & 3] : kkb[r & 3]); ss += kkr[q][r] * kkr[q][r];
                        }
                    }
                    ss += __shfl_xor(ss, 16); ss += __shfl_xor(ss, 32);
                    const float inv = 1.0f / fmaxf(sqrtf(ss), 1e-12f);
#pragma unroll
                    for (int q = 0; q < 2; ++q) {
                        const int col = n0 + wc * 64 + q * 32 + fq * 8;
                        const f32x4 kaa = *(const f32x4*)(k_a + col), kab = *(const f32x4*)(k_a + col + 4);
                        float k1[8], b1[8], kp[8];
#pragma unroll
                        for (int r = 0; r < 8; ++r) { k1[r] = kkr[q][r] * inv; b1[r] = k1[r] * al[q][r]; kp[r] = ksv[q][r] * (1.0f + (al[q][r] - 1.0f) * (r < 4 ? kaa[r & 3] : kab[r & 3])); }
                        *(u32x4*)(kk + (size_t)row * 512 + col) = pack8(k1);
                        *(u32x4*)(bb + (size_t)row * 512 + col) = pack8(b1);
                        *(u32x4*)(ks + (size_t)row * 512 + col) = pack8(kp);
                    }
                }
            } else {
                gemm_core(lin + (size_t)m0 * 256 + 128, 256, (const bf16_t*)(ws + W_G2) + (size_t)n0 * 128, 128, 128, acc, lds);
#pragma unroll
                for (int mi = 0; mi < 4; ++mi) {
                    const int row = m0 + wr * 64 + mi * 16 + fr;
#pragma unroll
                    for (int q = 0; q < 2; ++q) {
                        const int col = n0 + wc * 64 + q * 32 + fq * 8; const f32x4 a = acc[mi][2 * q], c = acc[mi][2 * q + 1];
                        u32x4 o; o.x = pk2(a[0], a[1]); o.y = pk2(a[2], a[3]); o.z = pk2(c[0], c[1]); o.w = pk2(c[2], c[3]);
                        *(u32x4*)(gg + (size_t)row * 512 + col) = o;
                    }
                }
            }
        }
    }
}

struct HalfBar { unsigned addr; unsigned target; };
__device__ __forceinline__ void hb_sync(HalfBar& hb) {
    asm volatile("s_waitcnt lgkmcnt(0)" ::: "memory");
    hb.target += 4u;
    const int lane = threadIdx.x & 63;
    if (lane == 0) asm volatile("ds_add_u32 %0, %1" :: "v"(hb.addr), "v"(1u) : "memory");
    for (;;) {
        unsigned v;
        asm volatile("ds_read_b32 %0, %1\n\ts_waitcnt lgkmcnt(0)" : "=v"(v) : "v"(hb.addr) : "memory");
        if ((int)(__builtin_amdgcn_readfirstlane(v) - hb.target) >= 0) break;
        __builtin_amdgcn_s_sleep(1);
    }
    asm volatile("" ::: "memory");
}
#define SCAN_BAR() do { asm volatile("s_waitcnt lgkmcnt(0)" ::: "memory"); __builtin_amdgcn_s_barrier(); asm volatile("" ::: "memory"); } while (0)
constexpr int SCAN_CH = 32;
constexpr int SCAN_NBAR = 2 + (SEQ / SCAN_CH);
__device__ void scan_consumer(const Params& p, int si, unsigned char* lds) {
    unsigned char* ws = lnd(p.ws);
    const int chain = si >> 2, rg = si & 3, b = chain >> 3, h = chain & 7;
    const int tid = tidx(), w = tid >> 6, l = tid & 63, rowA = w * 4 + (l >> 4), kg = l & 15;
    const bf16_t* rs = (const bf16_t*)(ws + R_D); const bf16_t* ks = rs + (size_t)T_TOK * 512; const bf16_t* vs = ks + (size_t)T_TOK * 512;
    const bf16_t* kk = (const bf16_t*)(ws + R_C); const bf16_t* bb = kk + (size_t)T_TOK * 512; const bf16_t* om = bb + (size_t)T_TOK * 512;
    bf16_t* yo = (bf16_t*)(ws + R_I);
    float* ops = (float*)lds;
    float* vb = (float*)(lds + 81920);
    float* yb = (float*)(lds + 86016);
    const size_t tokb = (size_t)b * SEQ;
    const int lrem = tid & 127, lstep = lrem >> 3, lpart = lrem & 7, lhalf = tid >> 7;
    const bf16_t* sp0 = (lhalf ? om : kk) + (tokb + lstep) * 512 + h * 64 + lpart * 8;
    const bf16_t* sp1 = (lhalf ? ks : bb) + (tokb + lstep) * 512 + h * 64 + lpart * 8;
    const bf16_t* sp2 = rs + (tokb + lstep) * 512 + h * 64 + lpart * 8;
    const bf16_t* spv = vs + (tokb + ((tid & 31) >> 1)) * 512 + h * 64 + rg * 16 + (tid & 1) * 8;
    const int ldst0 = lstep * 320 + lhalf * 64 + lpart * 8, ldst1 = lstep * 320 + (2 + lhalf) * 64 + lpart * 8, ldst2 = lstep * 320 + 256 + lpart * 8;
    (void)sp0; (void)sp1; (void)sp2; (void)spv; (void)ldst0; (void)ldst1; (void)ldst2;
    constexpr int NCH = SEQ / SCAN_CH;
    const unsigned lds_ops = (unsigned)(size_t)(LAS unsigned char*)lds, lds_vb = lds_ops + 81920u, lds_yb = lds_ops + 86016u;
#define SC_RD(KK, DD, NB, K_, RR, VV, PA, PV, ST) do { \
        asm volatile("ds_read_b128 %0, %1 offset:%2" : "=v"(KK) : "v"(PA), "i"((ST) * 1280) : "memory"); \
        asm volatile("ds_read_b128 %0, %1 offset:%2" : "=v"(DD) : "v"(PA), "i"((ST) * 1280 + 256) : "memory"); \
        asm volatile("ds_read_b128 %0, %1 offset:%2" : "=v"(NB) : "v"(PA), "i"((ST) * 1280 + 512) : "memory"); \
        asm volatile("ds_read_b128 %0, %1 offset:%2" : "=v"(K_) : "v"(PA), "i"((ST) * 1280 + 768) : "memory"); \
        asm volatile("ds_read_b128 %0, %1 offset:%2" : "=v"(RR) : "v"(PA), "i"((ST) * 1280 + 1024) : "memory"); \
        asm volatile("ds_read_b32 %0, %1 offset:%2" : "=v"(VV) : "v"(PV), "i"((ST) * 64) : "memory"); } while (0)
#define SC_WAIT(N, KK, DD, NB, K_, RR, VV) asm volatile("s_waitcnt lgkmcnt(" #N ")" : "+v"(KK), "+v"(DD), "+v"(NB), "+v"(K_), "+v"(RR), "+v"(VV) :: "memory")
    typedef float f32x2 __attribute__((ext_vector_type(2)));
    f32x2 S01 = {0.f, 0.f}, S23 = {0.f, 0.f};
#define SC_STEP(ST, CKK, CD, CNB, CK, CR, CV, NKK, ND, NNB, NK, NR, NV, WN) do { \
        f32x2 u_ = {0.f, 0.f}; \
        if ((ST) > 0) { u_ = S01 * NR.xy; u_ = S23 * NR.zw + u_; } \
        if ((ST) < 31) SC_RD(NKK, ND, NNB, NK, NR, NV, pa, pv, (ST) + 1); \
        SC_WAIT(WN, CKK, CD, CNB, CK, CR, CV); \
        f32x2 t_ = S01 * CKK.xy; t_ = S23 * CKK.zw + t_; \
        float sa_ = t_.x + t_.y; \
        const f32x2 W01_ = S01 * CD.xy + CK.xy * CV, W23_ = S23 * CD.zw + CK.zw * CV; \
        float y_ = u_.x + u_.y; \
        sa_ += dppf<0x128>(sa_); sa_ += dppf<0x124>(sa_); \
        if ((ST) > 0) y_ += dppf<0x128>(y_); \
        sa_ += dppf<0x122>(sa_); sa_ += dppf<0x121>(sa_); \
        S01 = CNB.xy * sa_ + W01_; S23 = CNB.zw * sa_ + W23_; \
        if ((ST) > 0) asm volatile("ds_write_b32 %0, %1 offset:%2" :: "v"(pw), "v"(y_), "i"(((ST) > 0 ? (ST) - 1 : 0) * 512) : "memory"); } while (0)
    SCAN_BAR();
    SCAN_BAR();
    for (int c = 0; c < NCH; ++c) {
        const int buf = c & 1;
        const unsigned pa = lds_ops + (unsigned)(buf * 40960 + kg * 16), pv = lds_vb + (unsigned)(buf * 2048 + rowA * 4);
        const unsigned pw = lds_yb + (unsigned)(buf * 16384 + (rowA * 8 + (kg & 7)) * 4);
        f32x4 akk, ad, anb, ak, ar, bkk, bd, bnb, bk, br; float av, bv;
        SC_RD(akk, ad, anb, ak, ar, av, pa, pv, 0);
        SC_STEP(0, akk, ad, anb, ak, ar, av, bkk, bd, bnb, bk, br, bv, 6);
        SC_STEP(1, bkk, bd, bnb, bk, br, bv, akk, ad, anb, ak, ar, av, 6);
        SC_STEP(2, akk, ad, anb, ak, ar, av, bkk, bd, bnb, bk, br, bv, 7);
        SC_STEP(3, bkk, bd, bnb, bk, br, bv, akk, ad, anb, ak, ar, av, 7);
        SC_STEP(4, akk, ad, anb, ak, ar, av, bkk, bd, bnb, bk, br, bv, 7);
        SC_STEP(5, bkk, bd, bnb, bk, br, bv, akk, ad, anb, ak, ar, av, 7);
        SC_STEP(6, akk, ad, anb, ak, ar, av, bkk, bd, bnb, bk, br, bv, 7);
        SC_STEP(7, bkk, bd, bnb, bk, br, bv, akk, ad, anb, ak, ar, av, 7);
        SC_STEP(8, akk, ad, anb, ak, ar, av, bkk, bd, bnb, bk, br, bv, 7);
        SC_STEP(9, bkk, bd, bnb, bk, br, bv, akk, ad, anb, ak, ar, av, 7);
        SC_STEP(10, akk, ad, anb, ak, ar, av, bkk, bd, bnb, bk, br, bv, 7);
        SC_STEP(11, bkk, bd, bnb, bk, br, bv, akk, ad, anb, ak, ar, av, 7);
        SC_STEP(12, akk, ad, anb, ak, ar, av, bkk, bd, bnb, bk, br, bv, 7);
        SC_STEP(13, bkk, bd, bnb, bk, br, bv, akk, ad, anb, ak, ar, av, 7);
        SC_STEP(14, akk, ad, anb, ak, ar, av, bkk, bd, bnb, bk, br, bv, 7);
        SC_STEP(15, bkk, bd, bnb, bk, br, bv, akk, ad, anb, ak, ar, av, 7);
        SC_STEP(16, akk, ad, anb, ak, ar, av, bkk, bd, bnb, bk, br, bv, 7);
        SC_STEP(17, bkk, bd, bnb, bk, br, bv, akk, ad, anb, ak, ar, av, 7);
        SC_STEP(18, akk, ad, anb, ak, ar, av, bkk, bd, bnb, bk, br, bv, 7);
        SC_STEP(19, bkk, bd, bnb, bk, br, bv, akk, ad, anb, ak, ar, av, 7);
        SC_STEP(20, akk, ad, anb, ak, ar, av, bkk, bd, bnb, bk, br, bv, 7);
        SC_STEP(21, bkk, bd, bnb, bk, br, bv, akk, ad, anb, ak, ar, av, 7);
        SC_STEP(22, akk, ad, anb, ak, ar, av, bkk, bd, bnb, bk, br, bv, 7);
        SC_STEP(23, bkk, bd, bnb, bk, br, bv, akk, ad, anb, ak, ar, av, 7);
        SC_STEP(24, akk, ad, anb, ak, ar, av, bkk, bd, bnb, bk, br, bv, 7);
        SC_STEP(25, bkk, bd, bnb, bk, br, bv, akk, ad, anb, ak, ar, av, 7);
        SC_STEP(26, akk, ad, anb, ak, ar, av, bkk, bd, bnb, bk, br, bv, 7);
        SC_STEP(27, bkk, bd, bnb, bk, br, bv, akk, ad, anb, ak, ar, av, 7);
        SC_STEP(28, akk, ad, anb, ak, ar, av, bkk, bd, bnb, bk, br, bv, 7);
        SC_STEP(29, bkk, bd, bnb, bk, br, bv, akk, ad, anb, ak, ar, av, 7);
        SC_STEP(30, akk, ad, anb, ak, ar, av, bkk, bd, bnb, bk, br, bv, 7);
        SC_STEP(31, bkk, bd, bnb, bk, br, bv, akk, ad, anb, ak, ar, av, 1);
        {
            f32x2 u_ = S01 * br.xy; u_ = S23 * br.zw + u_;
            float y_ = u_.x + u_.y; y_ += dppf<0x128>(y_);
            asm volatile("ds_write_b32 %0, %1 offset:%2" :: "v"(pw), "v"(y_), "i"(31 * 512) : "memory");
        }
        asm volatile("s_waitcnt lgkmcnt(0)" ::: "memory");
        SCAN_BAR();
#pragma unroll
        for (int hh = 0; hh < 2; ++hh) {
            const int st = (tid >> 4) + 16 * hh, r = tid & 15;
            const float* yr = yb + buf * 4096 + st * 128 + r * 8;
            const f32x4 a0 = *(const f32x4*)(yr), a1 = *(const f32x4*)(yr + 4);
            const f32x4 sm = a0 + a1;
            const float y = (sm[0] + sm[1]) + (sm[2] + sm[3]);
            const unsigned short yv = (unsigned short)f2bf(y);
            const bf16_t* ya = yo + (tokb + (size_t)c * SCAN_CH + st) * 512 + h * 64 + rg * 16 + r;
            asm volatile("global_store_short %0, %1, off" :: "v"(ya), "v"((unsigned)yv) : "memory");
        }
    }
    asm volatile("s_waitcnt vmcnt(0)" ::: "memory");
}
__device__ void scan_producer(const Params& p, int si, unsigned char* lds) {
    unsigned char* ws = lnd(p.ws);
    const int chain = si >> 2, rg = si & 3, b = chain >> 3, h = chain & 7;
    const int tid = tidx(), w = tid >> 6, l = tid & 63, rowA = w * 4 + (l >> 4), kg = l & 15;
    const bf16_t* rs = (const bf16_t*)(ws + R_D); const bf16_t* ks = rs + (size_t)T_TOK * 512; const bf16_t* vs = ks + (size_t)T_TOK * 512;
    const bf16_t* kk = (const bf16_t*)(ws + R_C); const bf16_t* bb = kk + (size_t)T_TOK * 512; const bf16_t* om = bb + (size_t)T_TOK * 512;
    bf16_t* yo = (bf16_t*)(ws + R_I);
    float* ops = (float*)lds;
    float* vb = (float*)(lds + 81920);
    float* yb = (float*)(lds + 86016);
    const size_t tokb = (size_t)b * SEQ;
    const int lrem = tid & 127, lstep = lrem >> 3, lpart = lrem & 7, lhalf = tid >> 7;
    const bf16_t* sp0 = (lhalf ? om : kk) + (tokb + lstep) * 512 + h * 64 + lpart * 8;
    const bf16_t* sp1 = (lhalf ? ks : bb) + (tokb + lstep) * 512 + h * 64 + lpart * 8;
    const bf16_t* sp2 = rs + (tokb + lstep) * 512 + h * 64 + lpart * 8;
    const bf16_t* spv = vs + (tokb + ((tid & 31) >> 1)) * 512 + h * 64 + rg * 16 + (tid & 1) * 8;
    const int ldst0 = lstep * 320 + lhalf * 64 + lpart * 8, ldst1 = lstep * 320 + (2 + lhalf) * 64 + lpart * 8, ldst2 = lstep * 320 + 256 + lpart * 8;
    struct GSet { u32x4 g0, g1, g2, gv, h0, h1, h2, hv; };
    GSet RA, RB, RC;
    auto gload = [&](int c, GSet& R) {
        const size_t o = (size_t)c * SCAN_CH * 512 * 2, o2 = o + (size_t)16 * 512 * 2;
        const char* q0 = (const char*)sp0 + o; const char* q1 = (const char*)sp1 + o; const char* q2 = (const char*)sp2 + o; const char* q3 = (const char*)spv + o;
        const char* r0 = (const char*)sp0 + o2; const char* r1 = (const char*)sp1 + o2; const char* r2 = (const char*)sp2 + o2; const char* r3 = (const char*)spv + o2;
        asm volatile("global_load_dwordx4 %0, %1, off" : "=v"(R.g0) : "v"(q0) : "memory");
        asm volatile("global_load_dwordx4 %0, %1, off" : "=v"(R.g1) : "v"(q1) : "memory");
        asm volatile("global_load_dwordx4 %0, %1, off" : "=v"(R.g2) : "v"(q2) : "memory");
        asm volatile("global_load_dwordx4 %0, %1, off" : "=v"(R.gv) : "v"(q3) : "memory");
        asm volatile("global_load_dwordx4 %0, %1, off" : "=v"(R.h0) : "v"(r0) : "memory");
        asm volatile("global_load_dwordx4 %0, %1, off" : "=v"(R.h1) : "v"(r1) : "memory");
        asm volatile("global_load_dwordx4 %0, %1, off" : "=v"(R.h2) : "v"(r2) : "memory");
        asm volatile("global_load_dwordx4 %0, %1, off" : "=v"(R.hv) : "v"(r3) : "memory");
    };
    auto lstore1 = [&](int buf, int sub, const u32x4& x0, const u32x4& x1, const u32x4& x2, const u32x4& xv) {
        float f[8]; float* ob = ops + buf * 10240 + sub * 5120;
        unpack8(x0, f);
        if (lhalf) {
#pragma unroll
            for (int j = 0; j < 8; ++j) f[j] = 1.0f - f[j];
        }
        *(f32x4*)(ob + ldst0) = (f32x4){f[0], f[1], f[2], f[3]}; *(f32x4*)(ob + ldst0 + 4) = (f32x4){f[4], f[5], f[6], f[7]};
        unpack8(x1, f);
        if (!lhalf) {
#pragma unroll
            for (int j = 0; j < 8; ++j) f[j] = -f[j];
        }
        *(f32x4*)(ob + ldst1) = (f32x4){f[0], f[1], f[2], f[3]}; *(f32x4*)(ob + ldst1 + 4) = (f32x4){f[4], f[5], f[6], f[7]};
        if (tid < 128) { unpack8(x2, f); *(f32x4*)(ob + ldst2) = (f32x4){f[0], f[1], f[2], f[3]}; *(f32x4*)(ob + ldst2 + 4) = (f32x4){f[4], f[5], f[6], f[7]}; }
        if (tid < 32) { unpack8(xv, f); float* vd = vb + buf * 512 + sub * 256 + (tid >> 1) * 16 + (tid & 1) * 8;
            *(f32x4*)(vd) = (f32x4){f[0], f[1], f[2], f[3]}; *(f32x4*)(vd + 4) = (f32x4){f[4], f[5], f[6], f[7]}; }
    };
    auto lstore = [&](int buf, const GSet& R) { lstore1(buf, 0, R.g0, R.g1, R.g2, R.gv); lstore1(buf, 1, R.h0, R.h1, R.h2, R.hv); };
#define SC_VWAIT(N, R) asm volatile("s_waitcnt vmcnt(" #N ")" : "+v"(R.g0), "+v"(R.g1), "+v"(R.g2), "+v"(R.gv), "+v"(R.h0), "+v"(R.h1), "+v"(R.h2), "+v"(R.hv) :: "memory")
    constexpr int NCH = SEQ / SCAN_CH;
    (void)yo; (void)yb; (void)rowA; (void)kg;
    asm volatile("s_waitcnt vmcnt(0)" ::: "memory");
    SCAN_BAR();
    gload(0, RA); SC_VWAIT(0, RA); lstore(0, RA);
    gload(1, RB); gload(2, RC); gload(3, RA);
    SCAN_BAR();
    auto do_chunk = [&](int c, GSet& NX) {
        const int buf = c & 1;
        if (c + 1 < NCH) { SC_VWAIT(16, NX); lstore(buf ^ 1, NX); }
        SCAN_BAR();
        gload(c + 4 < NCH ? c + 4 : NCH - 1, NX);
    };
    for (int c = 0; c < NCH; c += 3) {
        do_chunk(c, RB);
        if (c + 1 < NCH) do_chunk(c + 1, RC);
        if (c + 2 < NCH) do_chunk(c + 2, RA);
    }
    asm volatile("s_waitcnt vmcnt(0)" ::: "memory");
}

__device__ __forceinline__ int pe_sw(int row) { return (0x78 >> (2 * ((row >> 2) & 3))) & 3; }
__device__ void attn_unit(const Params& p, int b, int h, int qblk, unsigned char* lds) {
    unsigned char* ws = lnd(p.ws);
    const bf16_t* Q = (const bf16_t*)(ws + R_A); const bf16_t* KN = (const bf16_t*)(ws + R_E); const bf16_t* VT = (const bf16_t*)(ws + R_F);
    const bf16_t* KP = (const bf16_t*)(ws + R_G); bf16_t* O = (bf16_t*)(ws + R_B);
    const int tid = tidx(), w = tid >> 6, l = tid & 63, fr = l & 15, g = l >> 4;
    const size_t tokb = (size_t)b * SEQ;
    const int q0 = qblk * 128 + w * 32;
    constexpr int BUFB = 21504, KP_OFF = 8192, VT_OFF = 12288;
    bf16x8 qf[2][3];
#pragma unroll
    for (int qi = 0; qi < 2; ++qi)
#pragma unroll
        for (int s = 0; s < 3; ++s) qf[qi][s] = *(const bf16x8*)(Q + (tokb + q0 + qi * 16 + fr) * 768 + h * 96 + s * 32 + g * 8);
    f32x4 o[4][2];
#pragma unroll
    for (int i = 0; i < 4; ++i) { o[i][0] = (f32x4){0.f, 0.f, 0.f, 0.f}; o[i][1] = (f32x4){0.f, 0.f, 0.f, 0.f}; }
    float mrun[2] = {-1e30f, -1e30f}, lsum[2] = {0.f, 0.f};
    const int ntiles = 2 * qblk + 2;
    const int kkey = tid >> 3, kkc = tid & 7;
    const int pkey = tid >> 2, pkc = tid & 3;
    const bf16_t* gkn = KN + (tokb + kkey) * 512 + h * 64 + kkc * 8;
    const bf16_t* gkp = KP + (tokb + pkey) * 32 + pkc * 8;
    const bf16_t* gvt = VT + ((size_t)h * 64 + kkey) * T_TOK + tokb + kkc * 8;
    const unsigned dkn = (unsigned)(kkey * 128 + ((kkc ^ (kkey & 7)) * 16));
    const unsigned dkp = (unsigned)(KP_OFF + pkey * 64 + ((pkc ^ pe_sw(pkey)) * 16));
    const unsigned dvt = (unsigned)(VT_OFF + kkey * 144 + kkc * 16);
    struct KVSet { u32x4 rk0, rk1, rp, rv0, rv1; };
    KVSet SA, SB;
    auto gload = [&](int kt, KVSet& R) {
        R.rk0 = *(const u32x4*)(gkn + (size_t)kt * 64 * 512); R.rk1 = *(const u32x4*)(gkn + ((size_t)kt * 64 + 32) * 512);
        R.rp = *(const u32x4*)(gkp + (size_t)kt * 64 * 32);
        R.rv0 = *(const u32x4*)(gvt + kt * 64); R.rv1 = *(const u32x4*)(gvt + (size_t)32 * T_TOK + kt * 64);
    };
    auto lstore = [&](int buf, const KVSet& R) {
        unsigned char* d = lds + buf * BUFB;
        *(u32x4*)(d + dkn) = R.rk0; *(u32x4*)(d + dkn + 32 * 128) = R.rk1; *(u32x4*)(d + dkp) = R.rp;
        *(u32x4*)(d + dvt) = R.rv0; *(u32x4*)(d + dvt + 32 * 144) = R.rv1;
    };
    const unsigned kfo0 = (unsigned)(fr * 128 + (((0 + g) ^ (fr & 7)) * 16)), kfo1 = (unsigned)(fr * 128 + (((4 + g) ^ (fr & 7)) * 16));
    const unsigned kfo2 = (unsigned)(KP_OFF + fr * 64 + ((g ^ pe_sw(fr)) * 16));
    const unsigned vfo = (unsigned)(VT_OFF + fr * 144 + g * 8);
    __syncthreads();
    gload(0, SA); lstore(0, SA);
    gload(1, SB);
    __syncthreads();
    auto tile_body = [&](int kt, const KVSet& NXT, KVSet& FREE) {
        const unsigned char* d = lds + (kt & 1) * BUFB;
        if (kt + 2 < ntiles) gload(kt + 2, FREE);
        f32x4 s_[4][2];
#pragma unroll
        for (int j = 0; j < 4; ++j) {
            const bf16x8 k0 = *(const bf16x8*)(d + kfo0 + j * 2048), k1 = *(const bf16x8*)(d + kfo1 + j * 2048), k2 = *(const bf16x8*)(d + kfo2 + j * 1024);
#pragma unroll
            for (int qi = 0; qi < 2; ++qi) {
                f32x4 a = {0.f, 0.f, 0.f, 0.f};
                a = __builtin_amdgcn_mfma_f32_16x16x32_bf16(k0, qf[qi][0], a, 0, 0, 0);
                a = __builtin_amdgcn_mfma_f32_16x16x32_bf16(k1, qf[qi][1], a, 0, 0, 0);
                a = __builtin_amdgcn_mfma_f32_16x16x32_bf16(k2, qf[qi][2], a, 0, 0, 0);
                s_[j][qi] = a;
            }
        }
        if (kt * 64 + 63 > q0) {
#pragma unroll
            for (int j = 0; j < 4; ++j)
#pragma unroll
                for (int qi = 0; qi < 2; ++qi)
#pragma unroll
                    for (int r = 0; r < 4; ++r) { const int key = kt * 64 + j * 16 + g * 4 + r, q = q0 + qi * 16 + fr; if (key > q) s_[j][qi][r] = -1e30f; }
        }
        bf16x8 pf[2][2];
#pragma unroll
        for (int qi = 0; qi < 2; ++qi) {
            float mx = -1e30f;
#pragma unroll
            for (int j = 0; j < 4; ++j) mx = fmaxf(mx, fmaxf(fmaxf(s_[j][qi][0], s_[j][qi][1]), fmaxf(s_[j][qi][2], s_[j][qi][3])));
            mx = fmaxf(mx, __shfl_xor(mx, 16)); mx = fmaxf(mx, __shfl_xor(mx, 32));
            const float mn = fmaxf(mrun[qi], mx);
            const float alpha = __builtin_amdgcn_exp2f(mrun[qi] - mn);
            mrun[qi] = mn;
            float psum = 0.f;
#pragma unroll
            for (int j = 0; j < 4; ++j)
#pragma unroll
                for (int r = 0; r < 4; ++r) { const float pv = __builtin_amdgcn_exp2f(s_[j][qi][r] - mn); s_[j][qi][r] = pv; psum += pv; }
            lsum[qi] = lsum[qi] * alpha + psum;
#pragma unroll
            for (int dt = 0; dt < 4; ++dt) o[dt][qi] = o[dt][qi] * alpha;
#pragma unroll
            for (int ksx = 0; ksx < 2; ++ksx) {
                u32x4 pw; pw.x = pk2(s_[2 * ksx][qi][0], s_[2 * ksx][qi][1]); pw.y = pk2(s_[2 * ksx][qi][2], s_[2 * ksx][qi][3]);
                pw.z = pk2(s_[2 * ksx + 1][qi][0], s_[2 * ksx + 1][qi][1]); pw.w = pk2(s_[2 * ksx + 1][qi][2], s_[2 * ksx + 1][qi][3]);
                pf[ksx][qi] = __builtin_bit_cast(bf16x8, pw);
            }
        }
#pragma unroll
        for (int ksx = 0; ksx < 2; ++ksx)
#pragma unroll
            for (int dt = 0; dt < 4; ++dt) {
                const u32x2 v0 = *(const u32x2*)(d + vfo + dt * 16 * 144 + ksx * 64), v1 = *(const u32x2*)(d + vfo + dt * 16 * 144 + ksx * 64 + 32);
                u32x4 vw; vw.x = v0.x; vw.y = v0.y; vw.z = v1.x; vw.w = v1.y;
                const bf16x8 vf = __builtin_bit_cast(bf16x8, vw);
                o[dt][0] = __builtin_amdgcn_mfma_f32_16x16x32_bf16(vf, pf[ksx][0], o[dt][0], 0, 0, 0);
                o[dt][1] = __builtin_amdgcn_mfma_f32_16x16x32_bf16(vf, pf[ksx][1], o[dt][1], 0, 0, 0);
            }
        if (kt + 1 < ntiles) lstore((kt + 1) & 1, NXT);
        __syncthreads();
    };
    for (int kt = 0; kt < ntiles; kt += 2) { tile_body(kt, SB, SA); tile_body(kt + 1, SA, SB); }
#pragma unroll
    for (int qi = 0; qi < 2; ++qi) {
        float lt = lsum[qi]; lt += __shfl_xor(lt, 16); lt += __shfl_xor(lt, 32);
        const float inv = 1.0f / lt;
        const size_t tok = tokb + q0 + qi * 16 + fr;
#pragma unroll
        for (int dt = 0; dt < 4; ++dt) {
            const f32x4 v = o[dt][qi] * inv;
            u32x2 ow; ow.x = pk2(v[0], v[1]); ow.y = pk2(v[2], v[3]);
            *(u32x2*)(O + tok * 512 + h * 64 + dt * 16 + g * 4) = ow;
        }
    }
}

__device__ void phase4(const Params& p, unsigned char* lds, int* s_item, int rep) {
    if (VHALF == 0) {
        for (int si = blockIdx.x; si < 128; si += gridDim.x) {
            __builtin_amdgcn_s_setprio(3);
            scan_consumer(p, si, lds);
            __builtin_amdgcn_s_setprio(0);
        }
    } else {
        for (int si = blockIdx.x; si < 128; si += gridDim.x) scan_producer(p, si, lds - 65536);
    }
    unsigned* queue = (unsigned*)(p.ws + OFF_QUEUE) + 512 * rep;
    const int myx = (int)(xb_xcc_id() & 7u);
    for (;;) {
        __syncthreads();
        if (threadIdx.x == 0) {
            int code = -1;
            for (int k = 0; k < 8; ++k) {
                const int xx = (myx + k) & 7;
                const unsigned it = atomicAdd(queue + xx * 16, 2u);
                if (it < 256u) { code = xx * 256 + (int)it; break; }
            }
            s_item[0] = code;
        }
        __syncthreads();
        const int code = s_item[0];
        if (code < 0) break;
        const int h = code >> 8, it = (code & 255) + VHALF;
        const int qblk = 63 - (it >> 2), b = it & 3;
        attn_unit(p, b, h, qblk, lds);
    }
}

__device__ void phase5(const Params& p) {
    unsigned char* ws = lnd(p.ws);
    const bf16_t* __restrict__ rs = (const bf16_t*)(ws + R_D); const bf16_t* __restrict__ ks = rs + (size_t)T_TOK * 512; const bf16_t* __restrict__ vs = ks + (size_t)T_TOK * 512;
    const bf16_t* __restrict__ yv = (const bf16_t*)(ws + R_I); const bf16_t* __restrict__ gg = (const bf16_t*)(ws + R_H);
    bf16_t* __restrict__ ybp = (bf16_t*)(ws + R_C);
    const float* lnw = IN(19); const float* lnb = IN(20); const float* rk = IN(18);
    const int l = tidx() & 63, gw = VB * 4 + (tidx() >> 6), nw = VG * 4;
    const int c0 = l * 8;
    float wv[8], bv[8], rkv[8];
    { const f32x4 a = *(const f32x4*)(lnw + c0), b = *(const f32x4*)(lnw + c0 + 4), c = *(const f32x4*)(lnb + c0), d = *(const f32x4*)(lnb + c0 + 4), e = *(const f32x4*)(rk + c0), f = *(const f32x4*)(rk + c0 + 4);
#pragma unroll
      for (int j = 0; j < 4; ++j) { wv[j] = a[j]; wv[j + 4] = b[j]; bv[j] = c[j]; bv[j + 4] = d[j]; rkv[j] = e[j]; rkv[j + 4] = f[j]; } }
#pragma unroll 2
    for (int tok = gw; tok < T_TOK; tok += nw) {
        const size_t off = (size_t)tok * 512 + c0;
        float y[8], r[8], k[8], v[8], g[8];
        unpack8(*(const u32x4*)(yv + off), y); unpack8(*(const u32x4*)(rs + off), r); unpack8(*(const u32x4*)(ks + off), k);
        unpack8(*(const u32x4*)(vs + off), v); unpack8(*(const u32x4*)(gg + off), g);
        float s = 0.f, bs = 0.f;
#pragma unroll
        for (int j = 0; j < 8; ++j) { s += y[j]; bs += r[j] * k[j] * rkv[j]; }
        s += __shfl_xor(s, 1); s += __shfl_xor(s, 2); s += __shfl_xor(s, 4);
        bs += __shfl_xor(bs, 1); bs += __shfl_xor(bs, 2); bs += __shfl_xor(bs, 4);
        const float mean = s * (1.0f / 64.0f);
        float q = 0.f;
#pragma unroll
        for (int j = 0; j < 8; ++j) { const float d = y[j] - mean; q += d * d; }
        q += __shfl_xor(q, 1); q += __shfl_xor(q, 2); q += __shfl_xor(q, 4);
        const float rstd = rsqrtf(q * (1.0f / 64.0f) + 64e-5f);
        float o[8];
#pragma unroll
        for (int j = 0; j < 8; ++j) o[j] = ((y[j] - mean) * rstd * wv[j] + bv[j] + bs * v[j]) * g[j];
        *(u32x4*)(ybp + off) = pack8(o);
    }
    rmsnorm_rows_bf16(IN(0), IN(3), (bf16_t*)(ws + R_A));
}

__device__ void phase6(const Params& p, unsigned char* lds8) {
    unsigned char* ws = lnd(p.ws); EPI8_IDS
    const bf16_t* h = (const bf16_t*)(ws + R_A); const bf16_t* ob = (const bf16_t*)(ws + R_B); const bf16_t* ybp = (const bf16_t*)(ws + R_C);
    const bf16_t* Wg = (const bf16_t*)(ws + W_IN) + (size_t)2464 * 1024;
    bf16_t* mo = (bf16_t*)(ws + R_D);
    bf16_t* gsc = (bf16_t*)(ws + R_C + 32 * MiB);
    for (int iter = 0, rt, ct; tile_map8(iter, 128, 4, rt, ct); ++iter) {
        const int m0 = rt * 256, n0 = ct * 256;
        const int row0 = m0 + wr * 128 + fr, col0 = n0 + wc * 64 + fq * 8;
        f32x4 acc[8][4];
#pragma unroll 1
        for (int pass = 0; pass < 2; ++pass) {
            gemm8(h + (size_t)m0 * 1024, 1024, Wg + (size_t)(pass * 1024 + n0) * 1024, 1024, 1024, acc, lds8);
#pragma unroll
            for (int mi = 0; mi < 8; ++mi) {
#pragma unroll
                for (int q = 0; q < 2; ++q) {
                    float v[8];
#pragma unroll
                    for (int r = 0; r < 4; ++r) { v[r] = sigmoidf_(acc[mi][2 * q][r]); v[4 + r] = sigmoidf_(acc[mi][2 * q + 1][r]); }
                    *(u32x4*)(gsc + (size_t)(row0 + mi * 16) * 1024 + col0 + q * 32) = pack8(v);
                }
            }
            if (pass == 0) gemm8(ob + (size_t)m0 * 512, 512, (const bf16_t*)(ws + W_OA) + (size_t)n0 * 512, 512, 512, acc, lds8);
            else gemm8(ybp + (size_t)m0 * 512, 512, (const bf16_t*)(ws + W_OB) + (size_t)n0 * 512, 512, 512, acc, lds8);
            {
                u32x4 gn[2], pn[2];
#pragma unroll
                for (int q = 0; q < 2; ++q) { gn[q] = *(const u32x4*)(gsc + (size_t)row0 * 1024 + col0 + q * 32); pn[q] = pass ? *(const u32x4*)(mo + (size_t)row0 * 1024 + col0 + q * 32) : (u32x4){0u, 0u, 0u, 0u}; }
#pragma unroll
                for (int mi = 0; mi < 8; ++mi) {
                    const int row = row0 + mi * 16;
                    u32x4 gc[2], pc[2];
#pragma unroll
                    for (int q = 0; q < 2; ++q) { gc[q] = gn[q]; pc[q] = pn[q]; }
                    if (mi < 7) {
#pragma unroll
                        for (int q = 0; q < 2; ++q) { gn[q] = *(const u32x4*)(gsc + (size_t)(row + 16) * 1024 + col0 + q * 32); pn[q] = pass ? *(const u32x4*)(mo + (size_t)(row + 16) * 1024 + col0 + q * 32) : (u32x4){0u, 0u, 0u, 0u}; }
                    }
#pragma unroll
                    for (int q = 0; q < 2; ++q) {
                        float g[8], pv[8], v[8];
                        unpack8(gc[q], g); unpack8(pc[q], pv);
#pragma unroll
                        for (int r = 0; r < 4; ++r) { v[r] = g[r] * acc[mi][2 * q][r] + pv[r]; v[4 + r] = g[4 + r] * acc[mi][2 * q + 1][r] + pv[4 + r]; }
                        *(u32x4*)(mo + (size_t)row * 1024 + col0 + q * 32) = pack8(v);
                    }
                }
            }
        }
    }
}

__device__ __forceinline__ void epi_residual8(const f32x4 (&acc)[8][4], int m0, int n0, const float* xin, float* xo, bf16_t* xb, float* ssq, const float* ss_in) {
    EPI8_IDS
    const int row0 = m0 + wr * 128 + fr, col0 = n0 + wc * 64 + fq * 8;
    f32x4 xn[4]; float sn = 0.f;
#pragma unroll
    for (int q = 0; q < 2; ++q) { xn[2 * q] = *(const f32x4*)(xin + (size_t)row0 * DM + col0 + q * 32); xn[2 * q + 1] = *(const f32x4*)(xin + (size_t)row0 * DM + col0 + q * 32 + 4); }
    if (ss_in) sn = ss_in[row0];
#pragma unroll
    for (int mi = 0; mi < 8; ++mi) {
        const int row = row0 + mi * 16;
        f32x4 xc[4]; const float sc_in = sn;
#pragma unroll
        for (int i = 0; i < 4; ++i) xc[i] = xn[i];
        if (mi < 7) {
#pragma unroll
            for (int q = 0; q < 2; ++q) { xn[2 * q] = *(const f32x4*)(xin + (size_t)(row + 16) * DM + col0 + q * 32); xn[2 * q + 1] = *(const f32x4*)(xin + (size_t)(row + 16) * DM + col0 + q * 32 + 4); }
            if (ss_in) sn = ss_in[row + 16];
        }
        float sc = 1.0f;
        if (ss_in) { const float r = rsqrtf(sc_in * (1.0f / DM) + RMS_EPS); sc = r * r; }
        float ss = 0.f;
#pragma unroll
        for (int q = 0; q < 2; ++q) {
            const int col = col0 + q * 32;
            const f32x4 v0 = xc[2 * q] + acc[mi][2 * q] * sc, v1 = xc[2 * q + 1] + acc[mi][2 * q + 1] * sc;
            *(f32x4*)(xo + (size_t)row * DM + col) = v0; *(f32x4*)(xo + (size_t)row * DM + col + 4) = v1;
            u32x4 o; o.x = pk2(v0[0], v0[1]); o.y = pk2(v0[2], v0[3]); o.z = pk2(v1[0], v1[1]); o.w = pk2(v1[2], v1[3]);
            *(u32x4*)(xb + (size_t)row * DM + col) = o;
            ss += (v0[0] * v0[0] + v0[1] * v0[1] + v0[2] * v0[2] + v0[3] * v0[3]) + (v1[0] * v1[0] + v1[1] * v1[1] + v1[2] * v1[2] + v1[3] * v1[3]);
        }
        ss += __shfl_xor(ss, 16); ss += __shfl_xor(ss, 32);
        if (fq == 0) atomicAdd(ssq + row, ss);
    }
}

__device__ void phase7(const Params& p, unsigned char* lds8) {
    unsigned char* ws = lnd(p.ws);
    const bf16_t* mo = (const bf16_t*)(ws + R_D);
    for (int iter = 0, rt, ct; tile_map8(iter, 128, 4, rt, ct); ++iter) {
        const int m0 = rt * 256, n0 = ct * 256;
        f32x4 acc[8][4];
        gemm8(mo + (size_t)m0 * 1024, 1024, (const bf16_t*)(ws + W_OUT) + (size_t)n0 * 1024, 1024, 1024, acc, lds8);
        epi_residual8(acc, m0, n0, IN(0), lnd(p.out), (bf16_t*)(ws + R_A), (float*)(ws + OFF_SS1), nullptr);
    }
}
__device__ void phase8(const Params& p, unsigned char* lds8) {
    unsigned char* ws = lnd(p.ws); EPI8_IDS
    const bf16_t* xb = (const bf16_t*)(ws + R_A); bf16_t* u = (bf16_t*)(ws + R_U);
    for (int iter = 0, rt, ct; tile_map8(iter, 128, 16, rt, ct); ++iter) {
        const int m0 = rt * 256, n0 = ct * 256;
        f32x4 acc[8][4];
        gemm8(xb + (size_t)m0 * 1024, 1024, (const bf16_t*)(ws + W_UP) + (size_t)n0 * 1024, 1024, 1024, acc, lds8);
#pragma unroll
        for (int mi = 0; mi < 8; ++mi) {
            const int row = m0 + wr * 128 + mi * 16 + fr;
#pragma unroll
            for (int q = 0; q < 2; ++q) {
                const int col = n0 + wc * 64 + q * 32 + fq * 8;
                float v[8];
#pragma unroll
                for (int r = 0; r < 4; ++r) { const float a = fmaxf(acc[mi][2 * q][r], 0.f), c = fmaxf(acc[mi][2 * q + 1][r], 0.f); v[r] = a * a; v[4 + r] = c * c; }
                *(u32x4*)(u + (size_t)row * 4096 + col) = pack8(v);
            }
        }
    }
}
__device__ void phase9(const Params& p, unsigned char* lds8) {
    unsigned char* ws = lnd(p.ws);
    const bf16_t* u = (const bf16_t*)(ws + R_U);
    for (int iter = 0, rt, ct; tile_map8(iter, 128, 4, rt, ct); ++iter) {
        const int m0 = rt * 256, n0 = ct * 256;
        f32x4 acc[8][4];
        gemm8(u + (size_t)m0 * 4096, 4096, (const bf16_t*)(ws + W_DN) + (size_t)n0 * 4096, 4096, 4096, acc, lds8);
        epi_residual8(acc, m0, n0, lnd(p.out), lnd(p.out), (bf16_t*)(ws + R_A), (float*)(ws + OFF_SS2), (const float*)(ws + OFF_SS1));
    }
}
__device__ void phase10(const Params& p, unsigned char* lds8) {
    unsigned char* ws = lnd(p.ws); EPI8_IDS
    const bf16_t* xb = (const bf16_t*)(ws + R_A); const bf16_t* pb = (const bf16_t*)(ws + R_PB);
    const float* ss2 = (const float*)(ws + OFF_SS2);
    float* xo = lnd(p.out);
    bf16_t* ppb = (bf16_t*)(ws + R_B);
    for (int iter = 0, rt, ct; tile_map8(iter, 128, 4, rt, ct); ++iter) {
        const int m0 = rt * 256, n0 = ct * 256;
        const int row0 = m0 + wr * 128 + fr, col0 = n0 + wc * 64 + fq * 8;
        f32x4 acc[8][4];
        gemm8(pb + (size_t)m0 * 256, 256, (const bf16_t*)(ws + W_PP) + (size_t)n0 * 256, 256, 256, acc, lds8);
#pragma unroll
        for (int mi = 0; mi < 8; ++mi) {
#pragma unroll
            for (int q = 0; q < 2; ++q) {
                u32x4 o; o.x = pk2(acc[mi][2 * q][0], acc[mi][2 * q][1]); o.y = pk2(acc[mi][2 * q][2], acc[mi][2 * q][3]);
                o.z = pk2(acc[mi][2 * q + 1][0], acc[mi][2 * q + 1][1]); o.w = pk2(acc[mi][2 * q + 1][2], acc[mi][2 * q + 1][3]);
                *(u32x4*)(ppb + (size_t)(row0 + mi * 16) * 1024 + col0 + q * 32) = o;
            }
        }
        gemm8(xb + (size_t)m0 * 1024, 1024, (const bf16_t*)(ws + W_PG) + (size_t)n0 * 1024, 1024, 1024, acc, lds8);
        {
            f32x4 xn[4]; u32x4 pn[2]; float sn;
#pragma unroll
            for (int q = 0; q < 2; ++q) { xn[2 * q] = *(const f32x4*)(xo + (size_t)row0 * DM + col0 + q * 32); xn[2 * q + 1] = *(const f32x4*)(xo + (size_t)row0 * DM + col0 + q * 32 + 4);
                                          pn[q] = *(const u32x4*)(ppb + (size_t)row0 * 1024 + col0 + q * 32); }
            sn = ss2[row0];
#pragma unroll
            for (int mi = 0; mi < 8; ++mi) {
                const int row = row0 + mi * 16;
                f32x4 xc[4]; u32x4 pc[2]; const float rstd = rsqrtf(sn * (1.0f / DM) + RMS_EPS);
#pragma unroll
                for (int i = 0; i < 4; ++i) xc[i] = xn[i];
                pc[0] = pn[0]; pc[1] = pn[1];
                if (mi < 7) {
#pragma unroll
                    for (int q = 0; q < 2; ++q) { xn[2 * q] = *(const f32x4*)(xo + (size_t)(row + 16) * DM + col0 + q * 32); xn[2 * q + 1] = *(const f32x4*)(xo + (size_t)(row + 16) * DM + col0 + q * 32 + 4);
                                                  pn[q] = *(const u32x4*)(ppb + (size_t)(row + 16) * 1024 + col0 + q * 32); }
                    sn = ss2[row + 16];
                }
#pragma unroll
                for (int q = 0; q < 2; ++q) {
                    float pf[8]; unpack8(pc[q], pf);
                    f32x4 v0 = xc[2 * q], v1 = xc[2 * q + 1];
#pragma unroll
                    for (int r = 0; r < 4; ++r) { v0[r] += sigmoidf_(acc[mi][2 * q][r] * rstd) * pf[r]; v1[r] += sigmoidf_(acc[mi][2 * q + 1][r] * rstd) * pf[4 + r]; }
                    *(f32x4*)(xo + (size_t)row * DM + col0 + q * 32) = v0; *(f32x4*)(xo + (size_t)row * DM + col0 + q * 32 + 4) = v1;
                }
            }
        }
    }
}
__device__ void phase11(const Params& p) {
    float* x = lnd(p.out); const float* g = IN(29);
    const int l = tidx() & 63, gw = VB * 4 + (tidx() >> 6), nw = VG * 4;
    for (int row = gw; row < T_TOK; row += 2 * nw) {
        const int row2 = row + nw; const bool has2 = row2 < T_TOK;
        float* xr = x + (size_t)row * DM; float* xr2 = x + (size_t)(has2 ? row2 : row) * DM;
        f32x4 v[4], w[4]; float ss = 0.f, ss2 = 0.f;
#pragma unroll
        for (int i = 0; i < 4; ++i) { v[i] = *(const f32x4*)(xr + i * 256 + l * 4); w[i] = *(const f32x4*)(xr2 + i * 256 + l * 4); }
#pragma unroll
        for (int i = 0; i < 4; ++i) { ss += v[i][0] * v[i][0] + v[i][1] * v[i][1] + v[i][2] * v[i][2] + v[i][3] * v[i][3]; ss2 += w[i][0] * w[i][0] + w[i][1] * w[i][1] + w[i][2] * w[i][2] + w[i][3] * w[i][3]; }
        ss = wave_sum(ss); ss2 = wave_sum(ss2);
        const float rs = rsqrtf(ss * (1.0f / DM) + RMS_EPS), rs2 = rsqrtf(ss2 * (1.0f / DM) + RMS_EPS);
#pragma unroll
        for (int i = 0; i < 4; ++i) {
            const f32x4 gg = *(const f32x4*)(g + i * 256 + l * 4);
            *(f32x4*)(xr + i * 256 + l * 4) = v[i] * rs * gg;
            if (has2) *(f32x4*)(xr2 + i * 256 + l * 4) = w[i] * rs2 * gg;
        }
    }
}

extern __shared__ __attribute__((aligned(16))) unsigned char dyn_lds[];
constexpr int DYN_LDS = 131072;
__global__ void __launch_bounds__(512, 2) mega(Params p) {
    unsigned char* lds = dyn_lds + VHALF * 65536;
    __shared__ uint4 xbw;
    __shared__ int s_item[2];
    const bool single = (p.ph_hi - p.ph_lo) > 1;
    if (threadIdx.x == 0) xbw = make_uint4(0u, 0u, 0u, 0u);
    __syncthreads();
    XcdBarrier xb; xb.bar = (unsigned*)(p.ws + OFF_BAR); xb.x = 0; xb.st = (volatile LAS unsigned*)&xbw;
    if (single) xb = xcd_barrier_post((unsigned*)(p.ws + OFF_BAR), (volatile LAS unsigned*)&xbw);
    if (p.ph_lo < 0) cg::this_grid().sync();
#ifndef PROBE_MASK
#define PROBE_MASK 0
#endif
#ifndef PROBE_DUP
#define PROBE_DUP -1
#endif
    for (int ph = p.ph_lo; ph < p.ph_hi; ++ph)
    for (int rep = 0; rep < ((ph == PROBE_DUP || ((PROBE_MASK >> ph) & 1)) ? 2 : 1); ++rep) {
#ifndef ONLY_PH
#define ONLY_PH -1
#endif
#ifndef SKIP_PH
#define SKIP_PH -1
#endif
#define RUNPH(k, call) if ((ONLY_PH < 0 || ONLY_PH == k) && SKIP_PH != k && ph == k) { call; }
        RUNPH(0, phase0(p)) RUNPH(1, phase1(p, dyn_lds)) RUNPH(2, phase2(p)) RUNPH(3, phase3(p, lds)) RUNPH(4, phase4(p, lds, s_item, rep)) RUNPH(5, phase5(p))
        RUNPH(6, phase6(p, dyn_lds)) RUNPH(7, phase7(p, dyn_lds)) RUNPH(8, phase8(p, dyn_lds)) RUNPH(9, phase9(p, dyn_lds)) RUNPH(10, phase10(p, dyn_lds)) RUNPH(11, phase11(p))
        if (ph + 1 < p.ph_hi || rep == 0) xcd_barrier(xb);
    }
}

extern "C" void kernel_launch(void* const* d_in, const int* in_sizes, int n_in, void* d_out, int out_size, void* d_ws, size_t ws_size, hipStream_t stream) {
    static int grid_blocks = 0;
    if (!grid_blocks) {
        int dev = 0, cus = 0, per_cu = 0;
        hipGetDevice(&dev);
        hipDeviceGetAttribute(&cus, hipDeviceAttributeMultiprocessorCount, dev);
        hipFuncSetAttribute((const void*)mega, hipFuncAttributeMaxDynamicSharedMemorySize, DYN_LDS);
        hipOccupancyMaxActiveBlocksPerMultiprocessor(&per_cu, mega, 512, DYN_LDS);
        if (per_cu > 1) per_cu = 1;
        if (per_cu < 1) per_cu = 1;
        grid_blocks = cus * per_cu;
    }
    if (ws_size < WS_NEED) { fprintf(stderr, "workspace too small: %zu < %zu\n", ws_size, (size_t)WS_NEED); return; }
    Params p{};
    for (int i = 0; i < 30; ++i) p.in[i] = (const float*)d_in[i];
    p.out = (float*)d_out; p.ws = (unsigned char*)d_ws;
    hipMemsetAsync(d_ws, 0, ZERO_BYTES, stream);
#if MK_MULTI
    for (int ph = 0; ph < NPH; ++ph) { p.ph_lo = ph; p.ph_hi = ph + 1; hipLaunchKernelGGL(mega, dim3(grid_blocks), dim3(512), DYN_LDS, stream, p); }
#else
    p.ph_lo = 0; p.ph_hi = NPH;
    void* args[] = {&p};
    hipError_t e = hipLaunchCooperativeKernel((void*)mega, dim3(grid_blocks), dim3(512), args, DYN_LDS, stream);
    if (e != hipSuccess) fprintf(stderr, "cooperative launch failed: %s (grid %d)\n", hipGetErrorString(e), grid_blocks);
#endif
}
```

```cpp
#include <hip/hip_runtime.h>
#include <hip/hip_cooperative_groups.h>
#include <stdint.h>
#include <stdio.h>
namespace cg = cooperative_groups;

#ifndef MK_MULTI
#define MK_MULTI 0
#endif

typedef unsigned short bf16_t;
typedef short bf16x8 __attribute__((ext_vector_type(8)));
typedef float f32x4 __attribute__((ext_vector_type(4)));
typedef unsigned u32x4 __attribute__((ext_vector_type(4)));
typedef unsigned u32x2 __attribute__((ext_vector_type(2)));
#define LAS __attribute__((address_space(3)))

constexpr int T_TOK = 32768, SEQ = 8192, DM = 1024;
constexpr int NPH = 12;
constexpr float RMS_EPS = 1e-6f;
constexpr float QSCALE = 0.10206207261596577f * 1.4426950408889634f;

constexpr size_t MiB = 1ull << 20;
constexpr size_t OFF_BAR = 0, OFF_QUEUE = 16384, ZERO_BYTES = 32768;
constexpr size_t OFF_SS1 = 65536, OFF_SS2 = OFF_SS1 + 131072, OFF_RSQ = OFF_SS2 + 131072, OFF_RSKV = OFF_RSQ + 131072;
constexpr size_t OFF_CS = 1 * MiB;
constexpr size_t OFF_W = 5 * MiB;
constexpr size_t W_IN = OFF_W;
constexpr size_t W_UQ = W_IN + 4608ull * 1024 * 2;
constexpr size_t W_KN = W_UQ + 768ull * 384 * 2;
constexpr size_t W_V = W_KN + 512ull * 256 * 2;
constexpr size_t W_OA = W_V + 512ull * 256 * 2;
constexpr size_t W_W2 = W_OA + 1024ull * 512 * 2;
constexpr size_t W_A2 = W_W2 + 512ull * 64 * 2;
constexpr size_t W_G2 = W_A2 + 512ull * 64 * 2;
constexpr size_t W_OB = W_G2 + 512ull * 128 * 2;
constexpr size_t W_OUT = W_OB + 1024ull * 512 * 2;
constexpr size_t W_UP = W_OUT + 1024ull * 1024 * 2;
constexpr size_t W_DN = W_UP + 4096ull * 1024 * 2;
constexpr size_t W_PG = W_DN + 4096ull * 1024 * 2;
constexpr size_t W_PP = W_PG + 1024ull * 1024 * 2;
constexpr size_t W_END = W_PP + 1024ull * 256 * 2;
static_assert(W_END <= 42 * MiB, "weights region");
constexpr size_t R_A = 42 * MiB;
constexpr size_t R_B = 106 * MiB;
constexpr size_t R_C = 148 * MiB;
constexpr size_t R_D = 260 * MiB;
constexpr size_t R_E = 356 * MiB;
constexpr size_t R_F = 388 * MiB;
constexpr size_t R_G = 420 * MiB;
constexpr size_t R_H = 422 * MiB;
constexpr size_t R_I = 454 * MiB;
constexpr size_t R_PB = 486 * MiB;
constexpr size_t WS_NEED = 502 * MiB;
constexpr size_t R_U = R_B;

struct Params {
    const float* in[30];
    float* out;
    unsigned char* ws;
    int ph_lo, ph_hi;
};

#define GAS __attribute__((address_space(1)))
template <class T> __device__ __forceinline__ T* lnd(T* q) { GAS T* g = (GAS T*)q; asm volatile("" : "+s"(g)); return (T*)g; }
#define IN(k) lnd(p.in[k])
#define VHALF ((int)__builtin_amdgcn_readfirstlane((int)(threadIdx.x >> 8)))
#define VB ((int)blockIdx.x * 2 + VHALF)
#define VG ((int)gridDim.x * 2)
__device__ __forceinline__ int tidx512() { int t = threadIdx.x; asm volatile("" : "+v"(t)); return t; }
__device__ __forceinline__ int tidx() { int t = threadIdx.x & 255; asm volatile("" : "+v"(t)); return t; }
__device__ __forceinline__ unsigned f2bf(float f) { unsigned u = __float_as_uint(f); return (u + 0x7fffu + ((u >> 16) & 1u)) >> 16; }
typedef float f32x2_t __attribute__((ext_vector_type(2)));
typedef __bf16 bf16x2_t __attribute__((ext_vector_type(2)));
__device__ __forceinline__ unsigned pk2(float lo, float hi) { f32x2_t v = {lo, hi}; bf16x2_t b = __builtin_convertvector(v, bf16x2_t); return __builtin_bit_cast(unsigned, b); }
__device__ __forceinline__ float bflo(unsigned w) { return __uint_as_float(w << 16); }
__device__ __forceinline__ float bfhi(unsigned w) { return __uint_as_float(w & 0xffff0000u); }
__device__ __forceinline__ float bf1(bf16_t v) { return __uint_as_float((unsigned)v << 16); }
__device__ __forceinline__ void unpack8(const u32x4 w, float (&f)[8]) {
    f[0] = bflo(w.x); f[1] = bfhi(w.x); f[2] = bflo(w.y); f[3] = bfhi(w.y); f[4] = bflo(w.z); f[5] = bfhi(w.z); f[6] = bflo(w.w); f[7] = bfhi(w.w);
}
__device__ __forceinline__ u32x4 pack8(const float (&f)[8]) { u32x4 w; w.x = pk2(f[0], f[1]); w.y = pk2(f[2], f[3]); w.z = pk2(f[4], f[5]); w.w = pk2(f[6], f[7]); return w; }
__device__ __forceinline__ float sigmoidf_(float x) { return __builtin_amdgcn_rcpf(1.0f + __expf(-x)); }
__device__ __forceinline__ float wave_sum(float v) {
#pragma unroll
    for (int o = 32; o >= 1; o >>= 1) v += __shfl_xor(v, o);
    return v;
}
template <int CTRL> __device__ __forceinline__ float dppf(float v) {
    return __int_as_float(__builtin_amdgcn_update_dpp(0, __float_as_int(v), CTRL, 0xf, 0xf, false));
}
__device__ __forceinline__ float row16_sum(float v) {
    v += dppf<0x128>(v); v += dppf<0x124>(v); v += dppf<0x122>(v); v += dppf<0x121>(v); return v;
}

#define XB_TMO      128
#define XB_XCNT(j)  (256  + 64 * (j))
#define XB_XSUB(j)  (1280 + 64 * (j))
#define XB_XGEN(j)  (2304 + 64 * (j))
#define XB_TOP      3328
#define XB_TOPGEN   3392
#define XCD_BAR_WORDS 3456
#define XB_SPIN_CAP (1u << 22)
__device__ __forceinline__ unsigned xb_ld(unsigned* p) { return __hip_atomic_load(p, __ATOMIC_RELAXED, __HIP_MEMORY_SCOPE_AGENT); }
__device__ __forceinline__ unsigned xb_add(unsigned* p, unsigned v) { return __hip_atomic_fetch_add(p, v, __ATOMIC_RELAXED, __HIP_MEMORY_SCOPE_AGENT); }
__device__ __forceinline__ unsigned xb_xcc_id() { return (unsigned)__builtin_amdgcn_s_getreg((3 << 11) | 20) & 0xFu; }
#define XB_SPIN(cond, bar) do { unsigned _sp = 0; while (cond) { __builtin_amdgcn_s_sleep(1); \
    if ((++_sp & 255u) == 0u) { if (xb_ld(&(bar)[XB_TMO])) break; if (_sp > XB_SPIN_CAP) { atomicAdd(&(bar)[XB_TMO], 1u); break; } } } } while (0)
struct XcdBarrier { unsigned* bar; unsigned x; volatile LAS unsigned* st; };
__device__ __forceinline__ XcdBarrier xcd_barrier_post(unsigned* bar, volatile LAS unsigned* st) {
    XcdBarrier b; b.bar = bar; b.x = xb_xcc_id(); b.st = st;
    if (threadIdx.x == 0) (void)xb_add(&bar[XB_XCNT(b.x)], 1u);
    return b;
}
__device__ __forceinline__ void xcd_barrier_complete(unsigned* bar, unsigned x, unsigned& nloc, unsigned& nx) {
    const unsigned G = gridDim.x * gridDim.y * gridDim.z;
    unsigned sum, cnt, mine, sp = 0u;
    for (;;) {
        sum = 0u; cnt = 0u; mine = 0u;
#pragma unroll
        for (unsigned j = 0; j < 16; ++j) { const unsigned c = xb_ld(&bar[XB_XCNT(j)]); sum += c; cnt += (c > 0u) ? 1u : 0u; mine = (j == x) ? c : mine; }
        if (sum == G) break;
        __builtin_amdgcn_s_sleep(1);
        if ((++sp & 255u) == 0u) { if (xb_ld(&bar[XB_TMO])) break; if (sp > XB_SPIN_CAP) { atomicAdd(&bar[XB_TMO], 1u); break; } }
    }
    nloc = mine > 0u ? mine : 1u; nx = cnt > 0u ? cnt : 1u;
}
__device__ __forceinline__ void xcd_barrier(const XcdBarrier& b) {
    asm volatile("s_waitcnt vmcnt(0)" ::: "memory");
    __syncthreads();
    if (threadIdx.x == 0) {
        unsigned* bar = b.bar;
        __builtin_amdgcn_s_waitcnt(0);
        unsigned nloc = b.st[0], nx = b.st[1];
        if (nloc == 0u) { xcd_barrier_complete(bar, b.x, nloc, nx); b.st[0] = nloc; b.st[1] = nx; }
        const unsigned old = xb_add(&bar[XB_XSUB(b.x)], 1u);
        const unsigned gen = old / nloc;
        if (old + 1u == (gen + 1u) * nloc) {
            __builtin_amdgcn_fence(__ATOMIC_RELEASE, "agent");
            asm volatile("s_waitcnt vmcnt(0)" ::: "memory");
            const unsigned og = xb_add(&bar[XB_TOP], 1u);
            const unsigned tg = og / nx;
            if (og + 1u == (tg + 1u) * nx) xb_add(&bar[XB_TOPGEN], 1u);
            else XB_SPIN(xb_ld(&bar[XB_TOPGEN]) == tg, bar);
            __builtin_amdgcn_fence(__ATOMIC_ACQUIRE, "agent");
            xb_add(&bar[XB_XGEN(b.x)], 1u);
            asm volatile("s_waitcnt vmcnt(0)" ::: "memory");
        } else {
            XB_SPIN(xb_ld(&bar[XB_XGEN(b.x)]) == gen, bar);
            __builtin_amdgcn_fence(__ATOMIC_ACQUIRE, "agent");
            asm volatile("s_waitcnt vmcnt(0)" ::: "memory");
        }
    }
    __syncthreads();
}

__device__ __forceinline__ int sw64(int row) { return (0x78 >> (2 * ((row >> 2) & 3))) & 3; }
__device__ __forceinline__ void gemm_core(const bf16_t* A, int lda, const bf16_t* Bt, int ldb, int K, f32x4 (&acc)[4][4], unsigned char* lds) {
    const int tid = tidx(), l = tid & 63, w = __builtin_amdgcn_readfirstlane(tid >> 6), wr = w >> 1, wc = w & 1, fr = l & 15, fq = l >> 4;
#pragma unroll
    for (int i = 0; i < 4; ++i)
#pragma unroll
        for (int j = 0; j < 4; ++j) acc[i][j] = (f32x4){0.f, 0.f, 0.f, 0.f};
    const int nk = K >> 5;
    const int rin = l >> 2, skc = (l & 3) ^ sw64(rin);
    const bf16_t* ga = A + (size_t)(w * 32 + rin) * lda + skc * 8;
    const bf16_t* gb = Bt + (size_t)(w * 32 + rin) * ldb + skc * 8;
    LAS unsigned char* L = (LAS unsigned char*)lds + w * 2048;
    const unsigned aoff = (unsigned)((wr * 64 + fr) * 64 + ((fq ^ sw64(fr)) * 16)), boff = (unsigned)(8192 + (wc * 64 + fr) * 64 + ((fq ^ sw64(fr)) * 16));
#define GC_ISSUE(kt_) do { LAS unsigned char* Ld_ = L + ((kt_) & 3) * 16384; \
        __builtin_amdgcn_global_load_lds((const unsigned*)(ga + (kt_) * 32), (LAS unsigned*)(Ld_), 16, 0, 0); \
        __builtin_amdgcn_global_load_lds((const unsigned*)(ga + (size_t)16 * lda + (kt_) * 32), (LAS unsigned*)(Ld_ + 1024), 16, 0, 0); \
        __builtin_amdgcn_global_load_lds((const unsigned*)(gb + (kt_) * 32), (LAS unsigned*)(Ld_ + 8192), 16, 0, 0); \
        __builtin_amdgcn_global_load_lds((const unsigned*)(gb + (size_t)16 * ldb + (kt_) * 32), (LAS unsigned*)(Ld_ + 8192 + 1024), 16, 0, 0); } while (0)
    const unsigned lbase = (unsigned)(size_t)(LAS unsigned char*)lds;
    asm volatile("s_waitcnt vmcnt(0)" ::: "memory");
    __syncthreads();
    GC_ISSUE(0);
    if (nk > 1) GC_ISSUE(1);
    if (nk > 2) GC_ISSUE(2);
#define GC_RD(dst, addr, OFF) asm volatile("ds_read_b128 %0, %1 offset:" #OFF : "=v"(dst) : "v"(addr) : "memory")
    for (int kt = 0; kt < nk; ++kt) {
        if (kt + 2 < nk) asm volatile("s_waitcnt vmcnt(8)" ::: "memory");
        else if (kt + 1 < nk) asm volatile("s_waitcnt vmcnt(4)" ::: "memory");
        else asm volatile("s_waitcnt vmcnt(0)" ::: "memory");
        __builtin_amdgcn_s_barrier();
        asm volatile("" ::: "memory");
        if (kt + 3 < nk) GC_ISSUE(kt + 3);
        const unsigned sa = lbase + (unsigned)((kt & 3) * 16384) + aoff, sb = lbase + (unsigned)((kt & 3) * 16384) + boff;
        bf16x8 a0, a1, a2, a3, b0, b1, b2, b3;
        GC_RD(a0, sa, 0); GC_RD(b0, sb, 0); GC_RD(a1, sa, 1024); GC_RD(b1, sb, 1024);
        GC_RD(a2, sa, 2048); GC_RD(b2, sb, 2048); GC_RD(a3, sa, 3072); GC_RD(b3, sb, 3072);
#define GC_MMA(mi, ni, A_, B_) acc[mi][ni] = __builtin_amdgcn_mfma_f32_16x16x32_bf16(B_, A_, acc[mi][ni], 0, 0, 0)
        asm volatile("s_waitcnt lgkmcnt(4)" : "+v"(a0), "+v"(a1), "+v"(b0), "+v"(b1) :: "memory");
        GC_MMA(0, 0, a0, b0); GC_MMA(0, 1, a0, b1); GC_MMA(1, 0, a1, b0); GC_MMA(1, 1, a1, b1);
        asm volatile("s_waitcnt lgkmcnt(2)" : "+v"(a2), "+v"(b2) :: "memory");
        GC_MMA(0, 2, a0, b2); GC_MMA(1, 2, a1, b2); GC_MMA(2, 0, a2, b0); GC_MMA(2, 1, a2, b1); GC_MMA(2, 2, a2, b2);
        asm volatile("s_waitcnt lgkmcnt(0)" : "+v"(a3), "+v"(b3) :: "memory");
        GC_MMA(0, 3, a0, b3); GC_MMA(1, 3, a1, b3); GC_MMA(2, 3, a2, b3); GC_MMA(3, 0, a3, b0); GC_MMA(3, 1, a3, b1); GC_MMA(3, 2, a3, b2); GC_MMA(3, 3, a3, b3);
    }
    __syncthreads();
}
__device__ __forceinline__ bool tile_map(int iter, int MT, int NT, int& rt, int& ct) {
    const int G = gridDim.x;
    if ((G & 7) == 0 && (MT & 63) == 0) {
        const int x = blockIdx.x & 7, lb = (blockIdx.x >> 3) * 2 + VHALF, nlb = (G >> 3) * 2, MTx = MT >> 3;
        const int li = lb + iter * nlb;
        if (li >= MTx * NT) return false;
        const int per = 8 * NT, rg = li / per, r = li - rg * per;
        ct = r >> 3; rt = x * MTx + rg * 8 + (r & 7);
        return true;
    }
    const int it = VB + iter * VG;
    if (it >= MT * NT) return false;
    rt = it / NT; ct = it - rt * NT; return true;
}
__device__ __forceinline__ void gemm8(const bf16_t* A, int lda, const bf16_t* Bt, int ldb, int K, f32x4 (&acc)[8][4], unsigned char* lds) {
    const int tid = tidx512(), l = tid & 63, w = __builtin_amdgcn_readfirstlane(tid >> 6), wr = w >> 2, wc = w & 3, fr = l & 15, fq = l >> 4;
#pragma unroll
    for (int i = 0; i < 8; ++i)
#pragma unroll
        for (int j = 0; j < 4; ++j) acc[i][j] = (f32x4){0.f, 0.f, 0.f, 0.f};
    const int nk = K >> 6;
    const int rin = l >> 3, skc = (l & 7) ^ (rin & 7);
    const bf16_t* ga = A + (size_t)(w * 32 + rin) * lda + skc * 8;
    const bf16_t* gb = Bt + (size_t)(w * 32 + rin) * ldb + skc * 8;
    LAS unsigned char* L = (LAS unsigned char*)lds + w * 4096;
#define G8_ISSUE(kt_) do { LAS unsigned char* Ld_ = L + ((kt_) & 1) * 65536; \
        __builtin_amdgcn_global_load_lds((const unsigned*)(ga + (kt_) * 64), (LAS unsigned*)(Ld_), 16, 0, 0); \
        __builtin_amdgcn_global_load_lds((const unsigned*)(ga + (size_t)8 * lda + (kt_) * 64), (LAS unsigned*)(Ld_ + 1024), 16, 0, 0); \
        __builtin_amdgcn_global_load_lds((const unsigned*)(ga + (size_t)16 * lda + (kt_) * 64), (LAS unsigned*)(Ld_ + 2048), 16, 0, 0); \
        __builtin_amdgcn_global_load_lds((const unsigned*)(ga + (size_t)24 * lda + (kt_) * 64), (LAS unsigned*)(Ld_ + 3072), 16, 0, 0); \
        __builtin_amdgcn_global_load_lds((const unsigned*)(gb + (kt_) * 64), (LAS unsigned*)(Ld_ + 32768), 16, 0, 0); \
        __builtin_amdgcn_global_load_lds((const unsigned*)(gb + (size_t)8 * ldb + (kt_) * 64), (LAS unsigned*)(Ld_ + 32768 + 1024), 16, 0, 0); \
        __builtin_amdgcn_global_load_lds((const unsigned*)(gb + (size_t)16 * ldb + (kt_) * 64), (LAS unsigned*)(Ld_ + 32768 + 2048), 16, 0, 0); \
        __builtin_amdgcn_global_load_lds((const unsigned*)(gb + (size_t)24 * ldb + (kt_) * 64), (LAS unsigned*)(Ld_ + 32768 + 3072), 16, 0, 0); } while (0)
    const unsigned lbase = (unsigned)(size_t)(LAS unsigned char*)lds;
    const unsigned arow = (unsigned)((wr * 128 + fr) * 128), brow = (unsigned)(32768 + (wc * 64 + fr) * 128);
    const unsigned sw0 = (unsigned)(((0 + fq) ^ (fr & 7)) * 16), sw1 = (unsigned)(((4 + fq) ^ (fr & 7)) * 16);
    asm volatile("s_waitcnt vmcnt(0)" ::: "memory");
    __syncthreads();
    G8_ISSUE(0);
#define G8_MMA(mi, ni, A_, B_) acc[mi][ni] = __builtin_amdgcn_mfma_f32_16x16x32_bf16(B_, A_, acc[mi][ni], 0, 0, 0)
#define G8_HALF(sa, sb, F1, F2, F3, F4) do { \
        bf16x8 a0, a1, a2, a3, b0, b1, b2, b3, c0, c1, c2, c3; \
        GC_RD(b0, sb, 0); GC_RD(b1, sb, 2048); GC_RD(b2, sb, 4096); GC_RD(b3, sb, 6144); \
        GC_RD(a0, sa, 0); GC_RD(a1, sa, 2048); GC_RD(a2, sa, 4096); GC_RD(a3, sa, 6144); \
        asm volatile("s_waitcnt lgkmcnt(2)" : "+v"(b0), "+v"(b1), "+v"(b2), "+v"(b3), "+v"(a0), "+v"(a1) :: "memory"); \
        G8_MMA(0, 0, a0, b0); G8_MMA(0, 1, a0, b1); G8_MMA(0, 2, a0, b2); G8_MMA(0, 3, a0, b3); \
        G8_MMA(1, 0, a1, b0); G8_MMA(1, 1, a1, b1); G8_MMA(1, 2, a1, b2); G8_MMA(1, 3, a1, b3); \
        F1; \
        asm volatile("s_waitcnt lgkmcnt(0)" : "+v"(a2), "+v"(a3) :: "memory"); \
        G8_MMA(2, 0, a2, b0); G8_MMA(2, 1, a2, b1); G8_MMA(2, 2, a2, b2); G8_MMA(2, 3, a2, b3); \
        G8_MMA(3, 0, a3, b0); G8_MMA(3, 1, a3, b1); G8_MMA(3, 2, a3, b2); G8_MMA(3, 3, a3, b3); \
        GC_RD(c0, sa, 8192); GC_RD(c1, sa, 10240); GC_RD(c2, sa, 12288); GC_RD(c3, sa, 14336); \
        F2; \
        asm volatile("s_waitcnt lgkmcnt(2)" : "+v"(c0), "+v"(c1) :: "memory"); \
        G8_MMA(4, 0, c0, b0); G8_MMA(4, 1, c0, b1); G8_MMA(4, 2, c0, b2); G8_MMA(4, 3, c0, b3); \
        G8_MMA(5, 0, c1, b0); G8_MMA(5, 1, c1, b1); G8_MMA(5, 2, c1, b2); G8_MMA(5, 3, c1, b3); \
        F3; \
        asm volatile("s_waitcnt lgkmcnt(0)" : "+v"(c2), "+v"(c3) :: "memory"); \
        G8_MMA(6, 0, c2, b0); G8_MMA(6, 1, c2, b1); G8_MMA(6, 2, c2, b2); G8_MMA(6, 3, c2, b3); \
        G8_MMA(7, 0, c3, b0); G8_MMA(7, 1, c3, b1); G8_MMA(7, 2, c3, b2); G8_MMA(7, 3, c3, b3); \
        F4; } while (0)
#define G8_PA(kt_, j) __builtin_amdgcn_global_load_lds((const unsigned*)(ga + (size_t)(8 * (j)) * lda + (kt_) * 64), (LAS unsigned*)(L + ((kt_) & 1) * 65536 + 1024 * (j)), 16, 0, 0)
#define G8_PB(kt_, j) __builtin_amdgcn_global_load_lds((const unsigned*)(gb + (size_t)(8 * (j)) * ldb + (kt_) * 64), (LAS unsigned*)(L + ((kt_) & 1) * 65536 + 32768 + 1024 * (j)), 16, 0, 0)
    for (int kt = 0; kt < nk; ++kt) {
        asm volatile("s_waitcnt vmcnt(0)" ::: "memory");
        __builtin_amdgcn_s_barrier();
        asm volatile("" ::: "memory");
        const bool nxt = kt + 1 < nk;
        const unsigned slot = lbase + (unsigned)((kt & 1) * 65536);
        const unsigned sa0 = slot + arow + sw0, sb0 = slot + brow + sw0, sa1 = slot + arow + sw1, sb1 = slot + brow + sw1;
        __builtin_amdgcn_s_setprio(1);
        G8_HALF(sa0, sb0,
                if (nxt) { G8_PA(kt + 1, 0); G8_PB(kt + 1, 0); },
                if (nxt) { G8_PA(kt + 1, 1); G8_PB(kt + 1, 1); },
                if (nxt) { G8_PA(kt + 1, 2); G8_PB(kt + 1, 2); },
                if (nxt) { G8_PA(kt + 1, 3); G8_PB(kt + 1, 3); });
        G8_HALF(sa1, sb1, (void)0, (void)0, (void)0, (void)0);
        __builtin_amdgcn_s_setprio(0);
    }
    __syncthreads();
}
__device__ __forceinline__ bool tile_map8(int iter, int MT, int NT, int& rt, int& ct) {
    const int G = gridDim.x;
    if ((G & 7) == 0 && (MT & 63) == 0) {
        const int x = blockIdx.x & 7, lb = blockIdx.x >> 3, nlb = G >> 3, MTx = MT >> 3;
        const int li = lb + iter * nlb;
        if (li >= MTx * NT) return false;
        const int per = 4 * NT, rg = li / per, r = li - rg * per;
        ct = r >> 2; rt = x * MTx + rg * 4 + (r & 3);
        return true;
    }
    const int it = (int)blockIdx.x + iter * G;
    if (it >= MT * NT) return false;
    rt = it / NT; ct = it - rt * NT; return true;
}
#define EPI8_IDS const int tid_ = tidx512(), l_ = tid_ & 63, w_ = tid_ >> 6, wr = w_ >> 2, wc = w_ & 3, fr = l_ & 15, fq = l_ >> 4; (void)wr; (void)wc; (void)fr; (void)fq;
#define EPI_IDS const int tid_ = tidx(), l_ = tid_ & 63, w_ = tid_ >> 6, wr = w_ >> 1, wc = w_ & 1, fr = l_ & 15, fq = l_ >> 4; (void)wr; (void)wc; (void)fr; (void)fq;

__device__ void transpose_job(const float* __restrict__ W, int K, int ldw, int rows, int mode, int perm, const float* __restrict__ gs, bf16_t* __restrict__ Wt, int gtid, int gthreads) {
    const int nch = rows * (K >> 3), nnb = rows >> 3;
    for (int id = gtid; id < nch; id += gthreads) {
        const int tile = id >> 6, lane = id & 63;
        const int n = (tile % nnb) * 8 + (lane & 7), kc = (tile / nnb) * 8 + (lane >> 3);
        int nn = n;
        if (perm) { const int j = n & 31; nn = (n & ~31) + ((j >> 2) & 3) * 8 + (j >> 4) * 4 + (j & 3); }
        int col = nn;
        if (mode == 1) col = (nn >> 6) * 128 + (nn & 63); else if (mode == 2) col = (nn >> 6) * 128 + 64 + (nn & 63);
        float v[8];
#pragma unroll
        for (int j = 0; j < 8; ++j) { const int k = kc * 8 + j; float x = W[(size_t)k * ldw + col]; if (gs) x *= gs[k]; v[j] = x; }
        *(u32x4*)(Wt + (size_t)n * K + kc * 8) = pack8(v);
    }
}
__device__ void rmsnorm_rows_bf16(const float* __restrict__ x, const float* __restrict__ g, bf16_t* __restrict__ h) {
    const int l = tidx() & 63, gw = VB * 4 + (tidx() >> 6), nw = VG * 4;
    for (int row = gw; row < T_TOK; row += 2 * nw) {
        const int row2 = row + nw; const bool has2 = row2 < T_TOK;
        const float* xr = x + (size_t)row * DM; const float* xr2 = x + (size_t)(has2 ? row2 : row) * DM;
        f32x4 v[4], w[4]; float ss = 0.f, ss2 = 0.f;
#pragma unroll
        for (int i = 0; i < 4; ++i) { v[i] = *(const f32x4*)(xr + i * 256 + l * 4); w[i] = *(const f32x4*)(xr2 + i * 256 + l * 4); }
#pragma unroll
        for (int i = 0; i < 4; ++i) { ss += v[i][0] * v[i][0] + v[i][1] * v[i][1] + v[i][2] * v[i][2] + v[i][3] * v[i][3]; ss2 += w[i][0] * w[i][0] + w[i][1] * w[i][1] + w[i][2] * w[i][2] + w[i][3] * w[i][3]; }
        ss = wave_sum(ss); ss2 = wave_sum(ss2);
        const float rs = rsqrtf(ss * (1.0f / DM) + RMS_EPS), rs2 = rsqrtf(ss2 * (1.0f / DM) + RMS_EPS);
#pragma unroll
        for (int i = 0; i < 4; ++i) {
            const f32x4 gg = *(const f32x4*)(g + i * 256 + l * 4);
            u32x2 o; o.x = pk2(v[i][0] * rs * gg[0], v[i][1] * rs * gg[1]); o.y = pk2(v[i][2] * rs * gg[2], v[i][3] * rs * gg[3]);
            *(u32x2*)(h + (size_t)row * DM + i * 256 + l * 4) = o;
            if (has2) { u32x2 o2; o2.x = pk2(w[i][0] * rs2 * gg[0], w[i][1] * rs2 * gg[1]); o2.y = pk2(w[i][2] * rs2 * gg[2], w[i][3] * rs2 * gg[3]);
                        *(u32x2*)(h + (size_t)row2 * DM + i * 256 + l * 4) = o2; }
        }
    }
}

__device__ void phase0(const Params& p) {
    unsigned char* ws = lnd(p.ws);
    const int gtid = VB * 256 + tidx(), gth = VG * 256;
    transpose_job(IN(4), 1024, 4512, 4512, 0, 1, nullptr, (bf16_t*)(ws + W_IN), gtid, gth);
    transpose_job(IN(6), 384, 768, 768, 0, 0, IN(5), (bf16_t*)(ws + W_UQ), gtid, gth);
    transpose_job(IN(8), 256, 1024, 512, 1, 1, IN(7), (bf16_t*)(ws + W_KN), gtid, gth);
    transpose_job(IN(8), 256, 1024, 512, 2, 0, IN(7), (bf16_t*)(ws + W_V), gtid, gth);
    transpose_job(IN(9), 512, 1024, 1024, 0, 1, nullptr, (bf16_t*)(ws + W_OA), gtid, gth);
    transpose_job(IN(12), 64, 512, 512, 0, 1, nullptr, (bf16_t*)(ws + W_W2), gtid, gth);
    transpose_job(IN(14), 64, 512, 512, 0, 1, nullptr, (bf16_t*)(ws + W_A2), gtid, gth);
    transpose_job(IN(15), 128, 512, 512, 0, 1, nullptr, (bf16_t*)(ws + W_G2), gtid, gth);
    transpose_job(IN(21), 512, 1024, 1024, 0, 1, nullptr, (bf16_t*)(ws + W_OB), gtid, gth);
    transpose_job(IN(22), 1024, 1024, 1024, 0, 1, nullptr, (bf16_t*)(ws + W_OUT), gtid, gth);
    transpose_job(IN(24), 1024, 4096, 4096, 0, 1, IN(23), (bf16_t*)(ws + W_UP), gtid, gth);
    transpose_job(IN(25), 4096, 1024, 1024, 0, 1, nullptr, (bf16_t*)(ws + W_DN), gtid, gth);
    transpose_job(IN(27), 1024, 1024, 1024, 0, 1, IN(26), (bf16_t*)(ws + W_PG), gtid, gth);
    transpose_job(IN(28), 256, 1024, 1024, 0, 1, nullptr, (bf16_t*)(ws + W_PP), gtid, gth);
    {
        const float* pp = IN(1); bf16_t* pb = (bf16_t*)(ws + R_PB);
        for (int id = gtid; id < T_TOK * 256 / 8; id += gth) {
            const f32x4 a = *(const f32x4*)(pp + (size_t)id * 8), b = *(const f32x4*)(pp + (size_t)id * 8 + 4);
            u32x4 o; o.x = pk2(a[0], a[1]); o.y = pk2(a[2], a[3]); o.z = pk2(b[0], b[1]); o.w = pk2(b[2], b[3]);
            *(u32x4*)(pb + (size_t)id * 8) = o;
        }
    }
    { float* z = (float*)(ws + OFF_SS1); for (int id = gtid; id < 2 * T_TOK; id += gth) z[id] = 0.f; }
    rmsnorm_rows_bf16(IN(0), IN(3), (bf16_t*)(ws + R_A));
}

__device__ void phase1(const Params& p, unsigned char* lds8) {
    unsigned char* ws = lnd(p.ws); EPI8_IDS
    const bf16_t* h = (const bf16_t*)(ws + R_A); const bf16_t* Wt = (const bf16_t*)(ws + W_IN);
    bf16_t* zm = (bf16_t*)(ws + R_B); bf16_t* zr = (bf16_t*)(ws + R_C);
    for (int iter = 0, rt, ct; tile_map8(iter, 128, 10, rt, ct); ++iter) {
        const int m0 = rt * 256, n0 = ct * 256;
        f32x4 acc[8][4];
        gemm8(h + (size_t)m0 * 1024, 1024, Wt + (size_t)n0 * 1024, 1024, 1024, acc, lds8);
#pragma unroll
        for (int mi = 0; mi < 8; ++mi) {
            const int row = m0 + wr * 128 + mi * 16 + fr;
#pragma unroll
            for (int q = 0; q < 2; ++q) {
                const int col = n0 + wc * 64 + q * 32 + fq * 8;
                u32x4 o; o.x = pk2(acc[mi][2 * q][0], acc[mi][2 * q][1]); o.y = pk2(acc[mi][2 * q][2], acc[mi][2 * q][3]);
                o.z = pk2(acc[mi][2 * q + 1][0], acc[mi][2 * q + 1][1]); o.w = pk2(acc[mi][2 * q + 1][2], acc[mi][2 * q + 1][3]);
                if (col < 672) *(u32x4*)(zm + (size_t)row * 672 + col) = o;
                else if (col < 2464) *(u32x4*)(zr + (size_t)row * 1792 + (col - 672)) = o;
            }
        }
    }
}

__device__ void phase2(const Params& p) {
    unsigned char* ws = lnd(p.ws);
    const bf16_t* __restrict__ zm = (const bf16_t*)(ws + R_B); const bf16_t* __restrict__ zr = (const bf16_t*)(ws + R_C);
    float* __restrict__ rsq = (float*)(ws + OFF_RSQ); float* __restrict__ rskv = (float*)(ws + OFF_RSKV); float* __restrict__ cs = (float*)(ws + OFF_CS);
    bf16_t* __restrict__ kpe = (bf16_t*)(ws + R_G);
    bf16_t* __restrict__ lin = (bf16_t*)(ws + R_A + 48 * MiB);
    bf16_t* __restrict__ rs = (bf16_t*)(ws + R_D); bf16_t* __restrict__ ks = rs + (size_t)T_TOK * 512; bf16_t* __restrict__ vs = ks + (size_t)T_TOK * 512;
    const float* mu = IN(10); const int* pos = (const int*)IN(2);
    const int l = tidx() & 63, gw = VB * 4 + (tidx() >> 6), nw = VG * 4;
#pragma unroll 2
    for (int tok = gw; tok < T_TOK; tok += nw) {
        const bf16_t* zrow = zm + (size_t)tok * 672;
        float sq = 0.f, skv = 0.f;
        {
            float f[8]; unpack8(*(const u32x4*)(zrow + l * 8), f);
            float s = 0.f;
#pragma unroll
            for (int j = 0; j < 8; ++j) s += f[j] * f[j];
            if (l < 48) sq += s; else skv += s;
            if (l < 16) { unpack8(*(const u32x4*)(zrow + (64 + l) * 8), f); s = 0.f;
#pragma unroll
                for (int j = 0; j < 8; ++j) s += f[j] * f[j];
                skv += s; }
        }
        sq = wave_sum(sq); skv = wave_sum(skv);
        if (l == 0) { rsq[tok] = rsqrtf(sq * (1.0f / 384.0f) + RMS_EPS); rskv[tok] = rsqrtf(skv * (1.0f / 256.0f) + RMS_EPS); }
        if (l < 16) {
            const float invf = powf(10000.0f, -(float)l * (1.0f / 16.0f));
            const float ang = (float)pos[tok] * invf;
            float sn, c; sincosf(ang, &sn, &c);
            cs[(size_t)tok * 32 + l] = c; cs[(size_t)tok * 32 + 16 + l] = sn;
            const float x1 = bf1(zrow[640 + l]), x2 = bf1(zrow[656 + l]);
            kpe[(size_t)tok * 32 + l] = (bf16_t)f2bf(x1 * c - x2 * sn);
            kpe[(size_t)tok * 32 + 16 + l] = (bf16_t)f2bf(x2 * c + x1 * sn);
        }
        const bool first = (tok % SEQ) == 0;
        const bf16_t* cur = zr + (size_t)tok * 1792; const bf16_t* prv = cur - 1792;
#pragma unroll
        for (int ps = 0; ps < 4; ++ps) {
            const int ch = ps * 64 + l;
            if (ch < 224) {
                const int c0 = ch * 8;
                float fc[8], fp[8], zs[8];
                unpack8(*(const u32x4*)(cur + c0), fc);
                if (first) {
#pragma unroll
                    for (int j = 0; j < 8; ++j) fp[j] = 0.f;
                } else unpack8(*(const u32x4*)(prv + c0), fp);
                const f32x4 m0 = *(const f32x4*)(mu + c0), m1 = *(const f32x4*)(mu + c0 + 4);
#pragma unroll
                for (int j = 0; j < 8; ++j) { const float m = j < 4 ? m0[j] : m1[j - 4]; zs[j] = fc[j] + (fp[j] - fc[j]) * m; }
                bf16_t* dst;
                if (c0 < 512) dst = rs + (size_t)tok * 512 + c0;
                else if (c0 < 1024) dst = ks + (size_t)tok * 512 + (c0 - 512);
                else if (c0 < 1536) dst = vs + (size_t)tok * 512 + (c0 - 1024);
                else {
                    dst = lin + (size_t)tok * 256 + (c0 - 1536);
                    if (c0 < 1600) {
#pragma unroll
                        for (int j = 0; j < 8; ++j) zs[j] = tanhf(zs[j]);
                    } else if (c0 >= 1664) {
#pragma unroll
                        for (int j = 0; j < 8; ++j) zs[j] = sigmoidf_(zs[j]);
                    }
                }
                *(u32x4*)dst = pack8(zs);
            }
        }
    }
}

__device__ void phase3(const Params& p, unsigned char* lds) {
    unsigned char* ws = lnd(p.ws); EPI_IDS
    const bf16_t* zm = (const bf16_t*)(ws + R_B);
    const bf16_t* lin = (const bf16_t*)(ws + R_A + 48 * MiB);
    const float* rsq = (const float*)(ws + OFF_RSQ); const float* rskv = (const float*)(ws + OFF_RSKV); const float* cs = (const float*)(ws + OFF_CS);
    bf16_t* qb = (bf16_t*)(ws + R_A); bf16_t* kn = (bf16_t*)(ws + R_E); bf16_t* vt = (bf16_t*)(ws + R_F);
    bf16_t* ks = (bf16_t*)(ws + R_D) + (size_t)T_TOK * 512;
    bf16_t* kk = (bf16_t*)(ws + R_C); bf16_t* bb = kk + (size_t)T_TOK * 512; bf16_t* om = bb + (size_t)T_TOK * 512;
    bf16_t* gg = (bf16_t*)(ws + R_H);
    constexpr int N_Q = 256 * 6, N_KN = 256 * 4, N_VT = 4 * 256, N_L = 256 * 4;
    constexpr int TOT = N_Q + N_KN + N_VT + 3 * N_L;
    for (int it = VB; it < TOT; it += VG) {
        f32x4 acc[4][4];
        if (it < N_Q) {
            const int rt = it / 6, ct = it % 6, m0 = rt * 128, n0 = ct * 128;
            gemm_core(zm + (size_t)m0 * 672, 672, (const bf16_t*)(ws + W_UQ) + (size_t)n0 * 384, 384, 384, acc, lds);
            const int G0 = (n0 + wc * 64) >> 4;
#pragma unroll
            for (int mi = 0; mi < 4; ++mi) {
                const int row = m0 + wr * 64 + mi * 16 + fr;
                const float sc = rsq[row] * QSCALE;
#pragma unroll
                for (int np = 0; np < 4; np += 2) {
                    const int r6 = (G0 + np) % 6;
                    f32x4 a = acc[mi][np] * sc, b = acc[mi][np + 1] * sc;
                    if (r6 == 4) {
                        const f32x4 c = *(const f32x4*)(cs + (size_t)row * 32 + fq * 4), s = *(const f32x4*)(cs + (size_t)row * 32 + 16 + fq * 4);
                        const f32x4 o1 = a * c - b * s, o2 = b * c + a * s; a = o1; b = o2;
                    }
                    const int col = n0 + wc * 64 + np * 16 + fq * 4;
                    u32x2 o; o.x = pk2(a[0], a[1]); o.y = pk2(a[2], a[3]); *(u32x2*)(qb + (size_t)row * 768 + col) = o;
                    o.x = pk2(b[0], b[1]); o.y = pk2(b[2], b[3]); *(u32x2*)(qb + (size_t)row * 768 + col + 16) = o;
                }
            }
        } else if (it < N_Q + N_KN) {
            const int i2 = it - N_Q, rt = i2 >> 2, ct = i2 & 3, m0 = rt * 128, n0 = ct * 128;
            gemm_core(zm + (size_t)m0 * 672 + 384, 672, (const bf16_t*)(ws + W_KN) + (size_t)n0 * 256, 256, 256, acc, lds);
#pragma unroll
            for (int mi = 0; mi < 4; ++mi) {
                const int row = m0 + wr * 64 + mi * 16 + fr; const float sc = rskv[row];
#pragma unroll
                for (int q = 0; q < 2; ++q) {
                    const int col = n0 + wc * 64 + q * 32 + fq * 8; const f32x4 a = acc[mi][2 * q] * sc, c = acc[mi][2 * q + 1] * sc;
                    u32x4 o; o.x = pk2(a[0], a[1]); o.y = pk2(a[2], a[3]); o.z = pk2(c[0], c[1]); o.w = pk2(c[2], c[3]);
                    *(u32x4*)(kn + (size_t)row * 512 + col) = o;
                }
            }
        } else if (it < N_Q + N_KN + N_VT) {
            const int i2 = it - N_Q - N_KN, rt = i2 & 3, ct = i2 >> 2, m0 = rt * 128, n0 = ct * 128;
            gemm_core((const bf16_t*)(ws + W_V) + (size_t)m0 * 256, 256, zm + (size_t)n0 * 672 + 384, 672, 256, acc, lds);
#pragma unroll
            for (int ni = 0; ni < 4; ++ni) {
                const int col = n0 + wc * 64 + ni * 16 + fq * 4; const f32x4 sc = *(const f32x4*)(rskv + col);
#pragma unroll
                for (int mi = 0; mi < 4; ++mi) {
                    const int row = m0 + wr * 64 + mi * 16 + fr; const f32x4 a = acc[mi][ni] * sc;
                    u32x2 o; o.x = pk2(a[0], a[1]); o.y = pk2(a[2], a[3]); *(u32x2*)(vt + (size_t)row * T_TOK + col) = o;
                }
            }
        } else {
            const int i2 = it - N_Q - N_KN - N_VT, which = i2 / N_L, i3 = i2 % N_L, rt = i3 >> 2, ct = i3 & 3, m0 = rt * 128, n0 = ct * 128;
            if (which == 0) {
                gemm_core(lin + (size_t)m0 * 256, 256, (const bf16_t*)(ws + W_W2) + (size_t)n0 * 64, 64, 64, acc, lds);
                const float* w0 = IN(11);
#pragma unroll
                for (int q = 0; q < 2; ++q) {
                    const int col = n0 + wc * 64 + q * 32 + fq * 8; const f32x4 w0a = *(const f32x4*)(w0 + col), w0b = *(const f32x4*)(w0 + col + 4);
#pragma unroll
                    for (int mi = 0; mi < 4; ++mi) {
                        const int row = m0 + wr * 64 + mi * 16 + fr; float o8[8];
#pragma unroll
                        for (int r = 0; r < 8; ++r) {
                            const float x = (r < 4 ? w0a[r & 3] : w0b[r & 3]) + (r < 4 ? acc[mi][2 * q][r & 3] : acc[mi][2 * q + 1][r & 3]);
                            const float e = 0.60653065971f * sigmoidf_(x);
                            o8[r] = e * (1.0f - e * (0.5f - e * (0.16666667f - e * (0.041666667f - e * (0.0083333333f - e * (0.0013888889f - e * 0.0001984127f))))));
                        }
                        *(u32x4*)(om + (size_t)row * 512 + col) = pack8(o8);
                    }
                }
            } else if (which == 1) {
                gemm_core(lin + (size_t)m0 * 256 + 64, 256, (const bf16_t*)(ws + W_A2) + (size_t)n0 * 64, 64, 64, acc, lds);
                const float* a0 = IN(13); const float* k_k = IN(16); const float* k_a = IN(17);
#pragma unroll
                for (int mi = 0; mi < 4; ++mi) {
                    const int row = m0 + wr * 64 + mi * 16 + fr;
                    float ksv[2][8], kkr[2][8], al[2][8]; float ss = 0.f;
#pragma unroll
                    for (int q = 0; q < 2; ++q) {
                        const int col = n0 + wc * 64 + q * 32 + fq * 8;
                        unpack8(*(const u32x4*)(ks + (size_t)row * 512 + col), ksv[q]);
                        const f32x4 a0a = *(const f32x4*)(a0 + col), a0b = *(const f32x4*)(a0 + col + 4), kka = *(const f32x4*)(k_k + col), kkb = *(const f32x4*)(k_k + col + 4);
#pragma unroll
                        for (int r = 0; r < 8; ++r) {
                            const float av = r < 4 ? acc[mi][2 * q][r & 3] : acc[mi][2 * q + 1][r & 3];
                            al[q][r] = sigmoidf_((r < 4 ? a0a[r & 3] : a0b[r & 3]) + av);
                            kkr[q][r] = ksv[q][r] * (r < 4 ? kka[r & 3] : kkb[r & 3]); ss += kkr[q][r] * kkr[q][r];
                        }
                    }
                    ss += __shfl_xor(ss, 16); ss += __shfl_xor(ss, 32);
                    const float inv = 1.0f / fmaxf(sqrtf(ss), 1e-12f);
#pragma unroll
                    for (int q = 0; q < 2; ++q) {
                        const int col = n0 + wc * 64 + q * 32 + fq * 8;
                        const f32x4 kaa = *(const f32x4*)(k_a + col), kab = *(const f32x4*)(k_a + col + 4);
                        float k1[8], b1[8], kp[8];
#pragma unroll
                        for (int r = 0; r < 8; ++r) { k1[r] = kkr[q][r] * inv; b1[r] = k1[r] * al[q][r]; kp[r] = ksv[q][r] * (1.0f + (al[q][r] - 1.0f) * (r < 4 ? kaa[r & 3] : kab[r & 3])); }
                        *(u32x4*)(kk + (size_t)row * 512 + col) = pack8(k1);
                        *(u32x4*)(bb + (size_t)row * 512 + col) = pack8(b1);
                        *(u32x4*)(ks + (size_t)row * 512 + col) = pack8(kp);
                    }
                }
            } else {
                gemm_core(lin + (size_t)m0 * 256 + 128, 256, (const bf16_t*)(ws + W_G2) + (size_t)n0 * 128, 128, 128, acc, lds);
#pragma unroll
                for (int mi = 0; mi < 4; ++mi) {
                    const int row = m0 + wr * 64 + mi * 16 + fr;
#pragma unroll
                    for (int q = 0; q < 2; ++q) {
                        const int col = n0 + wc * 64 + q * 32 + fq * 8; const f32x4 a = acc[mi][2 * q], c = acc[mi][2 * q + 1];
                        u32x4 o; o.x = pk2(a[0], a[1]); o.y = pk2(a[2], a[3]); o.z = pk2(c[0], c[1]); o.w = pk2(c[2], c[3]);
                        *(u32x4*)(gg + (size_t)row * 512 + col) = o;
                    }
                }
            }
        }
    }
}

struct HalfBar { unsigned addr; unsigned target; };
__device__ __forceinline__ void hb_sync(HalfBar& hb) {
    asm volatile("s_waitcnt lgkmcnt(0)" ::: "memory");
    hb.target += 4u;
    const int lane = threadIdx.x & 63;
    if (lane == 0) asm volatile("ds_add_u32 %0, %1" :: "v"(hb.addr), "v"(1u) : "memory");
    for (;;) {
        unsigned v;
        asm volatile("ds_read_b32 %0, %1\n\ts_waitcnt lgkmcnt(0)" : "=v"(v) : "v"(hb.addr) : "memory");
        if ((int)(__builtin_amdgcn_readfirstlane(v) - hb.target) >= 0) break;
        __builtin_amdgcn_s_sleep(1);
    }
    asm volatile("" ::: "memory");
}
#define SCAN_BAR() do { asm volatile("s_waitcnt lgkmcnt(0)" ::: "memory"); __builtin_amdgcn_s_barrier(); asm volatile("" ::: "memory"); } while (0)
constexpr int SCAN_CH = 32;
constexpr int SCAN_NBAR = 2 + (SEQ / SCAN_CH);
__device__ void scan_consumer(const Params& p, int si, unsigned char* lds) {
    unsigned char* ws = lnd(p.ws);
    const int chain = si >> 2, rg = si & 3, b = chain >> 3, h = chain & 7;
    const int tid = tidx(), w = tid >> 6, l = tid & 63, rowA = w * 4 + (l >> 4), kg = l & 15;
    const bf16_t* rs = (const bf16_t*)(ws + R_D); const bf16_t* ks = rs + (size_t)T_TOK * 512; const bf16_t* vs = ks + (size_t)T_TOK * 512;
    const bf16_t* kk = (const bf16_t*)(ws + R_C); const bf16_t* bb = kk + (size_t)T_TOK * 512; const bf16_t* om = bb + (size_t)T_TOK * 512;
    bf16_t* yo = (bf16_t*)(ws + R_I);
    float* ops = (float*)lds;
    float* vb = (float*)(lds + 81920);
    float* yb = (float*)(lds + 86016);
    const size_t tokb = (size_t)b * SEQ;
    const int lrem = tid & 127, lstep = lrem >> 3, lpart = lrem & 7, lhalf = tid >> 7;
    const bf16_t* sp0 = (lhalf ? om : kk) + (tokb + lstep) * 512 + h * 64 + lpart * 8;
    const bf16_t* sp1 = (lhalf ? ks : bb) + (tokb + lstep) * 512 + h * 64 + lpart * 8;
    const bf16_t* sp2 = rs + (tokb + lstep) * 512 + h * 64 + lpart * 8;
    const bf16_t* spv = vs + (tokb + ((tid & 31) >> 1)) * 512 + h * 64 + rg * 16 + (tid & 1) * 8;
    const int ldst0 = lstep * 320 + lhalf * 64 + lpart * 8, ldst1 = lstep * 320 + (2 + lhalf) * 64 + lpart * 8, ldst2 = lstep * 320 + 256 + lpart * 8;
    (void)sp0; (void)sp1; (void)sp2; (void)spv; (void)ldst0; (void)ldst1; (void)ldst2;
    constexpr int NCH = SEQ / SCAN_CH;
    const unsigned lds_ops = (unsigned)(size_t)(LAS unsigned char*)lds, lds_vb = lds_ops + 81920u, lds_yb = lds_ops + 86016u;
#define SC_RD(KK, DD, NB, K_, RR, VV, PA, PV, ST) do { \
        asm volatile("ds_read_b128 %0, %1 offset:%2" : "=v"(KK) : "v"(PA), "i"((ST) * 1280) : "memory"); \
        asm volatile("ds_read_b128 %0, %1 offset:%2" : "=v"(DD) : "v"(PA), "i"((ST) * 1280 + 256) : "memory"); \
        asm volatile("ds_read_b128 %0, %1 offset:%2" : "=v"(NB) : "v"(PA), "i"((ST) * 1280 + 512) : "memory"); \
        asm volatile("ds_read_b128 %0, %1 offset:%2" : "=v"(K_) : "v"(PA), "i"((ST) * 1280 + 768) : "memory"); \
        asm volatile("ds_read_b128 %0, %1 offset:%2" : "=v"(RR) : "v"(PA), "i"((ST) * 1280 + 1024) : "memory"); \
        asm volatile("ds_read_b32 %0, %1 offset:%2" : "=v"(VV) : "v"(PV), "i"((ST) * 64) : "memory"); } while (0)
#define SC_WAIT(N, KK, DD, NB, K_, RR, VV) asm volatile("s_waitcnt lgkmcnt(" #N ")" : "+v"(KK), "+v"(DD), "+v"(NB), "+v"(K_), "+v"(RR), "+v"(VV) :: "memory")
    typedef float f32x2 __attribute__((ext_vector_type(2)));
    f32x2 S01 = {0.f, 0.f}, S23 = {0.f, 0.f};
#define SC_STEP(ST, CKK, CD, CNB, CK, CR, CV, NKK, ND, NNB, NK, NR, NV, WN) do { \
        f32x2 u_ = {0.f, 0.f}; \
        if ((ST) > 0) { u_ = S01 * NR.xy; u_ = S23 * NR.zw + u_; } \
        if ((ST) < 31) SC_RD(NKK, ND, NNB, NK, NR, NV, pa, pv, (ST) + 1); \
        SC_WAIT(WN, CKK, CD, CNB, CK, CR, CV); \
        f32x2 t_ = S01 * CKK.xy; t_ = S23 * CKK.zw + t_; \
        float sa_ = t_.x + t_.y; \
        const f32x2 W01_ = S01 * CD.xy + CK.xy * CV, W23_ = S23 * CD.zw + CK.zw * CV; \
        float y_ = u_.x + u_.y; \
        sa_ += dppf<0x128>(sa_); sa_ += dppf<0x124>(sa_); \
        if ((ST) > 0) y_ += dppf<0x128>(y_); \
        sa_ += dppf<0x122>(sa_); sa_ += dppf<0x121>(sa_); \
        S01 = CNB.xy * sa_ + W01_; S23 = CNB.zw * sa_ + W23_; \
        if ((ST) > 0) asm volatile("ds_write_b32 %0, %1 offset:%2" :: "v"(pw), "v"(y_), "i"(((ST) > 0 ? (ST) - 1 : 0) * 512) : "memory"); } while (0)
    SCAN_BAR();
    SCAN_BAR();
    for (int c = 0; c < NCH; ++c) {
        const int buf = c & 1;
        const unsigned pa = lds_ops + (unsigned)(buf * 40960 + kg * 16), pv = lds_vb + (unsigned)(buf * 2048 + rowA * 4);
        const unsigned pw = lds_yb + (unsigned)(buf * 16384 + (rowA * 8 + (kg & 7)) * 4);
        f32x4 akk, ad, anb, ak, ar, bkk, bd, bnb, bk, br; float av, bv;
        SC_RD(akk, ad, anb, ak, ar, av, pa, pv, 0);
        SC_STEP(0, akk, ad, anb, ak, ar, av, bkk, bd, bnb, bk, br, bv, 6);
        SC_STEP(1, bkk, bd, bnb, bk, br, bv, akk, ad, anb, ak, ar, av, 6);
        SC_STEP(2, akk, ad, anb, ak, ar, av, bkk, bd, bnb, bk, br, bv, 7);
        SC_STEP(3, bkk, bd, bnb, bk, br, bv, akk, ad, anb, ak, ar, av, 7);
        SC_STEP(4, akk, ad, anb, ak, ar, av, bkk, bd, bnb, bk, br, bv, 7);
        SC_STEP(5, bkk, bd, bnb, bk, br, bv, akk, ad, anb, ak, ar, av, 7);
        SC_STEP(6, akk, ad, anb, ak, ar, av, bkk, bd, bnb, bk, br, bv, 7);
        SC_STEP(7, bkk, bd, bnb, bk, br, bv, akk, ad, anb, ak, ar, av, 7);
        SC_STEP(8, akk, ad, anb, ak, ar, av, bkk, bd, bnb, bk, br, bv, 7);
        SC_STEP(9, bkk, bd, bnb, bk, br, bv, akk, ad, anb, ak, ar, av, 7);
        SC_STEP(10, akk, ad, anb, ak, ar, av, bkk, bd, bnb, bk, br, bv, 7);
        SC_STEP(11, bkk, bd, bnb, bk, br, bv, akk, ad, anb, ak, ar, av, 7);
        SC_STEP(12, akk, ad, anb, ak, ar, av, bkk, bd, bnb, bk, br, bv, 7);
        SC_STEP(13, bkk, bd, bnb, bk, br, bv, akk, ad, anb, ak, ar, av, 7);
        SC_STEP(14, akk, ad, anb, ak, ar, av, bkk, bd, bnb, bk, br, bv, 7);
        SC_STEP(15, bkk, bd, bnb, bk, br, bv, akk, ad, anb, ak, ar, av, 7);
        SC_STEP(16, akk, ad, anb, ak, ar, av, bkk, bd, bnb, bk, br, bv, 7);
        SC_STEP(17, bkk, bd, bnb, bk, br, bv, akk, ad, anb, ak, ar, av, 7);
        SC_STEP(18, akk, ad, anb, ak, ar, av, bkk, bd, bnb, bk, br, bv, 7);
        SC_STEP(19, bkk, bd, bnb, bk, br, bv, akk, ad, anb, ak, ar, av, 7);
        SC_STEP(20, akk, ad, anb, ak, ar, av, bkk, bd, bnb, bk, br, bv, 7);
        SC_STEP(21, bkk, bd, bnb, bk, br, bv, akk, ad, anb, ak, ar, av, 7);
        SC_STEP(22, akk, ad, anb, ak, ar, av, bkk, bd, bnb, bk, br, bv, 7);
        SC_STEP(23, bkk, bd, bnb, bk, br, bv, akk, ad, anb, ak, ar, av, 7);
        SC_STEP(24, akk, ad, anb, ak, ar, av, bkk, bd, bnb, bk, br, bv, 7);
        SC_STEP(25, bkk, bd, bnb, bk, br, bv, akk, ad, anb, ak, ar, av, 7);
        SC_STEP(26, akk, ad, anb, ak, ar, av, bkk, bd, bnb, bk, br, bv, 7);
        SC_STEP(27, bkk, bd, bnb, bk, br, bv, akk, ad, anb, ak, ar, av, 7);
        SC_STEP(28, akk, ad, anb, ak, ar, av, bkk, bd, bnb, bk, br, bv, 7);
        SC_STEP(29, bkk, bd, bnb, bk, br, bv, akk, ad, anb, ak, ar, av, 7);
        SC_STEP(30, akk, ad, anb, ak, ar, av, bkk, bd, bnb, bk, br, bv, 7);
        SC_STEP(31, bkk, bd, bnb, bk, br, bv, akk, ad, anb, ak, ar, av, 1);
        {
            f32x2 u_ = S01 * br.xy; u_ = S23 * br.zw + u_;
            float y_ = u_.x + u_.y; y_ += dppf<0x128>(y_);
            asm volatile("ds_write_b32 %0, %1 offset:%2" :: "v"(pw), "v"(y_), "i"(31 * 512) : "memory");
        }
        asm volatile("s_waitcnt lgkmcnt(0)" ::: "memory");
        SCAN_BAR();
#pragma unroll
        for (int hh = 0; hh < 2; ++hh) {
            const int st = (tid >> 4) + 16 * hh, r = tid & 15;
            const float* yr = yb + buf * 4096 + st * 128 + r * 8;
            const f32x4 a0 = *(const f32x4*)(yr), a1 = *(const f32x4*)(yr + 4);
            const f32x4 sm = a0 + a1;
            const float y = (sm[0] + sm[1]) + (sm[2] + sm[3]);
            const unsigned short yv = (unsigned short)f2bf(y);
            const bf16_t* ya = yo + (tokb + (size_t)c * SCAN_CH + st) * 512 + h * 64 + rg * 16 + r;
            asm volatile("global_store_short %0, %1, off" :: "v"(ya), "v"((unsigned)yv) : "memory");
        }
    }
    asm volatile("s_waitcnt vmcnt(0)" ::: "memory");
}
__device__ void scan_producer(const Params& p, int si, unsigned char* lds) {
    unsigned char* ws = lnd(p.ws);
    const int chain = si >> 2, rg = si & 3, b = chain >> 3, h = chain & 7;
    const int tid = tidx(), w = tid >> 6, l = tid & 63, rowA = w * 4 + (l >> 4), kg = l & 15;
    const bf16_t* rs = (const bf16_t*)(ws + R_D); const bf16_t* ks = rs + (size_t)T_TOK * 512; const bf16_t* vs = ks + (size_t)T_TOK * 512;
    const bf16_t* kk = (const bf16_t*)(ws + R_C); const bf16_t* bb = kk + (size_t)T_TOK * 512; const bf16_t* om = bb + (size_t)T_TOK * 512;
    bf16_t* yo = (bf16_t*)(ws + R_I);
    float* ops = (float*)lds;
    float* vb = (float*)(lds + 81920);
    float* yb = (float*)(lds + 86016);
    const size_t tokb = (size_t)b * SEQ;
    const int lrem = tid & 127, lstep = lrem >> 3, lpart = lrem & 7, lhalf = tid >> 7;
    const bf16_t* sp0 = (lhalf ? om : kk) + (tokb + lstep) * 512 + h * 64 + lpart * 8;
    const bf16_t* sp1 = (lhalf ? ks : bb) + (tokb + lstep) * 512 + h * 64 + lpart * 8;
    const bf16_t* sp2 = rs + (tokb + lstep) * 512 + h * 64 + lpart * 8;
    const bf16_t* spv = vs + (tokb + ((tid & 31) >> 1)) * 512 + h * 64 + rg * 16 + (tid & 1) * 8;
    const int ldst0 = lstep * 320 + lhalf * 64 + lpart * 8, ldst1 = lstep * 320 + (2 + lhalf) * 64 + lpart * 8, ldst2 = lstep * 320 + 256 + lpart * 8;
    struct GSet { u32x4 g0, g1, g2, gv, h0, h1, h2, hv; };
    GSet RA, RB, RC;
    auto gload = [&](int c, GSet& R) {
        const size_t o = (size_t)c * SCAN_CH * 512 * 2, o2 = o + (size_t)16 * 512 * 2;
        const char* q0 = (const char*)sp0 + o; const char* q1 = (const char*)sp1 + o; const char* q2 = (const char*)sp2 + o; const char* q3 = (const char*)spv + o;
        const char* r0 = (const char*)sp0 + o2; const char* r1 = (const char*)sp1 + o2; const char* r2 = (const char*)sp2 + o2; const char* r3 = (const char*)spv + o2;
        asm volatile("global_load_dwordx4 %0, %1, off" : "=v"(R.g0) : "v"(q0) : "memory");
        asm volatile("global_load_dwordx4 %0, %1, off" : "=v"(R.g1) : "v"(q1) : "memory");
        asm volatile("global_load_dwordx4 %0, %1, off" : "=v"(R.g2) : "v"(q2) : "memory");
        asm volatile("global_load_dwordx4 %0, %1, off" : "=v"(R.gv) : "v"(q3) : "memory");
        asm volatile("global_load_dwordx4 %0, %1, off" : "=v"(R.h0) : "v"(r0) : "memory");
        asm volatile("global_load_dwordx4 %0, %1, off" : "=v"(R.h1) : "v"(r1) : "memory");
        asm volatile("global_load_dwordx4 %0, %1, off" : "=v"(R.h2) : "v"(r2) : "memory");
        asm volatile("global_load_dwordx4 %0, %1, off" : "=v"(R.hv) : "v"(r3) : "memory");
    };
    auto lstore1 = [&](int buf, int sub, const u32x4& x0, const u32x4& x1, const u32x4& x2, const u32x4& xv) {
        float f[8]; float* ob = ops + buf * 10240 + sub * 5120;
        unpack8(x0, f);
        if (lhalf) {
#pragma unroll
            for (int j = 0; j < 8; ++j) f[j] = 1.0f - f[j];
        }
        *(f32x4*)(ob + ldst0) = (f32x4){f[0], f[1], f[2], f[3]}; *(f32x4*)(ob + ldst0 + 4) = (f32x4){f[4], f[5], f[6], f[7]};
        unpack8(x1, f);
        if (!lhalf) {
#pragma unroll
            for (int j = 0; j < 8; ++j) f[j] = -f[j];
        }
        *(f32x4*)(ob + ldst1) = (f32x4){f[0], f[1], f[2], f[3]}; *(f32x4*)(ob + ldst1 + 4) = (f32x4){f[4], f[5], f[6], f[7]};
        if (tid < 128) { unpack8(x2, f); *(f32x4*)(ob + ldst2) = (f32x4){f[0], f[1], f[2], f[3]}; *(f32x4*)(ob + ldst2 + 4) = (f32x4){f[4], f[5], f[6], f[7]}; }
        if (tid < 32) { unpack8(xv, f); float* vd = vb + buf * 512 + sub * 256 + (tid >> 1) * 16 + (tid & 1) * 8;
            *(f32x4*)(vd) = (f32x4){f[0], f[1], f[2], f[3]}; *(f32x4*)(vd + 4) = (f32x4){f[4], f[5], f[6], f[7]}; }
    };
    auto lstore = [&](int buf, const GSet& R) { lstore1(buf, 0, R.g0, R.g1, R.g2, R.gv); lstore1(buf, 1, R.h0, R.h1, R.h2, R.hv); };
#define SC_VWAIT(N, R) asm volatile("s_waitcnt vmcnt(" #N ")" : "+v"(R.g0), "+v"(R.g1), "+v"(R.g2), "+v"(R.gv), "+v"(R.h0), "+v"(R.h1), "+v"(R.h2), "+v"(R.hv) :: "memory")
    constexpr int NCH = SEQ / SCAN_CH;
    (void)yo; (void)yb; (void)rowA; (void)kg;
    asm volatile("s_waitcnt vmcnt(0)" ::: "memory");
    SCAN_BAR();
    gload(0, RA); SC_VWAIT(0, RA); lstore(0, RA);
    gload(1, RB); gload(2, RC); gload(3, RA);
    SCAN_BAR();
    auto do_chunk = [&](int c, GSet& NX) {
        const int buf = c & 1;
        if (c + 1 < NCH) { SC_VWAIT(16, NX); lstore(buf ^ 1, NX); }
        SCAN_BAR();
        gload(c + 4 < NCH ? c + 4 : NCH - 1, NX);
    };
    for (int c = 0; c < NCH; c += 3) {
        do_chunk(c, RB);
        if (c + 1 < NCH) do_chunk(c + 1, RC);
        if (c + 2 < NCH) do_chunk(c + 2, RA);
    }
    asm volatile("s_waitcnt vmcnt(0)" ::: "memory");
}

__device__ __forceinline__ int pe_sw(int row) { return (0x78 >> (2 * ((row >> 2) & 3))) & 3; }
__device__ void attn_unit(const Params& p, int b, int h, int qblk, unsigned char* lds) {
    unsigned char* ws = lnd(p.ws);
    const bf16_t* Q = (const bf16_t*)(ws + R_A); const bf16_t* KN = (const bf16_t*)(ws + R_E); const bf16_t* VT = (const bf16_t*)(ws + R_F);
    const bf16_t* KP = (const bf16_t*)(ws + R_G); bf16_t* O = (bf16_t*)(ws + R_B);
    const int tid = tidx(), w = tid >> 6, l = tid & 63, fr = l & 15, g = l >> 4;
    const size_t tokb = (size_t)b * SEQ;
    const int q0 = qblk * 128 + w * 32;
    constexpr int BUFB = 21504, KP_OFF = 8192, VT_OFF = 12288;
    bf16x8 qf[2][3];
#pragma unroll
    for (int qi = 0; qi < 2; ++qi)
#pragma unroll
        for (int s = 0; s < 3; ++s) qf[qi][s] = *(const bf16x8*)(Q + (tokb + q0 + qi * 16 + fr) * 768 + h * 96 + s * 32 + g * 8);
    f32x4 o[4][2];
#pragma unroll
    for (int i = 0; i < 4; ++i) { o[i][0] = (f32x4){0.f, 0.f, 0.f, 0.f}; o[i][1] = (f32x4){0.f, 0.f, 0.f, 0.f}; }
    float mrun[2] = {-1e30f, -1e30f}, lsum[2] = {0.f, 0.f};
    const int ntiles = 2 * qblk + 2;
    const int kkey = tid >> 3, kkc = tid & 7;
    const int pkey = tid >> 2, pkc = tid & 3;
    const bf16_t* gkn = KN + (tokb + kkey) * 512 + h * 64 + kkc * 8;
    const bf16_t* gkp = KP + (tokb + pkey) * 32 + pkc * 8;
    const bf16_t* gvt = VT + ((size_t)h * 64 + kkey) * T_TOK + tokb + kkc * 8;
    const unsigned dkn = (unsigned)(kkey * 128 + ((kkc ^ (kkey & 7)) * 16));
    const unsigned dkp = (unsigned)(KP_OFF + pkey * 64 + ((pkc ^ pe_sw(pkey)) * 16));
    const unsigned dvt = (unsigned)(VT_OFF + kkey * 144 + kkc * 16);
    struct KVSet { u32x4 rk0, rk1, rp, rv0, rv1; };
    KVSet SA, SB;
    auto gload = [&](int kt, KVSet& R) {
        R.rk0 = *(const u32x4*)(gkn + (size_t)kt * 64 * 512); R.rk1 = *(const u32x4*)(gkn + ((size_t)kt * 64 + 32) * 512);
        R.rp = *(const u32x4*)(gkp + (size_t)kt * 64 * 32);
        R.rv0 = *(const u32x4*)(gvt + kt * 64); R.rv1 = *(const u32x4*)(gvt + (size_t)32 * T_TOK + kt * 64);
    };
    auto lstore = [&](int buf, const KVSet& R) {
        unsigned char* d = lds + buf * BUFB;
        *(u32x4*)(d + dkn) = R.rk0; *(u32x4*)(d + dkn + 32 * 128) = R.rk1; *(u32x4*)(d + dkp) = R.rp;
        *(u32x4*)(d + dvt) = R.rv0; *(u32x4*)(d + dvt + 32 * 144) = R.rv1;
    };
    const unsigned kfo0 = (unsigned)(fr * 128 + (((0 + g) ^ (fr & 7)) * 16)), kfo1 = (unsigned)(fr * 128 + (((4 + g) ^ (fr & 7)) * 16));
    const unsigned kfo2 = (unsigned)(KP_OFF + fr * 64 + ((g ^ pe_sw(fr)) * 16));
    const unsigned vfo = (unsigned)(VT_OFF + fr * 144 + g * 8);
    __syncthreads();
    gload(0, SA); lstore(0, SA);
    gload(1, SB);
    __syncthreads();
    auto tile_body = [&](int kt, const KVSet& NXT, KVSet& FREE) {
        const unsigned char* d = lds + (kt & 1) * BUFB;
        if (kt + 2 < ntiles) gload(kt + 2, FREE);
        f32x4 s_[4][2];
#pragma unroll
        for (int j = 0; j < 4; ++j) {
            const bf16x8 k0 = *(const bf16x8*)(d + kfo0 + j * 2048), k1 = *(const bf16x8*)(d + kfo1 + j * 2048), k2 = *(const bf16x8*)(d + kfo2 + j * 1024);
#pragma unroll
            for (int qi = 0; qi < 2; ++qi) {
                f32x4 a = {0.f, 0.f, 0.f, 0.f};
                a = __builtin_amdgcn_mfma_f32_16x16x32_bf16(k0, qf[qi][0], a, 0, 0, 0);
                a = __builtin_amdgcn_mfma_f32_16x16x32_bf16(k1, qf[qi][1], a, 0, 0, 0);
                a = __builtin_amdgcn_mfma_f32_16x16x32_bf16(k2, qf[qi][2], a, 0, 0, 0);
                s_[j][qi] = a;
            }
        }
        if (kt * 64 + 63 > q0) {
#pragma unroll
            for (int j = 0; j < 4; ++j)
#pragma unroll
                for (int qi = 0; qi < 2; ++qi)
#pragma unroll
                    for (int r = 0; r < 4; ++r) { const int key = kt * 64 + j * 16 + g * 4 + r, q = q0 + qi * 16 + fr; if (key > q) s_[j][qi][r] = -1e30f; }
        }
        bf16x8 pf[2][2];
#pragma unroll
        for (int qi = 0; qi < 2; ++qi) {
            float mx = -1e30f;
#pragma unroll
            for (int j = 0; j < 4; ++j) mx = fmaxf(mx, fmaxf(fmaxf(s_[j][qi][0], s_[j][qi][1]), fmaxf(s_[j][qi][2], s_[j][qi][3])));
            mx = fmaxf(mx, __shfl_xor(mx, 16)); mx = fmaxf(mx, __shfl_xor(mx, 32));
            const float mn = fmaxf(mrun[qi], mx);
            const float alpha = __builtin_amdgcn_exp2f(mrun[qi] - mn);
            mrun[qi] = mn;
            float psum = 0.f;
#pragma unroll
            for (int j = 0; j < 4; ++j)
#pragma unroll
                for (int r = 0; r < 4; ++r) { const float pv = __builtin_amdgcn_exp2f(s_[j][qi][r] - mn); s_[j][qi][r] = pv; psum += pv; }
            lsum[qi] = lsum[qi] * alpha + psum;
#pragma unroll
            for (int dt = 0; dt < 4; ++dt) o[dt][qi] = o[dt][qi] * alpha;
#pragma unroll
            for (int ksx = 0; ksx < 2; ++ksx) {
                u32x4 pw; pw.x = pk2(s_[2 * ksx][qi][0], s_[2 * ksx][qi][1]); pw.y = pk2(s_[2 * ksx][qi][2], s_[2 * ksx][qi][3]);
                pw.z = pk2(s_[2 * ksx + 1][qi][0], s_[2 * ksx + 1][qi][1]); pw.w = pk2(s_[2 * ksx + 1][qi][2], s_[2 * ksx + 1][qi][3]);
                pf[ksx][qi] = __builtin_bit_cast(bf16x8, pw);
            }
        }
#pragma unroll
        for (int ksx = 0; ksx < 2; ++ksx)
#pragma unroll
            for (int dt = 0; dt < 4; ++dt) {
                const u32x2 v0 = *(const u32x2*)(d + vfo + dt * 16 * 144 + ksx * 64), v1 = *(const u32x2*)(d + vfo + dt * 16 * 144 + ksx * 64 + 32);
                u32x4 vw; vw.x = v0.x; vw.y = v0.y; vw.z = v1.x; vw.w = v1.y;
                const bf16x8 vf = __builtin_bit_cast(bf16x8, vw);
                o[dt][0] = __builtin_amdgcn_mfma_f32_16x16x32_bf16(vf, pf[ksx][0], o[dt][0], 0, 0, 0);
                o[dt][1] = __builtin_amdgcn_mfma_f32_16x16x32_bf16(vf, pf[ksx][1], o[dt][1], 0, 0, 0);
            }
        if (kt + 1 < ntiles) lstore((kt + 1) & 1, NXT);
        __syncthreads();
    };
    for (int kt = 0; kt < ntiles; kt += 2) { tile_body(kt, SB, SA); tile_body(kt + 1, SA, SB); }
#pragma unroll
    for (int qi = 0; qi < 2; ++qi) {
        float lt = lsum[qi]; lt += __shfl_xor(lt, 16); lt += __shfl_xor(lt, 32);
        const float inv = 1.0f / lt;
        const size_t tok = tokb + q0 + qi * 16 + fr;
#pragma unroll
        for (int dt = 0; dt < 4; ++dt) {
            const f32x4 v = o[dt][qi] * inv;
            u32x2 ow; ow.x = pk2(v[0], v[1]); ow.y = pk2(v[2], v[3]);
            *(u32x2*)(O + tok * 512 + h * 64 + dt * 16 + g * 4) = ow;
        }
    }
}

__device__ void phase4(const Params& p, unsigned char* lds, int* s_item, int rep) {
    if (VHALF == 0) {
        for (int si = blockIdx.x; si < 128; si += gridDim.x) {
            __builtin_amdgcn_s_setprio(3);
            scan_consumer(p, si, lds);
            __builtin_amdgcn_s_setprio(0);
        }
    } else {
        for (int si = blockIdx.x; si < 128; si += gridDim.x) scan_producer(p, si, lds - 65536);
    }
    unsigned* queue = (unsigned*)(p.ws + OFF_QUEUE) + 512 * rep;
    const int myx = (int)(xb_xcc_id() & 7u);
    for (;;) {
        __syncthreads();
        if (threadIdx.x == 0) {
            int code = -1;
            for (int k = 0; k < 8; ++k) {
                const int xx = (myx + k) & 7;
                const unsigned it = atomicAdd(queue + xx * 16, 2u);
                if (it < 256u) { code = xx * 256 + (int)it; break; }
            }
            s_item[0] = code;
        }
        __syncthreads();
        const int code = s_item[0];
        if (code < 0) break;
        const int h = code >> 8, it = (code & 255) + VHALF;
        const int qblk = 63 - (it >> 2), b = it & 3;
        attn_unit(p, b, h, qblk, lds);
    }
}

__device__ void phase5(const Params& p) {
    unsigned char* ws = lnd(p.ws);
    const bf16_t* rs = (const bf16_t*)(ws + R_D); const bf16_t* ks = rs + (size_t)T_TOK * 512; const bf16_t* vs = ks + (size_t)T_TOK * 512;
    const bf16_t* yv = (const bf16_t*)(ws + R_I); const bf16_t* gg = (const bf16_t*)(ws + R_H);
    bf16_t* ybp = (bf16_t*)(ws + R_C);
    const float* lnw = IN(19); const float* lnb = IN(20); const float* rk = IN(18);
    const int l = tidx() & 63, gw = VB * 4 + (tidx() >> 6), nw = VG * 4;
    const int c0 = l * 8;
    float wv[8], bv[8], rkv[8];
    { const f32x4 a = *(const f32x4*)(lnw + c0), b = *(const f32x4*)(lnw + c0 + 4), c = *(const f32x4*)(lnb + c0), d = *(const f32x4*)(lnb + c0 + 4), e = *(const f32x4*)(rk + c0), f = *(const f32x4*)(rk + c0 + 4);
#pragma unroll
      for (int j = 0; j < 4; ++j) { wv[j] = a[j]; wv[j + 4] = b[j]; bv[j] = c[j]; bv[j + 4] = d[j]; rkv[j] = e[j]; rkv[j + 4] = f[j]; } }
    for (int tok = gw; tok < T_TOK; tok += nw) {
        const size_t off = (size_t)tok * 512 + c0;
        float y[8], r[8], k[8], v[8], g[8];
        unpack8(*(const u32x4*)(yv + off), y); unpack8(*(const u32x4*)(rs + off), r); unpack8(*(const u32x4*)(ks + off), k);
        unpack8(*(const u32x4*)(vs + off), v); unpack8(*(const u32x4*)(gg + off), g);
        float s = 0.f, bs = 0.f;
#pragma unroll
        for (int j = 0; j < 8; ++j) { s += y[j]; bs += r[j] * k[j] * rkv[j]; }
        s += __shfl_xor(s, 1); s += __shfl_xor(s, 2); s += __shfl_xor(s, 4);
        bs += __shfl_xor(bs, 1); bs += __shfl_xor(bs, 2); bs += __shfl_xor(bs, 4);
        const float mean = s * (1.0f / 64.0f);
        float q = 0.f;
#pragma unroll
        for (int j = 0; j < 8; ++j) { const float d = y[j] - mean; q += d * d; }
        q += __shfl_xor(q, 1); q += __shfl_xor(q, 2); q += __shfl_xor(q, 4);
        const float rstd = rsqrtf(q * (1.0f / 64.0f) + 64e-5f);
        float o[8];
#pragma unroll
        for (int j = 0; j < 8; ++j) o[j] = ((y[j] - mean) * rstd * wv[j] + bv[j] + bs * v[j]) * g[j];
        *(u32x4*)(ybp + off) = pack8(o);
    }
    rmsnorm_rows_bf16(IN(0), IN(3), (bf16_t*)(ws + R_A));
}

__device__ void phase6(const Params& p, unsigned char* lds8) {
    unsigned char* ws = lnd(p.ws); EPI8_IDS
    const bf16_t* h = (const bf16_t*)(ws + R_A); const bf16_t* ob = (const bf16_t*)(ws + R_B); const bf16_t* ybp = (const bf16_t*)(ws + R_C);
    const bf16_t* Wg = (const bf16_t*)(ws + W_IN) + (size_t)2464 * 1024;
    bf16_t* mo = (bf16_t*)(ws + R_D);
    bf16_t* gsc = (bf16_t*)(ws + R_C + 32 * MiB);
    for (int iter = 0, rt, ct; tile_map8(iter, 128, 4, rt, ct); ++iter) {
        const int m0 = rt * 256, n0 = ct * 256;
        const int row0 = m0 + wr * 128 + fr, col0 = n0 + wc * 64 + fq * 8;
        f32x4 acc[8][4];
#pragma unroll 1
        for (int pass = 0; pass < 2; ++pass) {
            gemm8(h + (size_t)m0 * 1024, 1024, Wg + (size_t)(pass * 1024 + n0) * 1024, 1024, 1024, acc, lds8);
#pragma unroll
            for (int mi = 0; mi < 8; ++mi) {
#pragma unroll
                for (int q = 0; q < 2; ++q) {
                    float v[8];
#pragma unroll
                    for (int r = 0; r < 4; ++r) { v[r] = sigmoidf_(acc[mi][2 * q][r]); v[4 + r] = sigmoidf_(acc[mi][2 * q + 1][r]); }
                    *(u32x4*)(gsc + (size_t)(row0 + mi * 16) * 1024 + col0 + q * 32) = pack8(v);
                }
            }
            if (pass == 0) gemm8(ob + (size_t)m0 * 512, 512, (const bf16_t*)(ws + W_OA) + (size_t)n0 * 512, 512, 512, acc, lds8);
            else gemm8(ybp + (size_t)m0 * 512, 512, (const bf16_t*)(ws + W_OB) + (size_t)n0 * 512, 512, 512, acc, lds8);
            {
                u32x4 gn[2], pn[2];
#pragma unroll
                for (int q = 0; q < 2; ++q) { gn[q] = *(const u32x4*)(gsc + (size_t)row0 * 1024 + col0 + q * 32); pn[q] = pass ? *(const u32x4*)(mo + (size_t)row0 * 1024 + col0 + q * 32) : (u32x4){0u, 0u, 0u, 0u}; }
#pragma unroll
                for (int mi = 0; mi < 8; ++mi) {
                    const int row = row0 + mi * 16;
                    u32x4 gc[2], pc[2];
#pragma unroll
                    for (int q = 0; q < 2; ++q) { gc[q] = gn[q]; pc[q] = pn[q]; }
                    if (mi < 7) {
#pragma unroll
                        for (int q = 0; q < 2; ++q) { gn[q] = *(const u32x4*)(gsc + (size_t)(row + 16) * 1024 + col0 + q * 32); pn[q] = pass ? *(const u32x4*)(mo + (size_t)(row + 16) * 1024 + col0 + q * 32) : (u32x4){0u, 0u, 0u, 0u}; }
                    }
#pragma unroll
                    for (int q = 0; q < 2; ++q) {
                        float g[8], pv[8], v[8];
                        unpack8(gc[q], g); unpack8(pc[q], pv);
#pragma unroll
                        for (int r = 0; r < 4; ++r) { v[r] = g[r] * acc[mi][2 * q][r] + pv[r]; v[4 + r] = g[4 + r] * acc[mi][2 * q + 1][r] + pv[4 + r]; }
                        *(u32x4*)(mo + (size_t)row * 1024 + col0 + q * 32) = pack8(v);
                    }
                }
            }
        }
    }
}

__device__ __forceinline__ void epi_residual8(const f32x4 (&acc)[8][4], int m0, int n0, const float* xin, float* xo, bf16_t* xb, float* ssq, const float* ss_in) {
    EPI8_IDS
    const int row0 = m0 + wr * 128 + fr, col0 = n0 + wc * 64 + fq * 8;
    f32x4 xn[4]; float sn = 0.f;
#pragma unroll
    for (int q = 0; q < 2; ++q) { xn[2 * q] = *(const f32x4*)(xin + (size_t)row0 * DM + col0 + q * 32); xn[2 * q + 1] = *(const f32x4*)(xin + (size_t)row0 * DM + col0 + q * 32 + 4); }
    if (ss_in) sn = ss_in[row0];
#pragma unroll
    for (int mi = 0; mi < 8; ++mi) {
        const int row = row0 + mi * 16;
        f32x4 xc[4]; const float sc_in = sn;
#pragma unroll
        for (int i = 0; i < 4; ++i) xc[i] = xn[i];
        if (mi < 7) {
#pragma unroll
            for (int q = 0; q < 2; ++q) { xn[2 * q] = *(const f32x4*)(xin + (size_t)(row + 16) * DM + col0 + q * 32); xn[2 * q + 1] = *(const f32x4*)(xin + (size_t)(row + 16) * DM + col0 + q * 32 + 4); }
            if (ss_in) sn = ss_in[row + 16];
        }
        float sc = 1.0f;
        if (ss_in) { const float r = rsqrtf(sc_in * (1.0f / DM) + RMS_EPS); sc = r * r; }
        float ss = 0.f;
#pragma unroll
        for (int q = 0; q < 2; ++q) {
            const int col = col0 + q * 32;
            const f32x4 v0 = xc[2 * q] + acc[mi][2 * q] * sc, v1 = xc[2 * q + 1] + acc[mi][2 * q + 1] * sc;
            *(f32x4*)(xo + (size_t)row * DM + col) = v0; *(f32x4*)(xo + (size_t)row * DM + col + 4) = v1;
            u32x4 o; o.x = pk2(v0[0], v0[1]); o.y = pk2(v0[2], v0[3]); o.z = pk2(v1[0], v1[1]); o.w = pk2(v1[2], v1[3]);
            *(u32x4*)(xb + (size_t)row * DM + col) = o;
            ss += (v0[0] * v0[0] + v0[1] * v0[1] + v0[2] * v0[2] + v0[3] * v0[3]) + (v1[0] * v1[0] + v1[1] * v1[1] + v1[2] * v1[2] + v1[3] * v1[3]);
        }
        ss += __shfl_xor(ss, 16); ss += __shfl_xor(ss, 32);
        if (fq == 0) atomicAdd(ssq + row, ss);
    }
}

__device__ void phase7(const Params& p, unsigned char* lds8) {
    unsigned char* ws = lnd(p.ws);
    const bf16_t* mo = (const bf16_t*)(ws + R_D);
    for (int iter = 0, rt, ct; tile_map8(iter, 128, 4, rt, ct); ++iter) {
        const int m0 = rt * 256, n0 = ct * 256;
        f32x4 acc[8][4];
        gemm8(mo + (size_t)m0 * 1024, 1024, (const bf16_t*)(ws + W_OUT) + (size_t)n0 * 1024, 1024, 1024, acc, lds8);
        epi_residual8(acc, m0, n0, IN(0), lnd(p.out), (bf16_t*)(ws + R_A), (float*)(ws + OFF_SS1), nullptr);
    }
}
__device__ void phase8(const Params& p, unsigned char* lds8) {
    unsigned char* ws = lnd(p.ws); EPI8_IDS
    const bf16_t* xb = (const bf16_t*)(ws + R_A); bf16_t* u = (bf16_t*)(ws + R_U);
    for (int iter = 0, rt, ct; tile_map8(iter, 128, 16, rt, ct); ++iter) {
        const int m0 = rt * 256, n0 = ct * 256;
        f32x4 acc[8][4];
        gemm8(xb + (size_t)m0 * 1024, 1024, (const bf16_t*)(ws + W_UP) + (size_t)n0 * 1024, 1024, 1024, acc, lds8);
#pragma unroll
        for (int mi = 0; mi < 8; ++mi) {
            const int row = m0 + wr * 128 + mi * 16 + fr;
#pragma unroll
            for (int q = 0; q < 2; ++q) {
                const int col = n0 + wc * 64 + q * 32 + fq * 8;
                float v[8];
#pragma unroll
                for (int r = 0; r < 4; ++r) { const float a = fmaxf(acc[mi][2 * q][r], 0.f), c = fmaxf(acc[mi][2 * q + 1][r], 0.f); v[r] = a * a; v[4 + r] = c * c; }
                *(u32x4*)(u + (size_t)row * 4096 + col) = pack8(v);
            }
        }
    }
}
__device__ void phase9(const Params& p, unsigned char* lds8) {
    unsigned char* ws = lnd(p.ws);
    const bf16_t* u = (const bf16_t*)(ws + R_U);
    for (int iter = 0, rt, ct; tile_map8(iter, 128, 4, rt, ct); ++iter) {
        const int m0 = rt * 256, n0 = ct * 256;
        f32x4 acc[8][4];
        gemm8(u + (size_t)m0 * 4096, 4096, (const bf16_t*)(ws + W_DN) + (size_t)n0 * 4096, 4096, 4096, acc, lds8);
        epi_residual8(acc, m0, n0, lnd(p.out), lnd(p.out), (bf16_t*)(ws + R_A), (float*)(ws + OFF_SS2), (const float*)(ws + OFF_SS1));
    }
}
__device__ void phase10(const Params& p, unsigned char* lds8) {
    unsigned char* ws = lnd(p.ws); EPI8_IDS
    const bf16_t* xb = (const bf16_t*)(ws + R_A); const bf16_t* pb = (const bf16_t*)(ws + R_PB);
    const float* ss2 = (const float*)(ws + OFF_SS2);
    float* xo = lnd(p.out);
    bf16_t* ppb = (bf16_t*)(ws + R_B);
    for (int iter = 0, rt, ct; tile_map8(iter, 128, 4, rt, ct); ++iter) {
        const int m0 = rt * 256, n0 = ct * 256;
        const int row0 = m0 + wr * 128 + fr, col0 = n0 + wc * 64 + fq * 8;
        f32x4 acc[8][4];
        gemm8(pb + (size_t)m0 * 256, 256, (const bf16_t*)(ws + W_PP) + (size_t)n0 * 256, 256, 256, acc, lds8);
#pragma unroll
        for (int mi = 0; mi < 8; ++mi) {
#pragma unroll
            for (int q = 0; q < 2; ++q) {
                u32x4 o; o.x = pk2(acc[mi][2 * q][0], acc[mi][2 * q][1]); o.y = pk2(acc[mi][2 * q][2], acc[mi][2 * q][3]);
                o.z = pk2(acc[mi][2 * q + 1][0], acc[mi][2 * q + 1][1]); o.w = pk2(acc[mi][2 * q + 1][2], acc[mi][2 * q + 1][3]);
                *(u32x4*)(ppb + (size_t)(row0 + mi * 16) * 1024 + col0 + q * 32) = o;
            }
        }
        gemm8(xb + (size_t)m0 * 1024, 1024, (const bf16_t*)(ws + W_PG) + (size_t)n0 * 1024, 1024, 1024, acc, lds8);
        {
            f32x4 xn[4]; u32x4 pn[2]; float sn;
#pragma unroll
            for (int q = 0; q < 2; ++q) { xn[2 * q] = *(const f32x4*)(xo + (size_t)row0 * DM + col0 + q * 32); xn[2 * q + 1] = *(const f32x4*)(xo + (size_t)row0 * DM + col0 + q * 32 + 4);
                                          pn[q] = *(const u32x4*)(ppb + (size_t)row0 * 1024 + col0 + q * 32); }
            sn = ss2[row0];
#pragma unroll
            for (int mi = 0; mi < 8; ++mi) {
                const int row = row0 + mi * 16;
                f32x4 xc[4]; u32x4 pc[2]; const float rstd = rsqrtf(sn * (1.0f / DM) + RMS_EPS);
#pragma unroll
                for (int i = 0; i < 4; ++i) xc[i] = xn[i];
                pc[0] = pn[0]; pc[1] = pn[1];
                if (mi < 7) {
#pragma unroll
                    for (int q = 0; q < 2; ++q) { xn[2 * q] = *(const f32x4*)(xo + (size_t)(row + 16) * DM + col0 + q * 32); xn[2 * q + 1] = *(const f32x4*)(xo + (size_t)(row + 16) * DM + col0 + q * 32 + 4);
                                                  pn[q] = *(const u32x4*)(ppb + (size_t)(row + 16) * 1024 + col0 + q * 32); }
                    sn = ss2[row + 16];
                }
#pragma unroll
                for (int q = 0; q < 2; ++q) {
                    float pf[8]; unpack8(pc[q], pf);
                    f32x4 v0 = xc[2 * q], v1 = xc[2 * q + 1];
#pragma unroll
                    for (int r = 0; r < 4; ++r) { v0[r] += sigmoidf_(acc[mi][2 * q][r] * rstd) * pf[r]; v1[r] += sigmoidf_(acc[mi][2 * q + 1][r] * rstd) * pf[4 + r]; }
                    *(f32x4*)(xo + (size_t)row * DM + col0 + q * 32) = v0; *(f32x4*)(xo + (size_t)row * DM + col0 + q * 32 + 4) = v1;
                }
            }
        }
    }
}
__device__ void phase11(const Params& p) {
    float* x = lnd(p.out); const float* g = IN(29);
    const int l = tidx() & 63, gw = VB * 4 + (tidx() >> 6), nw = VG * 4;
    for (int row = gw; row < T_TOK; row += 2 * nw) {
        const int row2 = row + nw; const bool has2 = row2 < T_TOK;
        float* xr = x + (size_t)row * DM; float* xr2 = x + (size_t)(has2 ? row2 : row) * DM;
        f32x4 v[4], w[4]; float ss = 0.f, ss2 = 0.f;
#pragma unroll
        for (int i = 0; i < 4; ++i) { v[i] = *(const f32x4*)(xr + i * 256 + l * 4); w[i] = *(const f32x4*)(xr2 + i * 256 + l * 4); }
#pragma unroll
        for (int i = 0; i < 4; ++i) { ss += v[i][0] * v[i][0] + v[i][1] * v[i][1] + v[i][2] * v[i][2] + v[i][3] * v[i][3]; ss2 += w[i][0] * w[i][0] + w[i][1] * w[i][1] + w[i][2] * w[i][2] + w[i][3] * w[i][3]; }
        ss = wave_sum(ss); ss2 = wave_sum(ss2);
        const float rs = rsqrtf(ss * (1.0f / DM) + RMS_EPS), rs2 = rsqrtf(ss2 * (1.0f / DM) + RMS_EPS);
#pragma unroll
        for (int i = 0; i < 4; ++i) {
            const f32x4 gg = *(const f32x4*)(g + i * 256 + l * 4);
            *(f32x4*)(xr + i * 256 + l * 4) = v[i] * rs * gg;
            if (has2) *(f32x4*)(xr2 + i * 256 + l * 4) = w[i] * rs2 * gg;
        }
    }
}

extern __shared__ __attribute__((aligned(16))) unsigned char dyn_lds[];
constexpr int DYN_LDS = 131072;
__global__ void __launch_bounds__(512, 2) mega(Params p) {
    unsigned char* lds = dyn_lds + VHALF * 65536;
    __shared__ uint4 xbw;
    __shared__ int s_item[2];
    const bool single = (p.ph_hi - p.ph_lo) > 1;
    if (threadIdx.x == 0) xbw = make_uint4(0u, 0u, 0u, 0u);
    __syncthreads();
    XcdBarrier xb; xb.bar = (unsigned*)(p.ws + OFF_BAR); xb.x = 0; xb.st = (volatile LAS unsigned*)&xbw;
    if (single) xb = xcd_barrier_post((unsigned*)(p.ws + OFF_BAR), (volatile LAS unsigned*)&xbw);
    if (p.ph_lo < 0) cg::this_grid().sync();
#ifndef PROBE_MASK
#define PROBE_MASK 0
#endif
#ifndef PROBE_DUP
#define PROBE_DUP -1
#endif
    for (int ph = p.ph_lo; ph < p.ph_hi; ++ph)
    for (int rep = 0; rep < ((ph == PROBE_DUP || ((PROBE_MASK >> ph) & 1)) ? 2 : 1); ++rep) {
#ifndef ONLY_PH
#define ONLY_PH -1
#endif
#ifndef SKIP_PH
#define SKIP_PH -1
#endif
#define RUNPH(k, call) if ((ONLY_PH < 0 || ONLY_PH == k) && SKIP_PH != k && ph == k) { call; }
        RUNPH(0, phase0(p)) RUNPH(1, phase1(p, dyn_lds)) RUNPH(2, phase2(p)) RUNPH(3, phase3(p, lds)) RUNPH(4, phase4(p, lds, s_item, rep)) RUNPH(5, phase5(p))
        RUNPH(6, phase6(p, dyn_lds)) RUNPH(7, phase7(p, dyn_lds)) RUNPH(8, phase8(p, dyn_lds)) RUNPH(9, phase9(p, dyn_lds)) RUNPH(10, phase10(p, dyn_lds)) RUNPH(11, phase11(p))
        if (ph + 1 < p.ph_hi || rep == 0) xcd_barrier(xb);
    }
}

extern "C" void kernel_launch(void* const* d_in, const int* in_sizes, int n_in, void* d_out, int out_size, void* d_ws, size_t ws_size, hipStream_t stream) {
    static int grid_blocks = 0;
    if (!grid_blocks) {
        int dev = 0, cus = 0, per_cu = 0;
        hipGetDevice(&dev);
        hipDeviceGetAttribute(&cus, hipDeviceAttributeMultiprocessorCount, dev);
        hipFuncSetAttribute((const void*)mega, hipFuncAttributeMaxDynamicSharedMemorySize, DYN_LDS);
        hipOccupancyMaxActiveBlocksPerMultiprocessor(&per_cu, mega, 512, DYN_LDS);
        if (per_cu > 1) per_cu = 1;
        if (per_cu < 1) per_cu = 1;
        grid_blocks = cus * per_cu;
    }
    if (ws_size < WS_NEED) { fprintf(stderr, "workspace too small: %zu < %zu\n", ws_size, (size_t)WS_NEED); return; }
    Params p{};
    for (int i = 0; i < 30; ++i) p.in[i] = (const float*)d_in[i];
    p.out = (float*)d_out; p.ws = (unsigned char*)d_ws;
    hipMemsetAsync(d_ws, 0, ZERO_BYTES, stream);
#if MK_MULTI
    for (int ph = 0; ph < NPH; ++ph) { p.ph_lo = ph; p.ph_hi = ph + 1; hipLaunchKernelGGL(mega, dim3(grid_blocks), dim3(512), DYN_LDS, stream, p); }
#else
    p.ph_lo = 0; p.ph_hi = NPH;
    void* args[] = {&p};
    hipError_t e = hipLaunchCooperativeKernel((void*)mega, dim3(grid_blocks), dim3(512), args, DYN_LDS, stream);
    if (e != hipSuccess) fprintf(stderr, "cooperative launch failed: %s (grid %d)\n", hipGetErrorString(e), grid_blocks);
#endif
}
```

```cpp
#include <hip/hip_runtime.h>
#include <hip/hip_cooperative_groups.h>
#include <stdint.h>
#include <stdio.h>
namespace cg = cooperative_groups;

#ifndef MK_MULTI
#define MK_MULTI 0
#endif

typedef unsigned short bf16_t;
typedef short bf16x8 __attribute__((ext_vector_type(8)));
typedef float f32x4 __attribute__((ext_vector_type(4)));
typedef unsigned u32x4 __attribute__((ext_vector_type(4)));
typedef unsigned u32x2 __attribute__((ext_vector_type(2)));
#define LAS __attribute__((address_space(3)))

constexpr int T_TOK = 32768, SEQ = 8192, DM = 1024;
constexpr int NPH = 12;
constexpr float RMS_EPS = 1e-6f;
constexpr float QSCALE = 0.10206207261596577f * 1.4426950408889634f;

constexpr size_t MiB = 1ull << 20;
constexpr size_t OFF_BAR = 0, OFF_QUEUE = 16384, ZERO_BYTES = 32768;
constexpr size_t OFF_SS1 = 65536, OFF_SS2 = OFF_SS1 + 131072, OFF_RSQ = OFF_SS2 + 131072, OFF_RSKV = OFF_RSQ + 131072;
constexpr size_t OFF_CS = 1 * MiB;
constexpr size_t OFF_W = 5 * MiB;
constexpr size_t W_IN = OFF_W;
constexpr size_t W_UQ = W_IN + 4608ull * 1024 * 2;
constexpr size_t W_KN = W_UQ + 768ull * 384 * 2;
constexpr size_t W_V = W_KN + 512ull * 256 * 2;
constexpr size_t W_OA = W_V + 512ull * 256 * 2;
constexpr size_t W_W2 = W_OA + 1024ull * 512 * 2;
constexpr size_t W_A2 = W_W2 + 512ull * 64 * 2;
constexpr size_t W_G2 = W_A2 + 512ull * 64 * 2;
constexpr size_t W_OB = W_G2 + 512ull * 128 * 2;
constexpr size_t W_OUT = W_OB + 1024ull * 512 * 2;
constexpr size_t W_UP = W_OUT + 1024ull * 1024 * 2;
constexpr size_t W_DN = W_UP + 4096ull * 1024 * 2;
constexpr size_t W_PG = W_DN + 4096ull * 1024 * 2;
constexpr size_t W_PP = W_PG + 1024ull * 1024 * 2;
constexpr size_t W_END = W_PP + 1024ull * 256 * 2;
static_assert(W_END <= 42 * MiB, "weights region");
constexpr size_t R_A = 42 * MiB;
constexpr size_t R_B = 106 * MiB;
constexpr size_t R_C = 148 * MiB;
constexpr size_t R_D = 260 * MiB;
constexpr size_t R_E = 356 * MiB;
constexpr size_t R_F = 388 * MiB;
constexpr size_t R_G = 420 * MiB;
constexpr size_t R_H = 422 * MiB;
constexpr size_t R_I = 454 * MiB;
constexpr size_t R_PB = 486 * MiB;
constexpr size_t WS_NEED = 502 * MiB;
constexpr size_t R_U = R_B;

struct Params {
    const float* in[30];
    float* out;
    unsigned char* ws;
    int ph_lo, ph_hi;
};

#define GAS __attribute__((address_space(1)))
template <class T> __device__ __forceinline__ T* lnd(T* q) { GAS T* g = (GAS T*)q; asm volatile("" : "+s"(g)); return (T*)g; }
#define IN(k) lnd(p.in[k])
#define VHALF ((int)__builtin_amdgcn_readfirstlane((int)(threadIdx.x >> 8)))
#define VB ((int)blockIdx.x * 2 + VHALF)
#define VG ((int)gridDim.x * 2)
__device__ __forceinline__ int tidx512() { int t = threadIdx.x; asm volatile("" : "+v"(t)); return t; }
__device__ __forceinline__ int tidx() { int t = threadIdx.x & 255; asm volatile("" : "+v"(t)); return t; }
__device__ __forceinline__ unsigned f2bf(float f) { unsigned u = __float_as_uint(f); return (u + 0x7fffu + ((u >> 16) & 1u)) >> 16; }
typedef float f32x2_t __attribute__((ext_vector_type(2)));
typedef __bf16 bf16x2_t __attribute__((ext_vector_type(2)));
__device__ __forceinline__ unsigned pk2(float lo, float hi) { f32x2_t v = {lo, hi}; bf16x2_t b = __builtin_convertvector(v, bf16x2_t); return __builtin_bit_cast(unsigned, b); }
__device__ __forceinline__ float bflo(unsigned w) { return __uint_as_float(w << 16); }
__device__ __forceinline__ float bfhi(unsigned w) { return __uint_as_float(w & 0xffff0000u); }
__device__ __forceinline__ float bf1(bf16_t v) { return __uint_as_float((unsigned)v << 16); }
__device__ __forceinline__ void unpack8(const u32x4 w, float (&f)[8]) {
    f[0] = bflo(w.x); f[1] = bfhi(w.x); f[2] = bflo(w.y); f[3] = bfhi(w.y); f[4] = bflo(w.z); f[5] = bfhi(w.z); f[6] = bflo(w.w); f[7] = bfhi(w.w);
}
__device__ __forceinline__ u32x4 pack8(const float (&f)[8]) { u32x4 w; w.x = pk2(f[0], f[1]); w.y = pk2(f[2], f[3]); w.z = pk2(f[4], f[5]); w.w = pk2(f[6], f[7]); return w; }
__device__ __forceinline__ float sigmoidf_(float x) { return __builtin_amdgcn_rcpf(1.0f + __expf(-x)); }
__device__ __forceinline__ float wave_sum(float v) {
#pragma unroll
    for (int o = 32; o >= 1; o >>= 1) v += __shfl_xor(v, o);
    return v;
}
template <int CTRL> __device__ __forceinline__ float dppf(float v) {
    return __int_as_float(__builtin_amdgcn_update_dpp(0, __float_as_int(v), CTRL, 0xf, 0xf, false));
}
__device__ __forceinline__ float row16_sum(float v) {
    v += dppf<0x128>(v); v += dppf<0x124>(v); v += dppf<0x122>(v); v += dppf<0x121>(v); return v;
}

#define XB_TMO      128
#define XB_XCNT(j)  (256  + 64 * (j))
#define XB_XSUB(j)  (1280 + 64 * (j))
#define XB_XGEN(j)  (2304 + 64 * (j))
#define XB_TOP      3328
#define XB_TOPGEN   3392
#define XCD_BAR_WORDS 3456
#define XB_SPIN_CAP (1u << 22)
__device__ __forceinline__ unsigned xb_ld(unsigned* p) { return __hip_atomic_load(p, __ATOMIC_RELAXED, __HIP_MEMORY_SCOPE_AGENT); }
__device__ __forceinline__ unsigned xb_add(unsigned* p, unsigned v) { return __hip_atomic_fetch_add(p, v, __ATOMIC_RELAXED, __HIP_MEMORY_SCOPE_AGENT); }
__device__ __forceinline__ unsigned xb_xcc_id() { return (unsigned)__builtin_amdgcn_s_getreg((3 << 11) | 20) & 0xFu; }
#define XB_SPIN(cond, bar) do { unsigned _sp = 0; while (cond) { __builtin_amdgcn_s_sleep(1); \
    if ((++_sp & 255u) == 0u) { if (xb_ld(&(bar)[XB_TMO])) break; if (_sp > XB_SPIN_CAP) { atomicAdd(&(bar)[XB_TMO], 1u); break; } } } } while (0)
struct XcdBarrier { unsigned* bar; unsigned x; volatile LAS unsigned* st; };
__device__ __forceinline__ XcdBarrier xcd_barrier_post(unsigned* bar, volatile LAS unsigned* st) {
    XcdBarrier b; b.bar = bar; b.x = xb_xcc_id(); b.st = st;
    if (threadIdx.x == 0) (void)xb_add(&bar[XB_XCNT(b.x)], 1u);
    return b;
}
__device__ __forceinline__ void xcd_barrier_complete(unsigned* bar, unsigned x, unsigned& nloc, unsigned& nx) {
    const unsigned G = gridDim.x * gridDim.y * gridDim.z;
    unsigned sum, cnt, mine, sp = 0u;
    for (;;) {
        sum = 0u; cnt = 0u; mine = 0u;
#pragma unroll
        for (unsigned j = 0; j < 16; ++j) { const unsigned c = xb_ld(&bar[XB_XCNT(j)]); sum += c; cnt += (c > 0u) ? 1u : 0u; mine = (j == x) ? c : mine; }
        if (sum == G) break;
        __builtin_amdgcn_s_sleep(1);
        if ((++sp & 255u) == 0u) { if (xb_ld(&bar[XB_TMO])) break; if (sp > XB_SPIN_CAP) { atomicAdd(&bar[XB_TMO], 1u); break; } }
    }
    nloc = mine > 0u ? mine : 1u; nx = cnt > 0u ? cnt : 1u;
}
__device__ __forceinline__ void xcd_barrier(const XcdBarrier& b) {
    asm volatile("s_waitcnt vmcnt(0)" ::: "memory");
    __syncthreads();
    if (threadIdx.x == 0) {
        unsigned* bar = b.bar;
        __builtin_amdgcn_s_waitcnt(0);
        unsigned nloc = b.st[0], nx = b.st[1];
        if (nloc == 0u) { xcd_barrier_complete(bar, b.x, nloc, nx); b.st[0] = nloc; b.st[1] = nx; }
        const unsigned old = xb_add(&bar[XB_XSUB(b.x)], 1u);
        const unsigned gen = old / nloc;
        if (old + 1u == (gen + 1u) * nloc) {
            __builtin_amdgcn_fence(__ATOMIC_RELEASE, "agent");
            asm volatile("s_waitcnt vmcnt(0)" ::: "memory");
            const unsigned og = xb_add(&bar[XB_TOP], 1u);
            const unsigned tg = og / nx;
            if (og + 1u == (tg + 1u) * nx) xb_add(&bar[XB_TOPGEN], 1u);
            else XB_SPIN(xb_ld(&bar[XB_TOPGEN]) == tg, bar);
            __builtin_amdgcn_fence(__ATOMIC_ACQUIRE, "agent");
            xb_add(&bar[XB_XGEN(b.x)], 1u);
            asm volatile("s_waitcnt vmcnt(0)" ::: "memory");
        } else {
            XB_SPIN(xb_ld(&bar[XB_XGEN(b.x)]) == gen, bar);
            __builtin_amdgcn_fence(__ATOMIC_ACQUIRE, "agent");
            asm volatile("s_waitcnt vmcnt(0)" ::: "memory");
        }
    }
    __syncthreads();
}

__device__ __forceinline__ int sw64(int row) { return (0x78 >> (2 * ((row >> 2) & 3))) & 3; }
__device__ __forceinline__ void gemm_core(const bf16_t* A, int lda, const bf16_t* Bt, int ldb, int K, f32x4 (&acc)[4][4], unsigned char* lds) {
    const int tid = tidx(), l = tid & 63, w = __builtin_amdgcn_readfirstlane(tid >> 6), wr = w >> 1, wc = w & 1, fr = l & 15, fq = l >> 4;
#pragma unroll
    for (int i = 0; i < 4; ++i)
#pragma unroll
        for (int j = 0; j < 4; ++j) acc[i][j] = (f32x4){0.f, 0.f, 0.f, 0.f};
    const int nk = K >> 5;
    const int rin = l >> 2, skc = (l & 3) ^ sw64(rin);
    const bf16_t* ga = A + (size_t)(w * 32 + rin) * lda + skc * 8;
    const bf16_t* gb = Bt + (size_t)(w * 32 + rin) * ldb + skc * 8;
    LAS unsigned char* L = (LAS unsigned char*)lds + w * 2048;
    const unsigned aoff = (unsigned)((wr * 64 + fr) * 64 + ((fq ^ sw64(fr)) * 16)), boff = (unsigned)(8192 + (wc * 64 + fr) * 64 + ((fq ^ sw64(fr)) * 16));
#define GC_ISSUE(kt_) do { LAS unsigned char* Ld_ = L + ((kt_) & 3) * 16384; \
        __builtin_amdgcn_global_load_lds((const unsigned*)(ga + (kt_) * 32), (LAS unsigned*)(Ld_), 16, 0, 0); \
        __builtin_amdgcn_global_load_lds((const unsigned*)(ga + (size_t)16 * lda + (kt_) * 32), (LAS unsigned*)(Ld_ + 1024), 16, 0, 0); \
        __builtin_amdgcn_global_load_lds((const unsigned*)(gb + (kt_) * 32), (LAS unsigned*)(Ld_ + 8192), 16, 0, 0); \
        __builtin_amdgcn_global_load_lds((const unsigned*)(gb + (size_t)16 * ldb + (kt_) * 32), (LAS unsigned*)(Ld_ + 8192 + 1024), 16, 0, 0); } while (0)
    const unsigned lbase = (unsigned)(size_t)(LAS unsigned char*)lds;
    asm volatile("s_waitcnt vmcnt(0)" ::: "memory");
    __syncthreads();
    GC_ISSUE(0);
    if (nk > 1) GC_ISSUE(1);
    if (nk > 2) GC_ISSUE(2);
#define GC_RD(dst, addr, OFF) asm volatile("ds_read_b128 %0, %1 offset:" #OFF : "=v"(dst) : "v"(addr) : "memory")
    for (int kt = 0; kt < nk; ++kt) {
        if (kt + 2 < nk) asm volatile("s_waitcnt vmcnt(8)" ::: "memory");
        else if (kt + 1 < nk) asm volatile("s_waitcnt vmcnt(4)" ::: "memory");
        else asm volatile("s_waitcnt vmcnt(0)" ::: "memory");
        __builtin_amdgcn_s_barrier();
        asm volatile("" ::: "memory");
        if (kt + 3 < nk) GC_ISSUE(kt + 3);
        const unsigned sa = lbase + (unsigned)((kt & 3) * 16384) + aoff, sb = lbase + (unsigned)((kt & 3) * 16384) + boff;
        bf16x8 a0, a1, a2, a3, b0, b1, b2, b3;
        GC_RD(a0, sa, 0); GC_RD(b0, sb, 0); GC_RD(a1, sa, 1024); GC_RD(b1, sb, 1024);
        GC_RD(a2, sa, 2048); GC_RD(b2, sb, 2048); GC_RD(a3, sa, 3072); GC_RD(b3, sb, 3072);
#define GC_MMA(mi, ni, A_, B_) acc[mi][ni] = __builtin_amdgcn_mfma_f32_16x16x32_bf16(B_, A_, acc[mi][ni], 0, 0, 0)
        asm volatile("s_waitcnt lgkmcnt(4)" : "+v"(a0), "+v"(a1), "+v"(b0), "+v"(b1) :: "memory");
        GC_MMA(0, 0, a0, b0); GC_MMA(0, 1, a0, b1); GC_MMA(1, 0, a1, b0); GC_MMA(1, 1, a1, b1);
        asm volatile("s_waitcnt lgkmcnt(2)" : "+v"(a2), "+v"(b2) :: "memory");
        GC_MMA(0, 2, a0, b2); GC_MMA(1, 2, a1, b2); GC_MMA(2, 0, a2, b0); GC_MMA(2, 1, a2, b1); GC_MMA(2, 2, a2, b2);
        asm volatile("s_waitcnt lgkmcnt(0)" : "+v"(a3), "+v"(b3) :: "memory");
        GC_MMA(0, 3, a0, b3); GC_MMA(1, 3, a1, b3); GC_MMA(2, 3, a2, b3); GC_MMA(3, 0, a3, b0); GC_MMA(3, 1, a3, b1); GC_MMA(3, 2, a3, b2); GC_MMA(3, 3, a3, b3);
    }
    __syncthreads();
}
__device__ __forceinline__ bool tile_map(int iter, int MT, int NT, int& rt, int& ct) {
    const int G = gridDim.x;
    if ((G & 7) == 0 && (MT & 63) == 0) {
        const int x = blockIdx.x & 7, lb = (blockIdx.x >> 3) * 2 + VHALF, nlb = (G >> 3) * 2, MTx = MT >> 3;
        const int li = lb + iter * nlb;
        if (li >= MTx * NT) return false;
        const int per = 8 * NT, rg = li / per, r = li - rg * per;
        ct = r >> 3; rt = x * MTx + rg * 8 + (r & 7);
        return true;
    }
    const int it = VB + iter * VG;
    if (it >= MT * NT) return false;
    rt = it / NT; ct = it - rt * NT; return true;
}
__device__ __forceinline__ void gemm8(const bf16_t* A, int lda, const bf16_t* Bt, int ldb, int K, f32x4 (&acc)[8][4], unsigned char* lds) {
    const int tid = tidx512(), l = tid & 63, w = __builtin_amdgcn_readfirstlane(tid >> 6), wr = w >> 2, wc = w & 3, fr = l & 15, fq = l >> 4;
#pragma unroll
    for (int i = 0; i < 8; ++i)
#pragma unroll
        for (int j = 0; j < 4; ++j) acc[i][j] = (f32x4){0.f, 0.f, 0.f, 0.f};
    const int nk = K >> 6;
    const int rin = l >> 3, skc = (l & 7) ^ (rin & 7);
    const bf16_t* ga = A + (size_t)(w * 32 + rin) * lda + skc * 8;
    const bf16_t* gb = Bt + (size_t)(w * 32 + rin) * ldb + skc * 8;
    LAS unsigned char* L = (LAS unsigned char*)lds + w * 4096;
#define G8_ISSUE(kt_) do { LAS unsigned char* Ld_ = L + ((kt_) & 1) * 65536; \
        __builtin_amdgcn_global_load_lds((const unsigned*)(ga + (kt_) * 64), (LAS unsigned*)(Ld_), 16, 0, 0); \
        __builtin_amdgcn_global_load_lds((const unsigned*)(ga + (size_t)8 * lda + (kt_) * 64), (LAS unsigned*)(Ld_ + 1024), 16, 0, 0); \
        __builtin_amdgcn_global_load_lds((const unsigned*)(ga + (size_t)16 * lda + (kt_) * 64), (LAS unsigned*)(Ld_ + 2048), 16, 0, 0); \
        __builtin_amdgcn_global_load_lds((const unsigned*)(ga + (size_t)24 * lda + (kt_) * 64), (LAS unsigned*)(Ld_ + 3072), 16, 0, 0); \
        __builtin_amdgcn_global_load_lds((const unsigned*)(gb + (kt_) * 64), (LAS unsigned*)(Ld_ + 32768), 16, 0, 0); \
        __builtin_amdgcn_global_load_lds((const unsigned*)(gb + (size_t)8 * ldb + (kt_) * 64), (LAS unsigned*)(Ld_ + 32768 + 1024), 16, 0, 0); \
        __builtin_amdgcn_global_load_lds((const unsigned*)(gb + (size_t)16 * ldb + (kt_) * 64), (LAS unsigned*)(Ld_ + 32768 + 2048), 16, 0, 0); \
        __builtin_amdgcn_global_load_lds((const unsigned*)(gb + (size_t)24 * ldb + (kt_) * 64), (LAS unsigned*)(Ld_ + 32768 + 3072), 16, 0, 0); } while (0)
    const unsigned lbase = (unsigned)(size_t)(LAS unsigned char*)lds;
    const unsigned arow = (unsigned)((wr * 128 + fr) * 128), brow = (unsigned)(32768 + (wc * 64 + fr) * 128);
    const unsigned sw0 = (unsigned)(((0 + fq) ^ (fr & 7)) * 16), sw1 = (unsigned)(((4 + fq) ^ (fr & 7)) * 16);
    asm volatile("s_waitcnt vmcnt(0)" ::: "memory");
    __syncthreads();
    G8_ISSUE(0);
#define G8_MMA(mi, ni, A_, B_) acc[mi][ni] = __builtin_amdgcn_mfma_f32_16x16x32_bf16(B_, A_, acc[mi][ni], 0, 0, 0)
#define G8_HALF(sa, sb, F1, F2, F3, F4) do { \
        bf16x8 a0, a1, a2, a3, b0, b1, b2, b3, c0, c1, c2, c3; \
        GC_RD(b0, sb, 0); GC_RD(b1, sb, 2048); GC_RD(b2, sb, 4096); GC_RD(b3, sb, 6144); \
        GC_RD(a0, sa, 0); GC_RD(a1, sa, 2048); GC_RD(a2, sa, 4096); GC_RD(a3, sa, 6144); \
        asm volatile("s_waitcnt lgkmcnt(2)" : "+v"(b0), "+v"(b1), "+v"(b2), "+v"(b3), "+v"(a0), "+v"(a1) :: "memory"); \
        G8_MMA(0, 0, a0, b0); G8_MMA(0, 1, a0, b1); G8_MMA(0, 2, a0, b2); G8_MMA(0, 3, a0, b3); \
        G8_MMA(1, 0, a1, b0); G8_MMA(1, 1, a1, b1); G8_MMA(1, 2, a1, b2); G8_MMA(1, 3, a1, b3); \
        F1; \
        asm volatile("s_waitcnt lgkmcnt(0)" : "+v"(a2), "+v"(a3) :: "memory"); \
        G8_MMA(2, 0, a2, b0); G8_MMA(2, 1, a2, b1); G8_MMA(2, 2, a2, b2); G8_MMA(2, 3, a2, b3); \
        G8_MMA(3, 0, a3, b0); G8_MMA(3, 1, a3, b1); G8_MMA(3, 2, a3, b2); G8_MMA(3, 3, a3, b3); \
        GC_RD(c0, sa, 8192); GC_RD(c1, sa, 10240); GC_RD(c2, sa, 12288); GC_RD(c3, sa, 14336); \
        F2; \
        asm volatile("s_waitcnt lgkmcnt(2)" : "+v"(c0), "+v"(c1) :: "memory"); \
        G8_MMA(4, 0, c0, b0); G8_MMA(4, 1, c0, b1); G8_MMA(4, 2, c0, b2); G8_MMA(4, 3, c0, b3); \
        G8_MMA(5, 0, c1, b0); G8_MMA(5, 1, c1, b1); G8_MMA(5, 2, c1, b2); G8_MMA(5, 3, c1, b3); \
        F3; \
        asm volatile("s_waitcnt lgkmcnt(0)" : "+v"(c2), "+v"(c3) :: "memory"); \
        G8_MMA(6, 0, c2, b0); G8_MMA(6, 1, c2, b1); G8_MMA(6, 2, c2, b2); G8_MMA(6, 3, c2, b3); \
        G8_MMA(7, 0, c3, b0); G8_MMA(7, 1, c3, b1); G8_MMA(7, 2, c3, b2); G8_MMA(7, 3, c3, b3); \
        F4; } while (0)
#define G8_PA(kt_, j) __builtin_amdgcn_global_load_lds((const unsigned*)(ga + (size_t)(8 * (j)) * lda + (kt_) * 64), (LAS unsigned*)(L + ((kt_) & 1) * 65536 + 1024 * (j)), 16, 0, 0)
#define G8_PB(kt_, j) __builtin_amdgcn_global_load_lds((const unsigned*)(gb + (size_t)(8 * (j)) * ldb + (kt_) * 64), (LAS unsigned*)(L + ((kt_) & 1) * 65536 + 32768 + 1024 * (j)), 16, 0, 0)
    for (int kt = 0; kt < nk; ++kt) {
        asm volatile("s_waitcnt vmcnt(0)" ::: "memory");
        __builtin_amdgcn_s_barrier();
        asm volatile("" ::: "memory");
        const bool nxt = kt + 1 < nk;
        const unsigned slot = lbase + (unsigned)((kt & 1) * 65536);
        const unsigned sa0 = slot + arow + sw0, sb0 = slot + brow + sw0, sa1 = slot + arow + sw1, sb1 = slot + brow + sw1;
        __builtin_amdgcn_s_setprio(1);
        G8_HALF(sa0, sb0,
                if (nxt) { G8_PA(kt + 1, 0); G8_PB(kt + 1, 0); },
                if (nxt) { G8_PA(kt + 1, 1); G8_PB(kt + 1, 1); },
                if (nxt) { G8_PA(kt + 1, 2); G8_PB(kt + 1, 2); },
                if (nxt) { G8_PA(kt + 1, 3); G8_PB(kt + 1, 3); });
        G8_HALF(sa1, sb1, (void)0, (void)0, (void)0, (void)0);
        __builtin_amdgcn_s_setprio(0);
    }
    __syncthreads();
}
__device__ __forceinline__ bool tile_map8(int iter, int MT, int NT, int& rt, int& ct) {
    const int G = gridDim.x;
    if ((G & 7) == 0 && (MT & 63) == 0) {
        const int x = blockIdx.x & 7, lb = blockIdx.x >> 3, nlb = G >> 3, MTx = MT >> 3;
        const int li = lb + iter * nlb;
        if (li >= MTx * NT) return false;
        const int per = 4 * NT, rg = li / per, r = li - rg * per;
        ct = r >> 2; rt = x * MTx + rg * 4 + (r & 3);
        return true;
    }
    const int it = (int)blockIdx.x + iter * G;
    if (it >= MT * NT) return false;
    rt = it / NT; ct = it - rt * NT; return true;
}
#define EPI8_IDS const int tid_ = tidx512(), l_ = tid_ & 63, w_ = tid_ >> 6, wr = w_ >> 2, wc = w_ & 3, fr = l_ & 15, fq = l_ >> 4; (void)wr; (void)wc; (void)fr; (void)fq;
#define EPI_IDS const int tid_ = tidx(), l_ = tid_ & 63, w_ = tid_ >> 6, wr = w_ >> 1, wc = w_ & 1, fr = l_ & 15, fq = l_ >> 4; (void)wr; (void)wc; (void)fr; (void)fq;

__device__ void transpose_job(const float* __restrict__ W, int K, int ldw, int rows, int mode, int perm, const float* __restrict__ gs, bf16_t* __restrict__ Wt, int gtid, int gthreads) {
    const int nch = rows * (K >> 3), nnb = rows >> 3;
    for (int id = gtid; id < nch; id += gthreads) {
        const int tile = id >> 6, lane = id & 63;
        const int n = (tile % nnb) * 8 + (lane & 7), kc = (tile / nnb) * 8 + (lane >> 3);
        int nn = n;
        if (perm) { const int j = n & 31; nn = (n & ~31) + ((j >> 2) & 3) * 8 + (j >> 4) * 4 + (j & 3); }
        int col = nn;
        if (mode == 1) col = (nn >> 6) * 128 + (nn & 63); else if (mode == 2) col = (nn >> 6) * 128 + 64 + (nn & 63);
        float v[8];
#pragma unroll
        for (int j = 0; j < 8; ++j) { const int k = kc * 8 + j; float x = W[(size_t)k * ldw + col]; if (gs) x *= gs[k]; v[j] = x; }
        *(u32x4*)(Wt + (size_t)n * K + kc * 8) = pack8(v);
    }
}
__device__ void rmsnorm_rows_bf16(const float* __restrict__ x, const float* __restrict__ g, bf16_t* __restrict__ h) {
    const int l = tidx() & 63, gw = VB * 4 + (tidx() >> 6), nw = VG * 4;
    for (int row = gw; row < T_TOK; row += 2 * nw) {
        const int row2 = row + nw; const bool has2 = row2 < T_TOK;
        const float* xr = x + (size_t)row * DM; const float* xr2 = x + (size_t)(has2 ? row2 : row) * DM;
        f32x4 v[4], w[4]; float ss = 0.f, ss2 = 0.f;
#pragma unroll
        for (int i = 0; i < 4; ++i) { v[i] = *(const f32x4*)(xr + i * 256 + l * 4); w[i] = *(const f32x4*)(xr2 + i * 256 + l * 4); }
#pragma unroll
        for (int i = 0; i < 4; ++i) { ss += v[i][0] * v[i][0] + v[i][1] * v[i][1] + v[i][2] * v[i][2] + v[i][3] * v[i][3]; ss2 += w[i][0] * w[i][0] + w[i][1] * w[i][1] + w[i][2] * w[i][2] + w[i][3] * w[i][3]; }
        ss = wave_sum(ss); ss2 = wave_sum(ss2);
        const float rs = rsqrtf(ss * (1.0f / DM) + RMS_EPS), rs2 = rsqrtf(ss2 * (1.0f / DM) + RMS_EPS);
#pragma unroll
        for (int i = 0; i < 4; ++i) {
            const f32x4 gg = *(const f32x4*)(g + i * 256 + l * 4);
            u32x2 o; o.x = pk2(v[i][0] * rs * gg[0], v[i][1] * rs * gg[1]); o.y = pk2(v[i][2] * rs * gg[2], v[i][3] * rs * gg[3]);
            *(u32x2*)(h + (size_t)row * DM + i * 256 + l * 4) = o;
            if (has2) { u32x2 o2; o2.x = pk2(w[i][0] * rs2 * gg[0], w[i][1] * rs2 * gg[1]); o2.y = pk2(w[i][2] * rs2 * gg[2], w[i][3] * rs2 * gg[3]);
                        *(u32x2*)(h + (size_t)row2 * DM + i * 256 + l * 4) = o2; }
        }
    }
}

__device__ void phase0(const Params& p) {
    unsigned char* ws = lnd(p.ws);
    const int gtid = VB * 256 + tidx(), gth = VG * 256;
    transpose_job(IN(4), 1024, 4512, 4512, 0, 1, nullptr, (bf16_t*)(ws + W_IN), gtid, gth);
    transpose_job(IN(6), 384, 768, 768, 0, 0, IN(5), (bf16_t*)(ws + W_UQ), gtid, gth);
    transpose_job(IN(8), 256, 1024, 512, 1, 1, IN(7), (bf16_t*)(ws + W_KN), gtid, gth);
    transpose_job(IN(8), 256, 1024, 512, 2, 0, IN(7), (bf16_t*)(ws + W_V), gtid, gth);
    transpose_job(IN(9), 512, 1024, 1024, 0, 1, nullptr, (bf16_t*)(ws + W_OA), gtid, gth);
    transpose_job(IN(12), 64, 512, 512, 0, 1, nullptr, (bf16_t*)(ws + W_W2), gtid, gth);
    transpose_job(IN(14), 64, 512, 512, 0, 1, nullptr, (bf16_t*)(ws + W_A2), gtid, gth);
    transpose_job(IN(15), 128, 512, 512, 0, 1, nullptr, (bf16_t*)(ws + W_G2), gtid, gth);
    transpose_job(IN(21), 512, 1024, 1024, 0, 1, nullptr, (bf16_t*)(ws + W_OB), gtid, gth);
    transpose_job(IN(22), 1024, 1024, 1024, 0, 1, nullptr, (bf16_t*)(ws + W_OUT), gtid, gth);
    transpose_job(IN(24), 1024, 4096, 4096, 0, 1, IN(23), (bf16_t*)(ws + W_UP), gtid, gth);
    transpose_job(IN(25), 4096, 1024, 1024, 0, 1, nullptr, (bf16_t*)(ws + W_DN), gtid, gth);
    transpose_job(IN(27), 1024, 1024, 1024, 0, 1, IN(26), (bf16_t*)(ws + W_PG), gtid, gth);
    transpose_job(IN(28), 256, 1024, 1024, 0, 1, nullptr, (bf16_t*)(ws + W_PP), gtid, gth);
    {
        const float* pp = IN(1); bf16_t* pb = (bf16_t*)(ws + R_PB);
        for (int id = gtid; id < T_TOK * 256 / 8; id += gth) {
            const f32x4 a = *(const f32x4*)(pp + (size_t)id * 8), b = *(const f32x4*)(pp + (size_t)id * 8 + 4);
            u32x4 o; o.x = pk2(a[0], a[1]); o.y = pk2(a[2], a[3]); o.z = pk2(b[0], b[1]); o.w = pk2(b[2], b[3]);
            *(u32x4*)(pb + (size_t)id * 8) = o;
        }
    }
    { float* z = (float*)(ws + OFF_SS1); for (int id = gtid; id < 2 * T_TOK; id += gth) z[id] = 0.f; }
    rmsnorm_rows_bf16(IN(0), IN(3), (bf16_t*)(ws + R_A));
}

__device__ void phase1(const Params& p, unsigned char* lds8) {
    unsigned char* ws = lnd(p.ws); EPI8_IDS
    const bf16_t* h = (const bf16_t*)(ws + R_A); const bf16_t* Wt = (const bf16_t*)(ws + W_IN);
    bf16_t* zm = (bf16_t*)(ws + R_B); bf16_t* zr = (bf16_t*)(ws + R_C);
    for (int iter = 0, rt, ct; tile_map8(iter, 128, 10, rt, ct); ++iter) {
        const int m0 = rt * 256, n0 = ct * 256;
        f32x4 acc[8][4];
        gemm8(h + (size_t)m0 * 1024, 1024, Wt + (size_t)n0 * 1024, 1024, 1024, acc, lds8);
#pragma unroll
        for (int mi = 0; mi < 8; ++mi) {
            const int row = m0 + wr * 128 + mi * 16 + fr;
#pragma unroll
            for (int q = 0; q < 2; ++q) {
                const int col = n0 + wc * 64 + q * 32 + fq * 8;
                u32x4 o; o.x = pk2(acc[mi][2 * q][0], acc[mi][2 * q][1]); o.y = pk2(acc[mi][2 * q][2], acc[mi][2 * q][3]);
                o.z = pk2(acc[mi][2 * q + 1][0], acc[mi][2 * q + 1][1]); o.w = pk2(acc[mi][2 * q + 1][2], acc[mi][2 * q + 1][3]);
                if (col < 672) *(u32x4*)(zm + (size_t)row * 672 + col) = o;
                else if (col < 2464) *(u32x4*)(zr + (size_t)row * 1792 + (col - 672)) = o;
            }
        }
    }
}

__device__ void phase2(const Params& p) {
    unsigned char* ws = lnd(p.ws);
    const bf16_t* __restrict__ zm = (const bf16_t*)(ws + R_B); const bf16_t* __restrict__ zr = (const bf16_t*)(ws + R_C);
    float* __restrict__ rsq = (float*)(ws + OFF_RSQ); float* __restrict__ rskv = (float*)(ws + OFF_RSKV); float* __restrict__ cs = (float*)(ws + OFF_CS);
    bf16_t* __restrict__ kpe = (bf16_t*)(ws + R_G);
    bf16_t* __restrict__ lin = (bf16_t*)(ws + R_A + 48 * MiB);
    bf16_t* __restrict__ rs = (bf16_t*)(ws + R_D); bf16_t* __restrict__ ks = rs + (size_t)T_TOK * 512; bf16_t* __restrict__ vs = ks + (size_t)T_TOK * 512;
    const float* mu = IN(10); const int* pos = (const int*)IN(2);
    const int l = tidx() & 63, gw = VB * 4 + (tidx() >> 6), nw = VG * 4;
#pragma unroll 2
    for (int tok = gw; tok < T_TOK; tok += nw) {
        const bf16_t* zrow = zm + (size_t)tok * 672;
        float sq = 0.f, skv = 0.f;
        {
            float f[8]; unpack8(*(const u32x4*)(zrow + l * 8), f);
            float s = 0.f;
#pragma unroll
            for (int j = 0; j < 8; ++j) s += f[j] * f[j];
            if (l < 48) sq += s; else skv += s;
            if (l < 16) { unpack8(*(const u32x4*)(zrow + (64 + l) * 8), f); s = 0.f;
#pragma unroll
                for (int j = 0; j < 8; ++j) s += f[j] * f[j];
                skv += s; }
        }
        sq = wave_sum(sq); skv = wave_sum(skv);
        if (l == 0) { rsq[tok] = rsqrtf(sq * (1.0f / 384.0f) + RMS_EPS); rskv[tok] = rsqrtf(skv * (1.0f / 256.0f) + RMS_EPS); }
        if (l < 16) {
            const float invf = powf(10000.0f, -(float)l * (1.0f / 16.0f));
            const float ang = (float)pos[tok] * invf;
            float sn, c; sincosf(ang, &sn, &c);
            cs[(size_t)tok * 32 + l] = c; cs[(size_t)tok * 32 + 16 + l] = sn;
            const float x1 = bf1(zrow[640 + l]), x2 = bf1(zrow[656 + l]);
            kpe[(size_t)tok * 32 + l] = (bf16_t)f2bf(x1 * c - x2 * sn);
            kpe[(size_t)tok * 32 + 16 + l] = (bf16_t)f2bf(x2 * c + x1 * sn);
        }
        const bool first = (tok % SEQ) == 0;
        const bf16_t* cur = zr + (size_t)tok * 1792; const bf16_t* prv = cur - 1792;
#pragma unroll
        for (int ps = 0; ps < 4; ++ps) {
            const int ch = ps * 64 + l;
            if (ch < 224) {
                const int c0 = ch * 8;
                float fc[8], fp[8], zs[8];
                unpack8(*(const u32x4*)(cur + c0), fc);
                if (first) {
#pragma unroll
                    for (int j = 0; j < 8; ++j) fp[j] = 0.f;
                } else unpack8(*(const u32x4*)(prv + c0), fp);
                const f32x4 m0 = *(const f32x4*)(mu + c0), m1 = *(const f32x4*)(mu + c0 + 4);
#pragma unroll
                for (int j = 0; j < 8; ++j) { const float m = j < 4 ? m0[j] : m1[j - 4]; zs[j] = fc[j] + (fp[j] - fc[j]) * m; }
                bf16_t* dst;
                if (c0 < 512) dst = rs + (size_t)tok * 512 + c0;
                else if (c0 < 1024) dst = ks + (size_t)tok * 512 + (c0 - 512);
                else if (c0 < 1536) dst = vs + (size_t)tok * 512 + (c0 - 1024);
                else {
                    dst = lin + (size_t)tok * 256 + (c0 - 1536);
                    if (c0 < 1600) {
#pragma unroll
                        for (int j = 0; j < 8; ++j) zs[j] = tanhf(zs[j]);
                    } else if (c0 >= 1664) {
#pragma unroll
                        for (int j = 0; j < 8; ++j) zs[j] = sigmoidf_(zs[j]);
                    }
                }
                *(u32x4*)dst = pack8(zs);
            }
        }
    }
}

__device__ void phase3(const Params& p, unsigned char* lds) {
    unsigned char* ws = lnd(p.ws); EPI_IDS
    const bf16_t* zm = (const bf16_t*)(ws + R_B);
    const bf16_t* lin = (const bf16_t*)(ws + R_A + 48 * MiB);
    const float* rsq = (const float*)(ws + OFF_RSQ); const float* rskv = (const float*)(ws + OFF_RSKV); const float* cs = (const float*)(ws + OFF_CS);
    bf16_t* qb = (bf16_t*)(ws + R_A); bf16_t* kn = (bf16_t*)(ws + R_E); bf16_t* vt = (bf16_t*)(ws + R_F);
    bf16_t* ks = (bf16_t*)(ws + R_D) + (size_t)T_TOK * 512;
    bf16_t* kk = (bf16_t*)(ws + R_C); bf16_t* bb = kk + (size_t)T_TOK * 512; bf16_t* om = bb + (size_t)T_TOK * 512;
    bf16_t* gg = (bf16_t*)(ws + R_H);
    constexpr int N_Q = 256 * 6, N_KN = 256 * 4, N_VT = 4 * 256, N_L = 256 * 4;
    constexpr int TOT = N_Q + N_KN + N_VT + 3 * N_L;
    for (int it = VB; it < TOT; it += VG) {
        f32x4 acc[4][4];
        if (it < N_Q) {
            const int rt = it / 6, ct = it % 6, m0 = rt * 128, n0 = ct * 128;
            gemm_core(zm + (size_t)m0 * 672, 672, (const bf16_t*)(ws + W_UQ) + (size_t)n0 * 384, 384, 384, acc, lds);
            const int G0 = (n0 + wc * 64) >> 4;
#pragma unroll
            for (int mi = 0; mi < 4; ++mi) {
                const int row = m0 + wr * 64 + mi * 16 + fr;
                const float sc = rsq[row] * QSCALE;
#pragma unroll
                for (int np = 0; np < 4; np += 2) {
                    const int r6 = (G0 + np) % 6;
                    f32x4 a = acc[mi][np] * sc, b = acc[mi][np + 1] * sc;
                    if (r6 == 4) {
                        const f32x4 c = *(const f32x4*)(cs + (size_t)row * 32 + fq * 4), s = *(const f32x4*)(cs + (size_t)row * 32 + 16 + fq * 4);
                        const f32x4 o1 = a * c - b * s, o2 = b * c + a * s; a = o1; b = o2;
                    }
                    const int col = n0 + wc * 64 + np * 16 + fq * 4;
                    u32x2 o; o.x = pk2(a[0], a[1]); o.y = pk2(a[2], a[3]); *(u32x2*)(qb + (size_t)row * 768 + col) = o;
                    o.x = pk2(b[0], b[1]); o.y = pk2(b[2], b[3]); *(u32x2*)(qb + (size_t)row * 768 + col + 16) = o;
                }
            }
        } else if (it < N_Q + N_KN) {
            const int i2 = it - N_Q, rt = i2 >> 2, ct = i2 & 3, m0 = rt * 128, n0 = ct * 128;
            gemm_core(zm + (size_t)m0 * 672 + 384, 672, (const bf16_t*)(ws + W_KN) + (size_t)n0 * 256, 256, 256, acc, lds);
#pragma unroll
            for (int mi = 0; mi < 4; ++mi) {
                const int row = m0 + wr * 64 + mi * 16 + fr; const float sc = rskv[row];
#pragma unroll
                for (int q = 0; q < 2; ++q) {
                    const int col = n0 + wc * 64 + q * 32 + fq * 8; const f32x4 a = acc[mi][2 * q] * sc, c = acc[mi][2 * q + 1] * sc;
                    u32x4 o; o.x = pk2(a[0], a[1]); o.y = pk2(a[2], a[3]); o.z = pk2(c[0], c[1]); o.w = pk2(c[2], c[3]);
                    *(u32x4*)(kn + (size_t)row * 512 + col) = o;
                }
            }
        } else if (it < N_Q + N_KN + N_VT) {
            const int i2 = it - N_Q - N_KN, rt = i2 & 3, ct = i2 >> 2, m0 = rt * 128, n0 = ct * 128;
            gemm_core((const bf16_t*)(ws + W_V) + (size_t)m0 * 256, 256, zm + (size_t)n0 * 672 + 384, 672, 256, acc, lds);
#pragma unroll
            for (int ni = 0; ni < 4; ++ni) {
                const int col = n0 + wc * 64 + ni * 16 + fq * 4; const f32x4 sc = *(const f32x4*)(rskv + col);
#pragma unroll
                for (int mi = 0; mi < 4; ++mi) {
                    const int row = m0 + wr * 64 + mi * 16 + fr; const f32x4 a = acc[mi][ni] * sc;
                    u32x2 o; o.x = pk2(a[0], a[1]); o.y = pk2(a[2], a[3]); *(u32x2*)(vt + (size_t)row * T_TOK + col) = o;
                }
            }
        } else {
            const int i2 = it - N_Q - N_KN - N_VT, which = i2 / N_L, i3 = i2 % N_L, rt = i3 >> 2, ct = i3 & 3, m0 = rt * 128, n0 = ct * 128;
            if (which == 0) {
                gemm_core(lin + (size_t)m0 * 256, 256, (const bf16_t*)(ws + W_W2) + (size_t)n0 * 64, 64, 64, acc, lds);
                const float* w0 = IN(11);
#pragma unroll
                for (int q = 0; q < 2; ++q) {
                    const int col = n0 + wc * 64 + q * 32 + fq * 8; const f32x4 w0a = *(const f32x4*)(w0 + col), w0b = *(const f32x4*)(w0 + col + 4);
#pragma unroll
                    for (int mi = 0; mi < 4; ++mi) {
                        const int row = m0 + wr * 64 + mi * 16 + fr; float o8[8];
#pragma unroll
                        for (int r = 0; r < 8; ++r) {
                            const float x = (r < 4 ? w0a[r & 3] : w0b[r & 3]) + (r < 4 ? acc[mi][2 * q][r & 3] : acc[mi][2 * q + 1][r & 3]);
                            const float e = 0.60653065971f * sigmoidf_(x);
                            o8[r] = e * (1.0f - e * (0.5f - e * (0.16666667f - e * (0.041666667f - e * (0.0083333333f - e * (0.0013888889f - e * 0.0001984127f))))));
                        }
                        *(u32x4*)(om + (size_t)row * 512 + col) = pack8(o8);
                    }
                }
            } else if (which == 1) {
                gemm_core(lin + (size_t)m0 * 256 + 64, 256, (const bf16_t*)(ws + W_A2) + (size_t)n0 * 64, 64, 64, acc, lds);
                const float* a0 = IN(13); const float* k_k = IN(16); const float* k_a = IN(17);
#pragma unroll
                for (int mi = 0; mi < 4; ++mi) {
                    const int row = m0 + wr * 64 + mi * 16 + fr;
                    float ksv[2][8], kkr[2][8], al[2][8]; float ss = 0.f;
#pragma unroll
                    for (int q = 0; q < 2; ++q) {
                        const int col = n0 + wc * 64 + q * 32 + fq * 8;
                        unpack8(*(const u32x4*)(ks + (size_t)row * 512 + col), ksv[q]);
                        const f32x4 a0a = *(const f32x4*)(a0 + col), a0b = *(const f32x4*)(a0 + col + 4), kka = *(const f32x4*)(k_k + col), kkb = *(const f32x4*)(k_k + col + 4);
#pragma unroll
                        for (int r = 0; r < 8; ++r) {
                            const float av = r < 4 ? acc[mi][2 * q][r & 3] : acc[mi][2 * q + 1][r & 3];
                            al[q][r] = sigmoidf_((r < 4 ? a0a[r & 3] : a0b[r & 3]) + av);
                            kkr[q][r] = ksv[q][r] * (r < 4 ? kka[r & 3] : kkb[r & 3]); ss += kkr[q][r] * kkr[q][r];
                        }
                    }
                    ss += __shfl_xor(ss, 16); ss += __shfl_xor(ss, 32);
                    const float inv = 1.0f / fmaxf(sqrtf(ss), 1e-12f);
#pragma unroll
                    for (int q = 0; q < 2; ++q) {
                        const int col = n0 + wc * 64 + q * 32 + fq * 8;
                        const f32x4 kaa = *(const f32x4*)(k_a + col), kab = *(const f32x4*)(k_a + col + 4);
                        float k1[8], b1[8], kp[8];
#pragma unroll
                        for (int r = 0; r < 8; ++r) { k1[r] = kkr[q][r] * inv; b1[r] = k1[r] * al[q][r]; kp[r] = ksv[q][r] * (1.0f + (al[q][r] - 1.0f) * (r < 4 ? kaa[r & 3] : kab[r & 3])); }
                        *(u32x4*)(kk + (size_t)row * 512 + col) = pack8(k1);
                        *(u32x4*)(bb + (size_t)row * 512 + col) = pack8(b1);
                        *(u32x4*)(ks + (size_t)row * 512 + col) = pack8(kp);
                    }
                }
            } else {
                gemm_core(lin + (size_t)m0 * 256 + 128, 256, (const bf16_t*)(ws + W_G2) + (size_t)n0 * 128, 128, 128, acc, lds);
#pragma unroll
                for (int mi = 0; mi < 4; ++mi) {
                    const int row = m0 + wr * 64 + mi * 16 + fr;
#pragma unroll
                    for (int q = 0; q < 2; ++q) {
                        const int col = n0 + wc * 64 + q * 32 + fq * 8; const f32x4 a = acc[mi][2 * q], c = acc[mi][2 * q + 1];
                        u32x4 o; o.x = pk2(a[0], a[1]); o.y = pk2(a[2], a[3]); o.z = pk2(c[0], c[1]); o.w = pk2(c[2], c[3]);
                        *(u32x4*)(gg + (size_t)row * 512 + col) = o;
                    }
                }
            }
        }
    }
}

struct HalfBar { unsigned addr; unsigned target; };
__device__ __forceinline__ void hb_sync(HalfBar& hb) {
    asm volatile("s_waitcnt lgkmcnt(0)" ::: "memory");
    hb.target += 4u;
    const int lane = threadIdx.x & 63;
    if (lane == 0) asm volatile("ds_add_u32 %0, %1" :: "v"(hb.addr), "v"(1u) : "memory");
    for (;;) {
        unsigned v;
        asm volatile("ds_read_b32 %0, %1\n\ts_waitcnt lgkmcnt(0)" : "=v"(v) : "v"(hb.addr) : "memory");
        if ((int)(__builtin_amdgcn_readfirstlane(v) - hb.target) >= 0) break;
        __builtin_amdgcn_s_sleep(1);
    }
    asm volatile("" ::: "memory");
}
#define SCAN_BAR() do { asm volatile("s_waitcnt lgkmcnt(0)" ::: "memory"); __builtin_amdgcn_s_barrier(); asm volatile("" ::: "memory"); } while (0)
constexpr int SCAN_CH = 32;
constexpr int SCAN_NBAR = 2 + (SEQ / SCAN_CH);
__device__ void scan_consumer(const Params& p, int si, unsigned char* lds) {
    unsigned char* ws = lnd(p.ws);
    const int chain = si >> 2, rg = si & 3, b = chain >> 3, h = chain & 7;
    const int tid = tidx(), w = tid >> 6, l = tid & 63, rowA = w * 4 + (l >> 4), kg = l & 15;
    const bf16_t* rs = (const bf16_t*)(ws + R_D); const bf16_t* ks = rs + (size_t)T_TOK * 512; const bf16_t* vs = ks + (size_t)T_TOK * 512;
    const bf16_t* kk = (const bf16_t*)(ws + R_C); const bf16_t* bb = kk + (size_t)T_TOK * 512; const bf16_t* om = bb + (size_t)T_TOK * 512;
    bf16_t* yo = (bf16_t*)(ws + R_I);
    float* ops = (float*)lds;
    float* vb = (float*)(lds + 81920);
    float* yb = (float*)(lds + 86016);
    const size_t tokb = (size_t)b * SEQ;
    const int lrem = tid & 127, lstep = lrem >> 3, lpart = lrem & 7, lhalf = tid >> 7;
    const bf16_t* sp0 = (lhalf ? om : kk) + (tokb + lstep) * 512 + h * 64 + lpart * 8;
    const bf16_t* sp1 = (lhalf ? ks : bb) + (tokb + lstep) * 512 + h * 64 + lpart * 8;
    const bf16_t* sp2 = rs + (tokb + lstep) * 512 + h * 64 + lpart * 8;
    const bf16_t* spv = vs + (tokb + ((tid & 31) >> 1)) * 512 + h * 64 + rg * 16 + (tid & 1) * 8;
    const int ldst0 = lstep * 320 + lhalf * 64 + lpart * 8, ldst1 = lstep * 320 + (2 + lhalf) * 64 + lpart * 8, ldst2 = lstep * 320 + 256 + lpart * 8;
    (void)sp0; (void)sp1; (void)sp2; (void)spv; (void)ldst0; (void)ldst1; (void)ldst2;
    constexpr int NCH = SEQ / SCAN_CH;
    const unsigned lds_ops = (unsigned)(size_t)(LAS unsigned char*)lds, lds_vb = lds_ops + 81920u, lds_yb = lds_ops + 86016u;
#define SC_RD(KK, DD, NB, K_, RR, VV, PA, PV, ST) do { \
        asm volatile("ds_read_b128 %0, %1 offset:%2" : "=v"(KK) : "v"(PA), "i"((ST) * 1280) : "memory"); \
        asm volatile("ds_read_b128 %0, %1 offset:%2" : "=v"(DD) : "v"(PA), "i"((ST) * 1280 + 256) : "memory"); \
        asm volatile("ds_read_b128 %0, %1 offset:%2" : "=v"(NB) : "v"(PA), "i"((ST) * 1280 + 512) : "memory"); \
        asm volatile("ds_read_b128 %0, %1 offset:%2" : "=v"(K_) : "v"(PA), "i"((ST) * 1280 + 768) : "memory"); \
        asm volatile("ds_read_b128 %0, %1 offset:%2" : "=v"(RR) : "v"(PA), "i"((ST) * 1280 + 1024) : "memory"); \
        asm volatile("ds_read_b32 %0, %1 offset:%2" : "=v"(VV) : "v"(PV), "i"((ST) * 64) : "memory"); } while (0)
#define SC_WAIT(N, KK, DD, NB, K_, RR, VV) asm volatile("s_waitcnt lgkmcnt(" #N ")" : "+v"(KK), "+v"(DD), "+v"(NB), "+v"(K_), "+v"(RR), "+v"(VV) :: "memory")
    typedef float f32x2 __attribute__((ext_vector_type(2)));
    f32x2 S01 = {0.f, 0.f}, S23 = {0.f, 0.f};
#define SC_STEP(ST, CKK, CD, CNB, CK, CR, CV, NKK, ND, NNB, NK, NR, NV, WN) do { \
        f32x2 u_ = {0.f, 0.f}; \
        if ((ST) > 0) { u_ = S01 * NR.xy; u_ = S23 * NR.zw + u_; } \
        if ((ST) < 31) SC_RD(NKK, ND, NNB, NK, NR, NV, pa, pv, (ST) + 1); \
        SC_WAIT(WN, CKK, CD, CNB, CK, CR, CV); \
        f32x2 t_ = S01 * CKK.xy; t_ = S23 * CKK.zw + t_; \
        float sa_ = t_.x + t_.y; \
        const f32x2 W01_ = S01 * CD.xy + CK.xy * CV, W23_ = S23 * CD.zw + CK.zw * CV; \
        float y_ = u_.x + u_.y; \
        sa_ += dppf<0x128>(sa_); sa_ += dppf<0x124>(sa_); \
        if ((ST) > 0) y_ += dppf<0x128>(y_); \
        sa_ += dppf<0x122>(sa_); sa_ += dppf<0x121>(sa_); \
        S01 = CNB.xy * sa_ + W01_; S23 = CNB.zw * sa_ + W23_; \
        if ((ST) > 0) asm volatile("ds_write_b32 %0, %1 offset:%2" :: "v"(pw), "v"(y_), "i"(((ST) > 0 ? (ST) - 1 : 0) * 512) : "memory"); } while (0)
    SCAN_BAR();
    SCAN_BAR();
    for (int c = 0; c < NCH; ++c) {
        const int buf = c & 1;
        const unsigned pa = lds_ops + (unsigned)(buf * 40960 + kg * 16), pv = lds_vb + (unsigned)(buf * 2048 + rowA * 4);
        const unsigned pw = lds_yb + (unsigned)(buf * 16384 + (rowA * 8 + (kg & 7)) * 4);
        f32x4 akk, ad, anb, ak, ar, bkk, bd, bnb, bk, br; float av, bv;
        SC_RD(akk, ad, anb, ak, ar, av, pa, pv, 0);
        SC_STEP(0, akk, ad, anb, ak, ar, av, bkk, bd, bnb, bk, br, bv, 6);
        SC_STEP(1, bkk, bd, bnb, bk, br, bv, akk, ad, anb, ak, ar, av, 6);
        SC_STEP(2, akk, ad, anb, ak, ar, av, bkk, bd, bnb, bk, br, bv, 7);
        SC_STEP(3, bkk, bd, bnb, bk, br, bv, akk, ad, anb, ak, ar, av, 7);
        SC_STEP(4, akk, ad, anb, ak, ar, av, bkk, bd, bnb, bk, br, bv, 7);
        SC_STEP(5, bkk, bd, bnb, bk, br, bv, akk, ad, anb, ak, ar, av, 7);
        SC_STEP(6, akk, ad, anb, ak, ar, av, bkk, bd, bnb, bk, br, bv, 7);
        SC_STEP(7, bkk, bd, bnb, bk, br, bv, akk, ad, anb, ak, ar, av, 7);
        SC_STEP(8, akk, ad, anb, ak, ar, av, bkk, bd, bnb, bk, br, bv, 7);
        SC_STEP(9, bkk, bd, bnb, bk, br, bv, akk, ad, anb, ak, ar, av, 7);
        SC_STEP(10, akk, ad, anb, ak, ar, av, bkk, bd, bnb, bk, br, bv, 7);
        SC_STEP(11, bkk, bd, bnb, bk, br, bv, akk, ad, anb, ak, ar, av, 7);
        SC_STEP(12, akk, ad, anb, ak, ar, av, bkk, bd, bnb, bk, br, bv, 7);
        SC_STEP(13, bkk, bd, bnb, bk, br, bv, akk, ad, anb, ak, ar, av, 7);
        SC_STEP(14, akk, ad, anb, ak, ar, av, bkk, bd, bnb, bk, br, bv, 7);
        SC_STEP(15, bkk, bd, bnb, bk, br, bv, akk, ad, anb, ak, ar, av, 7);
        SC_STEP(16, akk, ad, anb, ak, ar, av, bkk, bd, bnb, bk, br, bv, 7);
        SC_STEP(17, bkk, bd, bnb, bk, br, bv, akk, ad, anb, ak, ar, av, 7);
        SC_STEP(18, akk, ad, anb, ak, ar, av, bkk, bd, bnb, bk, br, bv, 7);
        SC_STEP(19, bkk, bd, bnb, bk, br, bv, akk, ad, anb, ak, ar, av, 7);
        SC_STEP(20, akk, ad, anb, ak, ar, av, bkk, bd, bnb, bk, br, bv, 7);
        SC_STEP(21, bkk, bd, bnb, bk, br, bv, akk, ad, anb, ak, ar, av, 7);
        SC_STEP(22, akk, ad, anb, ak, ar, av, bkk, bd, bnb, bk, br, bv, 7);
        SC_STEP(23, bkk, bd, bnb, bk, br, bv, akk, ad, anb, ak, ar, av, 7);
        SC_STEP(24, akk, ad, anb, ak, ar, av, bkk, bd, bnb, bk, br, bv, 7);
        SC_STEP(25, bkk, bd, bnb, bk, br, bv, akk, ad, anb, ak, ar, av, 7);
        SC_STEP(26, akk, ad, anb, ak, ar, av, bkk, bd, bnb, bk, br, bv, 7);
        SC_STEP(27, bkk, bd, bnb, bk, br, bv, akk, ad, anb, ak, ar, av, 7);
        SC_STEP(28, akk, ad, anb, ak, ar, av, bkk, bd, bnb, bk, br, bv, 7);
        SC_STEP(29, bkk, bd, bnb, bk, br, bv, akk, ad, anb, ak, ar, av, 7);
        SC_STEP(30, akk, ad, anb, ak, ar, av, bkk, bd, bnb, bk, br, bv, 7);
        SC_STEP(31, bkk, bd, bnb, bk, br, bv, akk, ad, anb, ak, ar, av, 1);
        {
            f32x2 u_ = S01 * br.xy; u_ = S23 * br.zw + u_;
            float y_ = u_.x + u_.y; y_ += dppf<0x128>(y_);
            asm volatile("ds_write_b32 %0, %1 offset:%2" :: "v"(pw), "v"(y_), "i"(31 * 512) : "memory");
        }
        asm volatile("s_waitcnt lgkmcnt(0)" ::: "memory");
        SCAN_BAR();
#pragma unroll
        for (int hh = 0; hh < 2; ++hh) {
            const int st = (tid >> 4) + 16 * hh, r = tid & 15;
            const float* yr = yb + buf * 4096 + st * 128 + r * 8;
            const f32x4 a0 = *(const f32x4*)(yr), a1 = *(const f32x4*)(yr + 4);
            const f32x4 sm = a0 + a1;
            const float y = (sm[0] + sm[1]) + (sm[2] + sm[3]);
            const unsigned short yv = (unsigned short)f2bf(y);
            const bf16_t* ya = yo + (tokb + (size_t)c * SCAN_CH + st) * 512 + h * 64 + rg * 16 + r;
            asm volatile("global_store_short %0, %1, off" :: "v"(ya), "v"((unsigned)yv) : "memory");
        }
    }
    asm volatile("s_waitcnt vmcnt(0)" ::: "memory");
}
__device__ void scan_producer(const Params& p, int si, unsigned char* lds) {
    unsigned char* ws = lnd(p.ws);
    const int chain = si >> 2, rg = si & 3, b = chain >> 3, h = chain & 7;
    const int tid = tidx(), w = tid >> 6, l = tid & 63, rowA = w * 4 + (l >> 4), kg = l & 15;
    const bf16_t* rs = (const bf16_t*)(ws + R_D); const bf16_t* ks = rs + (size_t)T_TOK * 512; const bf16_t* vs = ks + (size_t)T_TOK * 512;
    const bf16_t* kk = (const bf16_t*)(ws + R_C); const bf16_t* bb = kk + (size_t)T_TOK * 512; const bf16_t* om = bb + (size_t)T_TOK * 512;
    bf16_t* yo = (bf16_t*)(ws + R_I);
    float* ops = (float*)lds;
    float* vb = (float*)(lds + 81920);
    float* yb = (float*)(lds + 86016);
    const size_t tokb = (size_t)b * SEQ;
    const int lrem = tid & 127, lstep = lrem >> 3, lpart = lrem & 7, lhalf = tid >> 7;
    const bf16_t* sp0 = (lhalf ? om : kk) + (tokb + lstep) * 512 + h * 64 + lpart * 8;
    const bf16_t* sp1 = (lhalf ? ks : bb) + (tokb + lstep) * 512 + h * 64 + lpart * 8;
    const bf16_t* sp2 = rs + (tokb + lstep) * 512 + h * 64 + lpart * 8;
    const bf16_t* spv = vs + (tokb + ((tid & 31) >> 1)) * 512 + h * 64 + rg * 16 + (tid & 1) * 8;
    const int ldst0 = lstep * 320 + lhalf * 64 + lpart * 8, ldst1 = lstep * 320 + (2 + lhalf) * 64 + lpart * 8, ldst2 = lstep * 320 + 256 + lpart * 8;
    struct GSet { u32x4 g0, g1, g2, gv, h0, h1, h2, hv; };
    GSet RA, RB, RC;
    auto gload = [&](int c, GSet& R) {
        const size_t o = (size_t)c * SCAN_CH * 512 * 2, o2 = o + (size_t)16 * 512 * 2;
        const char* q0 = (const char*)sp0 + o; const char* q1 = (const char*)sp1 + o; const char* q2 = (const char*)sp2 + o; const char* q3 = (const char*)spv + o;
        const char* r0 = (const char*)sp0 + o2; const char* r1 = (const char*)sp1 + o2; const char* r2 = (const char*)sp2 + o2; const char* r3 = (const char*)spv + o2;
        asm volatile("global_load_dwordx4 %0, %1, off" : "=v"(R.g0) : "v"(q0) : "memory");
        asm volatile("global_load_dwordx4 %0, %1, off" : "=v"(R.g1) : "v"(q1) : "memory");
        asm volatile("global_load_dwordx4 %0, %1, off" : "=v"(R.g2) : "v"(q2) : "memory");
        asm volatile("global_load_dwordx4 %0, %1, off" : "=v"(R.gv) : "v"(q3) : "memory");
        asm volatile("global_load_dwordx4 %0, %1, off" : "=v"(R.h0) : "v"(r0) : "memory");
        asm volatile("global_load_dwordx4 %0, %1, off" : "=v"(R.h1) : "v"(r1) : "memory");
        asm volatile("global_load_dwordx4 %0, %1, off" : "=v"(R.h2) : "v"(r2) : "memory");
        asm volatile("global_load_dwordx4 %0, %1, off" : "=v"(R.hv) : "v"(r3) : "memory");
    };
    auto lstore1 = [&](int buf, int sub, const u32x4& x0, const u32x4& x1, const u32x4& x2, const u32x4& xv) {
        float f[8]; float* ob = ops + buf * 10240 + sub * 5120;
        unpack8(x0, f);
        if (lhalf) {
#pragma unroll
            for (int j = 0; j < 8; ++j) f[j] = 1.0f - f[j];
        }
        *(f32x4*)(ob + ldst0) = (f32x4){f[0], f[1], f[2], f[3]}; *(f32x4*)(ob + ldst0 + 4) = (f32x4){f[4], f[5], f[6], f[7]};
        unpack8(x1, f);
        if (!lhalf) {
#pragma unroll
            for (int j = 0; j < 8; ++j) f[j] = -f[j];
        }
        *(f32x4*)(ob + ldst1) = (f32x4){f[0], f[1], f[2], f[3]}; *(f32x4*)(ob + ldst1 + 4) = (f32x4){f[4], f[5], f[6], f[7]};
        if (tid < 128) { unpack8(x2, f); *(f32x4*)(ob + ldst2) = (f32x4){f[0], f[1], f[2], f[3]}; *(f32x4*)(ob + ldst2 + 4) = (f32x4){f[4], f[5], f[6], f[7]}; }
        if (tid < 32) { unpack8(xv, f); float* vd = vb + buf * 512 + sub * 256 + (tid >> 1) * 16 + (tid & 1) * 8;
            *(f32x4*)(vd) = (f32x4){f[0], f[1], f[2], f[3]}; *(f32x4*)(vd + 4) = (f32x4){f[4], f[5], f[6], f[7]}; }
    };
    auto lstore = [&](int buf, const GSet& R) { lstore1(buf, 0, R.g0, R.g1, R.g2, R.gv); lstore1(buf, 1, R.h0, R.h1, R.h2, R.hv); };
#define SC_VWAIT(N, R) asm volatile("s_waitcnt vmcnt(" #N ")" : "+v"(R.g0), "+v"(R.g1), "+v"(R.g2), "+v"(R.gv), "+v"(R.h0), "+v"(R.h1), "+v"(R.h2), "+v"(R.hv) :: "memory")
    constexpr int NCH = SEQ / SCAN_CH;
    (void)yo; (void)yb; (void)rowA; (void)kg;
    asm volatile("s_waitcnt vmcnt(0)" ::: "memory");
    SCAN_BAR();
    gload(0, RA); SC_VWAIT(0, RA); lstore(0, RA);
    gload(1, RB); gload(2, RC); gload(3, RA);
    SCAN_BAR();
    auto do_chunk = [&](int c, GSet& NX) {
        const int buf = c & 1;
        if (c + 1 < NCH) { SC_VWAIT(16, NX); lstore(buf ^ 1, NX); }
        SCAN_BAR();
        gload(c + 4 < NCH ? c + 4 : NCH - 1, NX);
    };
    for (int c = 0; c < NCH; c += 3) {
        do_chunk(c, RB);
        if (c + 1 < NCH) do_chunk(c + 1, RC);
        if (c + 2 < NCH) do_chunk(c + 2, RA);
    }
    asm volatile("s_waitcnt vmcnt(0)" ::: "memory");
}

__device__ __forceinline__ int pe_sw(int row) { return (0x78 >> (2 * ((row >> 2) & 3))) & 3; }
__device__ void attn_unit(const Params& p, int b, int h, int qblk, unsigned char* lds) {
    unsigned char* ws = lnd(p.ws);
    const bf16_t* Q = (const bf16_t*)(ws + R_A); const bf16_t* KN = (const bf16_t*)(ws + R_E); const bf16_t* VT = (const bf16_t*)(ws + R_F);
    const bf16_t* KP = (const bf16_t*)(ws + R_G); bf16_t* O = (bf16_t*)(ws + R_B);
    const int tid = tidx(), w = tid >> 6, l = tid & 63, fr = l & 15, g = l >> 4;
    const size_t tokb = (size_t)b * SEQ;
    const int q0 = qblk * 128 + w * 32;
    constexpr int BUFB = 21504, KP_OFF = 8192, VT_OFF = 12288;
    bf16x8 qf[2][3];
#pragma unroll
    for (int qi = 0; qi < 2; ++qi)
#pragma unroll
        for (int s = 0; s < 3; ++s) qf[qi][s] = *(const bf16x8*)(Q + (tokb + q0 + qi * 16 + fr) * 768 + h * 96 + s * 32 + g * 8);
    f32x4 o[4][2];
#pragma unroll
    for (int i = 0; i < 4; ++i) { o[i][0] = (f32x4){0.f, 0.f, 0.f, 0.f}; o[i][1] = (f32x4){0.f, 0.f, 0.f, 0.f}; }
    float mrun[2] = {-1e30f, -1e30f}, lsum[2] = {0.f, 0.f};
    const int ntiles = 2 * qblk + 2;
    const int kkey = tid >> 3, kkc = tid & 7;
    const int pkey = tid >> 2, pkc = tid & 3;
    const bf16_t* gkn = KN + (tokb + kkey) * 512 + h * 64 + kkc * 8;
    const bf16_t* gkp = KP + (tokb + pkey) * 32 + pkc * 8;
    const bf16_t* gvt = VT + ((size_t)h * 64 + kkey) * T_TOK + tokb + kkc * 8;
    const unsigned dkn = (unsigned)(kkey * 128 + ((kkc ^ (kkey & 7)) * 16));
    const unsigned dkp = (unsigned)(KP_OFF + pkey * 64 + ((pkc ^ pe_sw(pkey)) * 16));
    const unsigned dvt = (unsigned)(VT_OFF + kkey * 144 + kkc * 16);
    struct KVSet { u32x4 rk0, rk1, rp, rv0, rv1; };
    KVSet SA, SB;
    auto gload = [&](int kt, KVSet& R) {
        R.rk0 = *(const u32x4*)(gkn + (size_t)kt * 64 * 512); R.rk1 = *(const u32x4*)(gkn + ((size_t)kt * 64 + 32) * 512);
        R.rp = *(const u32x4*)(gkp + (size_t)kt * 64 * 32);
        R.rv0 = *(const u32x4*)(gvt + kt * 64); R.rv1 = *(const u32x4*)(gvt + (size_t)32 * T_TOK + kt * 64);
    };
    auto lstore = [&](int buf, const KVSet& R) {
        unsigned char* d = lds + buf * BUFB;
        *(u32x4*)(d + dkn) = R.rk0; *(u32x4*)(d + dkn + 32 * 128) = R.rk1; *(u32x4*)(d + dkp) = R.rp;
        *(u32x4*)(d + dvt) = R.rv0; *(u32x4*)(d + dvt + 32 * 144) = R.rv1;
    };
    const unsigned kfo0 = (unsigned)(fr * 128 + (((0 + g) ^ (fr & 7)) * 16)), kfo1 = (unsigned)(fr * 128 + (((4 + g) ^ (fr & 7)) * 16));
    const unsigned kfo2 = (unsigned)(KP_OFF + fr * 64 + ((g ^ pe_sw(fr)) * 16));
    const unsigned vfo = (unsigned)(VT_OFF + fr * 144 + g * 8);
    __syncthreads();
    gload(0, SA); lstore(0, SA);
    gload(1, SB);
    __syncthreads();
    auto tile_body = [&](int kt, const KVSet& NXT, KVSet& FREE) {
        const unsigned char* d = lds + (kt & 1) * BUFB;
        if (kt + 2 < ntiles) gload(kt + 2, FREE);
        f32x4 s_[4][2];
#pragma unroll
        for (int j = 0; j < 4; ++j) {
            const bf16x8 k0 = *(const bf16x8*)(d + kfo0 + j * 2048), k1 = *(const bf16x8*)(d + kfo1 + j * 2048), k2 = *(const bf16x8*)(d + kfo2 + j * 1024);
#pragma unroll
            for (int qi = 0; qi < 2; ++qi) {
                f32x4 a = {0.f, 0.f, 0.f, 0.f};
                a = __builtin_amdgcn_mfma_f32_16x16x32_bf16(k0, qf[qi][0], a, 0, 0, 0);
                a = __builtin_amdgcn_mfma_f32_16x16x32_bf16(k1, qf[qi][1], a, 0, 0, 0);
                a = __builtin_amdgcn_mfma_f32_16x16x32_bf16(k2, qf[qi][2], a, 0, 0, 0);
                s_[j][qi] = a;
            }
        }
        if (kt * 64 + 63 > q0) {
#pragma unroll
            for (int j = 0; j < 4; ++j)
#pragma unroll
                for (int qi = 0; qi < 2; ++qi)
#pragma unroll
                    for (int r = 0; r < 4; ++r) { const int key = kt * 64 + j * 16 + g * 4 + r, q = q0 + qi * 16 + fr; if (key > q) s_[j][qi][r] = -1e30f; }
        }
        bf16x8 pf[2][2];
#pragma unroll
        for (int qi = 0; qi < 2; ++qi) {
            float mx = -1e30f;
#pragma unroll
            for (int j = 0; j < 4; ++j) mx = fmaxf(mx, fmaxf(fmaxf(s_[j][qi][0], s_[j][qi][1]), fmaxf(s_[j][qi][2], s_[j][qi][3])));
            mx = fmaxf(mx, __shfl_xor(mx, 16)); mx = fmaxf(mx, __shfl_xor(mx, 32));
            const float mn = fmaxf(mrun[qi], mx);
            const float alpha = __builtin_amdgcn_exp2f(mrun[qi] - mn);
            mrun[qi] = mn;
            float psum = 0.f;
#pragma unroll
            for (int j = 0; j < 4; ++j)
#pragma unroll
                for (int r = 0; r < 4; ++r) { const float pv = __builtin_amdgcn_exp2f(s_[j][qi][r] - mn); s_[j][qi][r] = pv; psum += pv; }
            lsum[qi] = lsum[qi] * alpha + psum;
#pragma unroll
            for (int dt = 0; dt < 4; ++dt) o[dt][qi] = o[dt][qi] * alpha;
#pragma unroll
            for (int ksx = 0; ksx < 2; ++ksx) {
                u32x4 pw; pw.x = pk2(s_[2 * ksx][qi][0], s_[2 * ksx][qi][1]); pw.y = pk2(s_[2 * ksx][qi][2], s_[2 * ksx][qi][3]);
                pw.z = pk2(s_[2 * ksx + 1][qi][0], s_[2 * ksx + 1][qi][1]); pw.w = pk2(s_[2 * ksx + 1][qi][2], s_[2 * ksx + 1][qi][3]);
                pf[ksx][qi] = __builtin_bit_cast(bf16x8, pw);
            }
        }
#pragma unroll
        for (int ksx = 0; ksx < 2; ++ksx)
#pragma unroll
            for (int dt = 0; dt < 4; ++dt) {
                const u32x2 v0 = *(const u32x2*)(d + vfo + dt * 16 * 144 + ksx * 64), v1 = *(const u32x2*)(d + vfo + dt * 16 * 144 + ksx * 64 + 32);
                u32x4 vw; vw.x = v0.x; vw.y = v0.y; vw.z = v1.x; vw.w = v1.y;
                const bf16x8 vf = __builtin_bit_cast(bf16x8, vw);
                o[dt][0] = __builtin_amdgcn_mfma_f32_16x16x32_bf16(vf, pf[ksx][0], o[dt][0], 0, 0, 0);
                o[dt][1] = __builtin_amdgcn_mfma_f32_16x16x32_bf16(vf, pf[ksx][1], o[dt][1], 0, 0, 0);
            }
        if (kt + 1 < ntiles) lstore((kt + 1) & 1, NXT);
        __syncthreads();
    };
    for (int kt = 0; kt < ntiles; kt += 2) { tile_body(kt, SB, SA); tile_body(kt + 1, SA, SB); }
#pragma unroll
    for (int qi = 0; qi < 2; ++qi) {
        float lt = lsum[qi]; lt += __shfl_xor(lt, 16); lt += __shfl_xor(lt, 32);
        const float inv = 1.0f / lt;
        const size_t tok = tokb + q0 + qi * 16 + fr;
#pragma unroll
        for (int dt = 0; dt < 4; ++dt) {
            const f32x4 v = o[dt][qi] * inv;
            u32x2 ow; ow.x = pk2(v[0], v[1]); ow.y = pk2(v[2], v[3]);
            *(u32x2*)(O + tok * 512 + h * 64 + dt * 16 + g * 4) = ow;
        }
    }
}

__device__ void phase4(const Params& p, unsigned char* lds, int* s_item, int rep) {
    if (VHALF == 0) {
        for (int si = blockIdx.x; si < 128; si += gridDim.x) {
            __builtin_amdgcn_s_setprio(3);
            scan_consumer(p, si, lds);
            __builtin_amdgcn_s_setprio(0);
        }
    } else {
        for (int si = blockIdx.x; si < 128; si += gridDim.x) scan_producer(p, si, lds - 65536);
    }
    unsigned* queue = (unsigned*)(p.ws + OFF_QUEUE) + 512 * rep;
    const int myx = (int)(xb_xcc_id() & 7u);
    for (;;) {
        __syncthreads();
        if (threadIdx.x == 0) {
            int code = -1;
            for (int k = 0; k < 8; ++k) {
                const int xx = (myx + k) & 7;
                const unsigned it = atomicAdd(queue + xx * 16, 2u);
                if (it < 256u) { code = xx * 256 + (int)it; break; }
            }
            s_item[0] = code;
        }
        __syncthreads();
        const int code = s_item[0];
        if (code < 0) break;
        const int h = code >> 8, it = (code & 255) + VHALF;
        const int qblk = 63 - (it >> 2), b = it & 3;
        attn_unit(p, b, h, qblk, lds);
    }
}

__device__ void phase5(const Params& p) {
    unsigned char* ws = lnd(p.ws);
    const bf16_t* __restrict__ rs = (const bf16_t*)(ws + R_D); const bf16_t* __restrict__ ks = rs + (size_t)T_TOK * 512; const bf16_t* __restrict__ vs = ks + (size_t)T_TOK * 512;
    const bf16_t* __restrict__ yv = (const bf16_t*)(ws + R_I); const bf16_t* __restrict__ gg = (const bf16_t*)(ws + R_H);
    bf16_t* __restrict__ ybp = (bf16_t*)(ws + R_C);
    const float* lnw = IN(19); const float* lnb = IN(20); const float* rk = IN(18);
    const int l = tidx() & 63, gw = VB * 4 + (tidx() >> 6), nw = VG * 4;
    const int c0 = l * 8;
    float wv[8], bv[8], rkv[8];
    { const f32x4 a = *(const f32x4*)(lnw + c0), b = *(const f32x4*)(lnw + c0 + 4), c = *(const f32x4*)(lnb + c0), d = *(const f32x4*)(lnb + c0 + 4), e = *(const f32x4*)(rk + c0), f = *(const f32x4*)(rk + c0 + 4);
#pragma unroll
      for (int j = 0; j < 4; ++j) { wv[j] = a[j]; wv[j + 4] = b[j]; bv[j] = c[j]; bv[j + 4] = d[j]; rkv[j] = e[j]; rkv[j + 4] = f[j]; } }
#pragma unroll 2
    for (int tok = gw; tok < T_TOK; tok += nw) {
        const size_t off = (size_t)tok * 512 + c0;
        float y[8], r[8], k[8], v[8], g[8];
        unpack8(*(const u32x4*)(yv + off), y); unpack8(*(const u32x4*)(rs + off), r); unpack8(*(const u32x4*)(ks + off), k);
        unpack8(*(const u32x4*)(vs + off), v); unpack8(*(const u32x4*)(gg + off), g);
        float s = 0.f, bs = 0.f;
#pragma unroll
        for (int j = 0; j < 8; ++j) { s += y[j]; bs += r[j] * k[j] * rkv[j]; }
        s += __shfl_xor(s, 1); s += __shfl_xor(s, 2); s += __shfl_xor(s, 4);
        bs += __shfl_xor(bs, 1); bs += __shfl_xor(bs, 2); bs += __shfl_xor(bs, 4);
        const float mean = s * (1.0f / 64.0f);
        float q = 0.f;
#pragma unroll
        for (int j = 0; j < 8; ++j) { const float d = y[j] - mean; q += d * d; }
        q += __shfl_xor(q, 1); q += __shfl_xor(q, 2); q += __shfl_xor(q, 4);
        const float rstd = rsqrtf(q * (1.0f / 64.0f) + 64e-5f);
        float o[8];
#pragma unroll
        for (int j = 0; j < 8; ++j) o[j] = ((y[j] - mean) * rstd * wv[j] + bv[j] + bs * v[j]) * g[j];
        *(u32x4*)(ybp + off) = pack8(o);
    }
    rmsnorm_rows_bf16(IN(0), IN(3), (bf16_t*)(ws + R_A));
}

__device__ void phase6(const Params& p, unsigned char* lds8) {
    unsigned char* ws = lnd(p.ws); EPI8_IDS
    const bf16_t* h = (const bf16_t*)(ws + R_A); const bf16_t* ob = (const bf16_t*)(ws + R_B); const bf16_t* ybp = (const bf16_t*)(ws + R_C);
    const bf16_t* Wg = (const bf16_t*)(ws + W_IN) + (size_t)2464 * 1024;
    bf16_t* mo = (bf16_t*)(ws + R_D);
    bf16_t* gsc = (bf16_t*)(ws + R_C + 32 * MiB);
    for (int iter = 0, rt, ct; tile_map8(iter, 128, 4, rt, ct); ++iter) {
        const int m0 = rt * 256, n0 = ct * 256;
        const int row0 = m0 + wr * 128 + fr, col0 = n0 + wc * 64 + fq * 8;
        f32x4 acc[8][4];
#pragma unroll 1
        for (int pass = 0; pass < 2; ++pass) {
            gemm8(h + (size_t)m0 * 1024, 1024, Wg + (size_t)(pass * 1024 + n0) * 1024, 1024, 1024, acc, lds8);
#pragma unroll
            for (int mi = 0; mi < 8; ++mi) {
#pragma unroll
                for (int q = 0; q < 2; ++q) {
                    float v[8];
#pragma unroll
                    for (int r = 0; r < 4; ++r) { v[r] = sigmoidf_(acc[mi][2 * q][r]); v[4 + r] = sigmoidf_(acc[mi][2 * q + 1][r]); }
                    *(u32x4*)(gsc + (size_t)(row0 + mi * 16) * 1024 + col0 + q * 32) = pack8(v);
                }
            }
            if (pass == 0) gemm8(ob + (size_t)m0 * 512, 512, (const bf16_t*)(ws + W_OA) + (size_t)n0 * 512, 512, 512, acc, lds8);
            else gemm8(ybp + (size_t)m0 * 512, 512, (const bf16_t*)(ws + W_OB) + (size_t)n0 * 512, 512, 512, acc, lds8);
            {
                u32x4 gn[2], pn[2];
#pragma unroll
                for (int q = 0; q < 2; ++q) { gn[q] = *(const u32x4*)(gsc + (size_t)row0 * 1024 + col0 + q * 32); pn[q] = pass ? *(const u32x4*)(mo + (size_t)row0 * 1024 + col0 + q * 32) : (u32x4){0u, 0u, 0u, 0u}; }
#pragma unroll
                for (int mi = 0; mi < 8; ++mi) {
                    const int row = row0 + mi * 16;
                    u32x4 gc[2], pc[2];
#pragma unroll
                    for (int q = 0; q < 2; ++q) { gc[q] = gn[q]; pc[q] = pn[q]; }
                    if (mi < 7) {
#pragma unroll
                        for (int q = 0; q < 2; ++q) { gn[q] = *(const u32x4*)(gsc + (size_t)(row + 16) * 1024 + col0 + q * 32); pn[q] = pass ? *(const u32x4*)(mo + (size_t)(row + 16) * 1024 + col0 + q * 32) : (u32x4){0u, 0u, 0u, 0u}; }
                    }
#pragma unroll
                    for (int q = 0; q < 2; ++q) {
                        float g[8], pv[8], v[8];
                        unpack8(gc[q], g); unpack8(pc[q], pv);
#pragma unroll
                        for (int r = 0; r < 4; ++r) { v[r] = g[r] * acc[mi][2 * q][r] + pv[r]; v[4 + r] = g[4 + r] * acc[mi][2 * q + 1][r] + pv[4 + r]; }
                        *(u32x4*)(mo + (size_t)row * 1024 + col0 + q * 32) = pack8(v);
                    }
                }
            }
        }
    }
}

__device__ __forceinline__ void epi_residual8(const f32x4 (&acc)[8][4], int m0, int n0, const float* xin, float* xo, bf16_t* xb, float* ssq, const float* ss_in) {
    EPI8_IDS
    const int row0 = m0 + wr * 128 + fr, col0 = n0 + wc * 64 + fq * 8;
    f32x4 xn[4]; float sn = 0.f;
#pragma unroll
    for (int q = 0; q < 2; ++q) { xn[2 * q] = *(const f32x4*)(xin + (size_t)row0 * DM + col0 + q * 32); xn[2 * q + 1] = *(const f32x4*)(xin + (size_t)row0 * DM + col0 + q * 32 + 4); }
    if (ss_in) sn = ss_in[row0];
#pragma unroll
    for (int mi = 0; mi < 8; ++mi) {
        const int row = row0 + mi * 16;
        f32x4 xc[4]; const float sc_in = sn;
#pragma unroll
        for (int i = 0; i < 4; ++i) xc[i] = xn[i];
        if (mi < 7) {
#pragma unroll
            for (int q = 0; q < 2; ++q) { xn[2 * q] = *(const f32x4*)(xin + (size_t)(row + 16) * DM + col0 + q * 32); xn[2 * q + 1] = *(const f32x4*)(xin + (size_t)(row + 16) * DM + col0 + q * 32 + 4); }
            if (ss_in) sn = ss_in[row + 16];
        }
        float sc = 1.0f;
        if (ss_in) { const float r = rsqrtf(sc_in * (1.0f / DM) + RMS_EPS); sc = r * r; }
        float ss = 0.f;
#pragma unroll
        for (int q = 0; q < 2; ++q) {
            const int col = col0 + q * 32;
            const f32x4 v0 = xc[2 * q] + acc[mi][2 * q] * sc, v1 = xc[2 * q + 1] + acc[mi][2 * q + 1] * sc;
            *(f32x4*)(xo + (size_t)row * DM + col) = v0; *(f32x4*)(xo + (size_t)row * DM + col + 4) = v1;
            u32x4 o; o.x = pk2(v0[0], v0[1]); o.y = pk2(v0[2], v0[3]); o.z = pk2(v1[0], v1[1]); o.w = pk2(v1[2], v1[3]);
            *(u32x4*)(xb + (size_t)row * DM + col) = o;
            ss += (v0[0] * v0[0] + v0[1] * v0[1] + v0[2] * v0[2] + v0[3] * v0[3]) + (v1[0] * v1[0] + v1[1] * v1[1] + v1[2] * v1[2] + v1[3] * v1[3]);
        }
        ss += __shfl_xor(ss, 16); ss += __shfl_xor(ss, 32);
        if (fq == 0) atomicAdd(ssq + row, ss);
    }
}

__device__ void phase7(const Params& p, unsigned char* lds8) {
    unsigned char* ws = lnd(p.ws);
    const bf16_t* mo = (const bf16_t*)(ws + R_D);
    for (int iter = 0, rt, ct; tile_map8(iter, 128, 4, rt, ct); ++iter) {
        const int m0 = rt * 256, n0 = ct * 256;
        f32x4 acc[8][4];
        gemm8(mo + (size_t)m0 * 1024, 1024, (const bf16_t*)(ws + W_OUT) + (size_t)n0 * 1024, 1024, 1024, acc, lds8);
        epi_residual8(acc, m0, n0, IN(0), lnd(p.out), (bf16_t*)(ws + R_A), (float*)(ws + OFF_SS1), nullptr);
    }
}
__device__ void phase8(const Params& p, unsigned char* lds8) {
    unsigned char* ws = lnd(p.ws); EPI8_IDS
    const bf16_t* xb = (const bf16_t*)(ws + R_A); bf16_t* u = (bf16_t*)(ws + R_U);
    for (int iter = 0, rt, ct; tile_map8(iter, 128, 16, rt, ct); ++iter) {
        const int m0 = rt * 256, n0 = ct * 256;
        f32x4 acc[8][4];
        gemm8(xb + (size_t)m0 * 1024, 1024, (const bf16_t*)(ws + W_UP) + (size_t)n0 * 1024, 1024, 1024, acc, lds8);
#pragma unroll
        for (int mi = 0; mi < 8; ++mi) {
            const int row = m0 + wr * 128 + mi * 16 + fr;
#pragma unroll
            for (int q = 0; q < 2; ++q) {
                const int col = n0 + wc * 64 + q * 32 + fq * 8;
                float v[8];
#pragma unroll
                for (int r = 0; r < 4; ++r) { const float a = fmaxf(acc[mi][2 * q][r], 0.f), c = fmaxf(acc[mi][2 * q + 1][r], 0.f); v[r] = a * a; v[4 + r] = c * c; }
                *(u32x4*)(u + (size_t)row * 4096 + col) = pack8(v);
            }
        }
    }
}
__device__ void phase9(const Params& p, unsigned char* lds8) {
    unsigned char* ws = lnd(p.ws);
    const bf16_t* u = (const bf16_t*)(ws + R_U);
    for (int iter = 0, rt, ct; tile_map8(iter, 128, 4, rt, ct); ++iter) {
        const int m0 = rt * 256, n0 = ct * 256;
        f32x4 acc[8][4];
        gemm8(u + (size_t)m0 * 4096, 4096, (const bf16_t*)(ws + W_DN) + (size_t)n0 * 4096, 4096, 4096, acc, lds8);
        epi_residual8(acc, m0, n0, lnd(p.out), lnd(p.out), (bf16_t*)(ws + R_A), (float*)(ws + OFF_SS2), (const float*)(ws + OFF_SS1));
    }
}
__device__ void phase10(const Params& p, unsigned char* lds8) {
    unsigned char* ws = lnd(p.ws); EPI8_IDS
    const bf16_t* xb = (const bf16_t*)(ws + R_A); const bf16_t* pb = (const bf16_t*)(ws + R_PB);
    const float* ss2 = (const float*)(ws + OFF_SS2);
    float* xo = lnd(p.out);
    bf16_t* ppb = (bf16_t*)(ws + R_B);
    for (int iter = 0, rt, ct; tile_map8(iter, 128, 4, rt, ct); ++iter) {
        const int m0 = rt * 256, n0 = ct * 256;
        const int row0 = m0 + wr * 128 + fr, col0 = n0 + wc * 64 + fq * 8;
        f32x4 acc[8][4];
        gemm8(pb + (size_t)m0 * 256, 256, (const bf16_t*)(ws + W_PP) + (size_t)n0 * 256, 256, 256, acc, lds8);
#pragma unroll
        for (int mi = 0; mi < 8; ++mi) {
#pragma unroll
            for (int q = 0; q < 2; ++q) {
                u32x4 o; o.x = pk2(acc[mi][2 * q][0], acc[mi][2 * q][1]); o.y = pk2(acc[mi][2 * q][2], acc[mi][2 * q][3]);
                o.z = pk2(acc[mi][2 * q + 1][0], acc[mi][2 * q + 1][1]); o.w = pk2(acc[mi][2 * q + 1][2], acc[mi][2 * q + 1][3]);
                *(u32x4*)(ppb + (size_t)(row0 + mi * 16) * 1024 + col0 + q * 32) = o;
            }
        }
        gemm8(xb + (size_t)m0 * 1024, 1024, (const bf16_t*)(ws + W_PG) + (size_t)n0 * 1024, 1024, 1024, acc, lds8);
        {
            f32x4 xn[4]; u32x4 pn[2]; float sn;
#pragma unroll
            for (int q = 0; q < 2; ++q) { xn[2 * q] = *(const f32x4*)(xo + (size_t)row0 * DM + col0 + q * 32); xn[2 * q + 1] = *(const f32x4*)(xo + (size_t)row0 * DM + col0 + q * 32 + 4);
                                          pn[q] = *(const u32x4*)(ppb + (size_t)row0 * 1024 + col0 + q * 32); }
            sn = ss2[row0];
#pragma unroll
            for (int mi = 0; mi < 8; ++mi) {
                const int row = row0 + mi * 16;
                f32x4 xc[4]; u32x4 pc[2]; const float rstd = rsqrtf(sn * (1.0f / DM) + RMS_EPS);
#pragma unroll
                for (int i = 0; i < 4; ++i) xc[i] = xn[i];
                pc[0] = pn[0]; pc[1] = pn[1];
                if (mi < 7) {
#pragma unroll
                    for (int q = 0; q < 2; ++q) { xn[2 * q] = *(const f32x4*)(xo + (size_t)(row + 16) * DM + col0 + q * 32); xn[2 * q + 1] = *(const f32x4*)(xo + (size_t)(row + 16) * DM + col0 + q * 32 + 4);
                                                  pn[q] = *(const u32x4*)(ppb + (size_t)(row + 16) * 1024 + col0 + q * 32); }
                    sn = ss2[row + 16];
                }
#pragma unroll
                for (int q = 0; q < 2; ++q) {
                    float pf[8]; unpack8(pc[q], pf);
                    f32x4 v0 = xc[2 * q], v1 = xc[2 * q + 1];
#pragma unroll
                    for (int r = 0; r < 4; ++r) { v0[r] += sigmoidf_(acc[mi][2 * q][r] * rstd) * pf[r]; v1[r] += sigmoidf_(acc[mi][2 * q + 1][r] * rstd) * pf[4 + r]; }
                    *(f32x4*)(xo + (size_t)row * DM + col0 + q * 32) = v0; *(f32x4*)(xo + (size_t)row * DM + col0 + q * 32 + 4) = v1;
                }
            }
        }
    }
}
__device__ void phase11(const Params& p) {
    float* x = lnd(p.out); const float* g = IN(29);
    const int l = tidx() & 63, gw = VB * 4 + (tidx() >> 6), nw = VG * 4;
    for (int row = gw; row < T_TOK; row += 2 * nw) {
        const int row2 = row + nw; const bool has2 = row2 < T_TOK;
        float* xr = x + (size_t)row * DM; float* xr2 = x + (size_t)(has2 ? row2 : row) * DM;
        f32x4 v[4], w[4]; float ss = 0.f, ss2 = 0.f;
#pragma unroll
        for (int i = 0; i < 4; ++i) { v[i] = *(const f32x4*)(xr + i * 256 + l * 4); w[i] = *(const f32x4*)(xr2 + i * 256 + l * 4); }
#pragma unroll
        for (int i = 0; i < 4; ++i) { ss += v[i][0] * v[i][0] + v[i][1] * v[i][1] + v[i][2] * v[i][2] + v[i][3] * v[i][3]; ss2 += w[i][0] * w[i][0] + w[i][1] * w[i][1] + w[i][2] * w[i][2] + w[i][3] * w[i][3]; }
        ss = wave_sum(ss); ss2 = wave_sum(ss2);
        const float rs = rsqrtf(ss * (1.0f / DM) + RMS_EPS), rs2 = rsqrtf(ss2 * (1.0f / DM) + RMS_EPS);
#pragma unroll
        for (int i = 0; i < 4; ++i) {
            const f32x4 gg = *(const f32x4*)(g + i * 256 + l * 4);
            *(f32x4*)(xr + i * 256 + l * 4) = v[i] * rs * gg;
            if (has2) *(f32x4*)(xr2 + i * 256 + l * 4) = w[i] * rs2 * gg;
        }
    }
}

extern __shared__ __attribute__((aligned(16))) unsigned char dyn_lds[];
constexpr int DYN_LDS = 131072;
__global__ void __launch_bounds__(512, 2) mega(Params p) {
    unsigned char* lds = dyn_lds + VHALF * 65536;
    __shared__ uint4 xbw;
    __shared__ int s_item[2];
    const bool single = (p.ph_hi - p.ph_lo) > 1;
    if (threadIdx.x == 0) xbw = make_uint4(0u, 0u, 0u, 0u);
    __syncthreads();
    XcdBarrier xb; xb.bar = (unsigned*)(p.ws + OFF_BAR); xb.x = 0; xb.st = (volatile LAS unsigned*)&xbw;
    if (single) xb = xcd_barrier_post((unsigned*)(p.ws + OFF_BAR), (volatile LAS unsigned*)&xbw);
    if (p.ph_lo < 0) cg::this_grid().sync();
#ifndef PROBE_MASK
#define PROBE_MASK 0
#endif
#ifndef PROBE_DUP
#define PROBE_DUP -1
#endif
    for (int ph = p.ph_lo; ph < p.ph_hi; ++ph)
    for (int rep = 0; rep < ((ph == PROBE_DUP || ((PROBE_MASK >> ph) & 1)) ? 2 : 1); ++rep) {
#ifndef ONLY_PH
#define ONLY_PH -1
#endif
#ifndef SKIP_PH
#define SKIP_PH -1
#endif
#define RUNPH(k, call) if ((ONLY_PH < 0 || ONLY_PH == k) && SKIP_PH != k && ph == k) { call; }
        RUNPH(0, phase0(p)) RUNPH(1, phase1(p, dyn_lds)) RUNPH(2, phase2(p)) RUNPH(3, phase3(p, lds)) RUNPH(4, phase4(p, lds, s_item, rep)) RUNPH(5, phase5(p))
        RUNPH(6, phase6(p, dyn_lds)) RUNPH(7, phase7(p, dyn_lds)) RUNPH(8, phase8(p, dyn_lds)) RUNPH(9, phase9(p, dyn_lds)) RUNPH(10, phase10(p, dyn_lds)) RUNPH(11, phase11(p))
        if (ph + 1 < p.ph_hi || rep == 0) xcd_barrier(xb);
    }
}

extern "C" void kernel_launch(void* const* d_in, const int* in_sizes, int n_in, void* d_out, int out_size, void* d_ws, size_t ws_size, hipStream_t stream) {
    static int grid_blocks = 0;
    if (!grid_blocks) {
        int dev = 0, cus = 0, per_cu = 0;
        hipGetDevice(&dev);
        hipDeviceGetAttribute(&cus, hipDeviceAttributeMultiprocessorCount, dev);
        hipFuncSetAttribute((const void*)mega, hipFuncAttributeMaxDynamicSharedMemorySize, DYN_LDS);
        hipOccupancyMaxActiveBlocksPerMultiprocessor(&per_cu, mega, 512, DYN_LDS);
        if (per_cu > 1) per_cu = 1;
        if (per_cu < 1) per_cu = 1;
        grid_blocks = cus * per_cu;
    }
    if (ws_size < WS_NEED) { fprintf(stderr, "workspace too small: %zu < %zu\n", ws_size, (size_t)WS_NEED); return; }
    Params p{};
    for (int i = 0; i < 30; ++i) p.in[i] = (const float*)d_in[i];
    p.out = (float*)d_out; p.ws = (unsigned char*)d_ws;
    hipMemsetAsync(d_ws, 0, ZERO_BYTES, stream);
#if MK_MULTI
    for (int ph = 0; ph < NPH; ++ph) { p.ph_lo = ph; p.ph_hi = ph + 1; hipLaunchKernelGGL(mega, dim3(grid_blocks), dim3(512), DYN_LDS, stream, p); }
#else
    p.ph_lo = 0; p.ph_hi = NPH;
    void* args[] = {&p};
    hipError_t e = hipLaunchCooperativeKernel((void*)mega, dim3(grid_blocks), dim3(512), args, DYN_LDS, stream);
    if (e != hipSuccess) fprintf(stderr, "cooperative launch failed: %s (grid %d)\n", hipGetErrorString(e), grid_blocks);
#endif
}
```
